# Optimizing an MI355X kernel written in HIP

```python
import math
import jax
import jax.numpy as jnp
from jax import lax
import numpy as np

D_MODEL = 1024
BATCH = 8
SEQ = 2048
DEPTH = 2

GRID_W = 64
CTX_LEN = 256
N_DIR = 2
EPS = 1e-6

ML_HEADS = 4
ML_HEAD_DIM = 128
ML_WIDTH = ML_HEADS * ML_HEAD_DIM
ML_CHUNK = 64

SSD_HEADS = 8
SSD_HEAD_DIM = 64
SSD_WIDTH = SSD_HEADS * SSD_HEAD_DIM
SSD_STATE = 64
SSD_GROUPS = 2
SSD_CONV = 3
SSD_CHUNK = 64
SSD_XBC = SSD_WIDTH + 2 * SSD_GROUPS * SSD_STATE

ATT_Q_HEADS = 8
ATT_KV_HEADS = 2
ATT_HEAD_DIM = 64
ATT_WIDTH = ATT_Q_HEADS * ATT_HEAD_DIM
ATT_KV_WIDTH = ATT_KV_HEADS * ATT_HEAD_DIM
WINDOW = 128
ATT_BLOCK = 128
ROPE_BASE = 10000.0

MIX_WIDTH = ML_WIDTH + SSD_WIDTH + ATT_WIDTH
D_FF = 4 * D_MODEL

IN_LAYOUT = (
    ('ml_q', ML_WIDTH), ('ml_k', ML_WIDTH), ('ml_v', ML_WIDTH), ('ml_o', ML_WIDTH),
    ('ml_i', N_DIR * ML_HEADS), ('ml_f', N_DIR * ML_HEADS),
    ('ssd_z', SSD_WIDTH), ('ssd_xbc', SSD_XBC), ('ssd_dt', N_DIR * SSD_HEADS),
    ('att_q', ATT_WIDTH), ('att_k', ATT_KV_WIDTH), ('att_v', ATT_KV_WIDTH),
)
IN_WIDTH = (4 * ML_WIDTH + 2 * N_DIR * ML_HEADS + SSD_WIDTH + SSD_XBC + N_DIR * SSD_HEADS
            + ATT_WIDTH + 2 * ATT_KV_WIDTH)

kernel_name = 'hybrid_mlstm_ssd_swa_dit_block'


def rms_norm(x, g):
    xf = x.astype(jnp.float32)
    y = xf * lax.rsqrt(jnp.mean(xf * xf, axis=-1, keepdims=True) + EPS)
    return (y * g.astype(jnp.float32)).astype(x.dtype)


def modulate(h, shift, scale):
    return h * (1 + scale) + shift


def split_cols(u):
    out, off = {}, 0
    for name, width in IN_LAYOUT:
        out[name] = u[..., off:off + width]
        off += width
    return out


def to_chunks(a, q):
    bsz, n = a.shape[:2]
    a = a.reshape((bsz, n // q, q) + a.shape[2:])
    return jnp.moveaxis(jnp.moveaxis(a, 1, 0), 3, 2)


def from_chunks(a):
    nc, bsz, h, q, d = a.shape
    return jnp.moveaxis(jnp.moveaxis(a, 0, 1), 2, 3).reshape(bsz, nc * q, h, d)


def axial_rope(x, rows, cols):
    half = x.shape[-1] // 2
    nfreq = half // 2
    inv = ROPE_BASE ** (-jnp.arange(nfreq, dtype=jnp.float32) / nfreq)

    def rot(xa, pos):
        ang = pos.astype(jnp.float32)[:, None] * inv
        cos, sin = jnp.cos(ang)[None, :, None, :], jnp.sin(ang)[None, :, None, :]
        x1, x2 = xa[..., :nfreq].astype(jnp.float32), xa[..., nfreq:].astype(jnp.float32)
        return jnp.concatenate([x1 * cos - x2 * sin, x2 * cos + x1 * sin], axis=-1)

    return jnp.concatenate([rot(x[..., :half], rows), rot(x[..., half:], cols)], axis=-1).astype(x.dtype)


def depthwise_conv(u, w, b):
    pad = (SSD_CONV - 1) // 2
    y = lax.conv_general_dilated(u, w[:, None, :].astype(u.dtype), window_strides=(1,),
                                 padding=((pad, pad),), dimension_numbers=('NWC', 'WIO', 'NWC'),
                                 feature_group_count=u.shape[-1])
    return y + b.astype(u.dtype)


def mlstm_chunk_scan(q, k, v, log_i, log_f, state, with_outputs):
    tri = jnp.tril(jnp.ones((ML_CHUNK, ML_CHUNK), dtype=bool))

    def step(carry, inp):
        cmat, nvec, m = carry
        qc, kc, vc, li, lf = inp
        b = jnp.cumsum(lf, axis=-1)
        b_end = b[..., -1]
        wlog = b_end[..., None] - b + li
        m_new = jnp.maximum(b_end + m, jnp.max(wlog, axis=-1))
        w = jnp.exp(wlog - m_new[..., None])
        decay = jnp.exp(b_end + m - m_new)
        c_new = decay[..., None, None] * cmat + jnp.einsum('bhs,bhsk,bhsv->bhkv', w, kc, vc)
        n_new = decay[..., None] * nvec + jnp.einsum('bhs,bhsk->bhk', w, kc)
        if not with_outputs:
            return (c_new, n_new, m_new), None
        dlog = jnp.where(tri, b[..., :, None] - b[..., None, :] + li[..., None, :], -jnp.inf)
        inter = b + m[..., None]
        m_t = jnp.maximum(inter, jnp.max(dlog, axis=-1))
        s = jnp.einsum('bhtd,bhsd->bhts', qc, kc) * jnp.exp(dlog - m_t[..., None])
        g = jnp.exp(inter - m_t)
        num = jnp.einsum('bhts,bhsv->bhtv', s, vc) + g[..., None] * jnp.einsum('bhtk,bhkv->bhtv', qc, cmat)
        den = jnp.sum(s, axis=-1) + g * jnp.einsum('bhtk,bhk->bht', qc, nvec)
        h = num / jnp.maximum(jnp.abs(den), jnp.exp(-m_t))[..., None]
        return (c_new, n_new, m_new), h

    inputs = tuple(to_chunks(t, ML_CHUNK) for t in (q, k, v, log_i, log_f))
    state, hs = lax.scan(step, state, inputs)
    return (from_chunks(hs) if with_outputs else None), state


def ssd_chunk_scan(x, bm, cm, dt, a_head, state, with_outputs):
    la = dt * a_head
    tri = jnp.tril(jnp.ones((SSD_CHUNK, SSD_CHUNK), dtype=bool))

    def step(h, inp):
        xc, bc, cc, dtc, lac = inp
        acum = jnp.cumsum(lac, axis=-1)
        a_end = acum[..., -1]
        w = jnp.exp(a_end[..., None] - acum) * dtc
        h_new = jnp.exp(a_end)[..., None, None] * h + jnp.einsum('bhs,bhsp,bhsn->bhpn', w, xc, bc)
        if not with_outputs:
            return h_new, None
        seg = jnp.exp(jnp.where(tri, acum[..., :, None] - acum[..., None, :], -jnp.inf))
        scores = jnp.einsum('bhtn,bhsn->bhts', cc, bc) * seg * dtc[..., None, :]
        y = (jnp.einsum('bhts,bhsp->bhtp', scores, xc)
             + jnp.exp(acum)[..., None] * jnp.einsum('bhtn,bhpn->bhtp', cc, h))
        return h_new, y

    inputs = tuple(to_chunks(t, SSD_CHUNK) for t in (x, bm, cm, dt, la))
    state, ys = lax.scan(step, state, inputs)
    return (from_chunks(ys) if with_outputs else None), state


def orient_fn(d):
    return (lambda a: jnp.flip(a, axis=1)) if d == 1 else (lambda a: a)


def mlstm_mixer(pl, pc, b_i, b_f, norm_g, need_ctx_out):
    f32 = jnp.float32

    def prep(p):
        bsz, n = p['ml_q'].shape[:2]
        shp, gshp = (bsz, n, ML_HEADS, ML_HEAD_DIM), (bsz, n, N_DIR, ML_HEADS)
        q = p['ml_q'].astype(f32).reshape(shp)
        k = p['ml_k'].astype(f32).reshape(shp) * (ML_HEAD_DIM ** -0.5)
        v = p['ml_v'].astype(f32).reshape(shp)
        log_i = p['ml_i'].astype(f32).reshape(gshp) + b_i.astype(f32)
        log_f = jax.nn.log_sigmoid(p['ml_f'].astype(f32).reshape(gshp) + b_f.astype(f32))
        return q, k, v, log_i, log_f

    def finish(h, p):
        bsz, n = h.shape[:2]
        h = rms_norm(h, norm_g.reshape(ML_HEADS, ML_HEAD_DIM)).reshape(bsz, n, ML_WIDTH)
        return (h * jax.nn.sigmoid(p['ml_o'].astype(f32))).astype(p['ml_o'].dtype)

    lat, con = prep(pl), prep(pc)
    bsz = lat[0].shape[0]
    h_lat, h_ctx = [], []
    for d in range(N_DIR):
        orient = orient_fn(d)
        state0 = (jnp.zeros((bsz, ML_HEADS, ML_HEAD_DIM, ML_HEAD_DIM), f32),
                  jnp.zeros((bsz, ML_HEADS, ML_HEAD_DIM), f32),
                  jnp.zeros((bsz, ML_HEADS), f32))
        args_c = [orient(a) for a in (con[0], con[1], con[2], con[3][:, :, d], con[4][:, :, d])]
        args_l = [orient(a) for a in (lat[0], lat[1], lat[2], lat[3][:, :, d], lat[4][:, :, d])]
        hc, st = mlstm_chunk_scan(*args_c, state0, need_ctx_out)
        hl, _ = mlstm_chunk_scan(*args_l, st, True)
        h_lat.append(orient(hl))
        if need_ctx_out:
            h_ctx.append(orient(hc))
    out_l = finish(h_lat[0] + h_lat[1], pl)
    out_c = finish(h_ctx[0] + h_ctx[1], pc) if need_ctx_out else None
    return out_l, out_c


def ssd_mixer(pl, pc, conv_w, conv_b, a_log, dt_bias, d_skip, norm_g, need_ctx_out):
    f32 = jnp.float32
    gn = SSD_GROUPS * SSD_STATE
    rep = SSD_HEADS // SSD_GROUPS

    def prep(p):
        bsz, n = p['ssd_xbc'].shape[:2]
        xbc = jax.nn.silu(depthwise_conv(p['ssd_xbc'], conv_w, conv_b)).astype(f32)
        xs = xbc[..., :SSD_WIDTH].reshape(bsz, n, SSD_HEADS, SSD_HEAD_DIM)
        bm = jnp.repeat(xbc[..., SSD_WIDTH:SSD_WIDTH + gn].reshape(bsz, n, SSD_GROUPS, SSD_STATE), rep, axis=2)
        cm = jnp.repeat(xbc[..., SSD_WIDTH + gn:].reshape(bsz, n, SSD_GROUPS, SSD_STATE), rep, axis=2)
        dt = jax.nn.softplus(p['ssd_dt'].astype(f32).reshape(bsz, n, N_DIR, SSD_HEADS) + dt_bias.astype(f32))
        return xs, bm, cm, dt

    def finish(y, xs, p):
        bsz, n = y.shape[:2]
        y = (y + d_skip.astype(f32)[:, None] * xs).reshape(bsz, n, SSD_WIDTH)
        return rms_norm(y * jax.nn.silu(p['ssd_z'].astype(f32)), norm_g).astype(p['ssd_z'].dtype)

    a = -jnp.exp(a_log.astype(f32))
    lat, con = prep(pl), prep(pc)
    bsz = lat[0].shape[0]
    y_lat, y_ctx = [], []
    for d in range(N_DIR):
        orient = orient_fn(d)
        state0 = jnp.zeros((bsz, SSD_HEADS, SSD_HEAD_DIM, SSD_STATE), f32)
        args_c = [orient(t) for t in (con[0], con[1], con[2], con[3][:, :, d])]
        args_l = [orient(t) for t in (lat[0], lat[1], lat[2], lat[3][:, :, d])]
        yc, st = ssd_chunk_scan(*args_c, a[d], state0, need_ctx_out)
        yl, _ = ssd_chunk_scan(*args_l, a[d], st, True)
        y_lat.append(orient(yl))
        if need_ctx_out:
            y_ctx.append(orient(yc))
    out_l = finish(y_lat[0] + y_lat[1], lat[0], pl)
    out_c = finish(y_ctx[0] + y_ctx[1], con[0], pc) if need_ctx_out else None
    return out_l, out_c


def window_attention(pl, pc, qn_g, kn_g, sink, rows, cols, need_ctx_out):
    f32 = jnp.float32
    bsz, n = pl['att_q'].shape[:2]
    lc = pc['att_k'].shape[1]
    rep = ATT_Q_HEADS // ATT_KV_HEADS
    dh = ATT_HEAD_DIM
    scale = dh ** -0.5
    ql = axial_rope(rms_norm(pl['att_q'].reshape(bsz, n, ATT_Q_HEADS, dh), qn_g), rows, cols)
    kl = axial_rope(rms_norm(pl['att_k'].reshape(bsz, n, ATT_KV_HEADS, dh), kn_g), rows, cols)
    vl = pl['att_v'].reshape(bsz, n, ATT_KV_HEADS, dh)
    kc = rms_norm(pc['att_k'].reshape(bsz, lc, ATT_KV_HEADS, dh), kn_g)
    vc = pc['att_v'].reshape(bsz, lc, ATT_KV_HEADS, dh)
    sink_g = sink.astype(f32).reshape(ATT_KV_HEADS, rep)

    nb = n // ATT_BLOCK
    qb = ql.reshape(bsz, nb, ATT_BLOCK, ATT_KV_HEADS, rep, dh)

    def band(t):
        tp = jnp.pad(t, ((0, 0), (ATT_BLOCK, ATT_BLOCK), (0, 0), (0, 0)))
        tp = tp.reshape(bsz, nb + 2, ATT_BLOCK, ATT_KV_HEADS, dh)
        return jnp.concatenate([tp[:, :-2], tp[:, 1:-1], tp[:, 2:]], axis=2)

    kb, vb = band(kl), band(vl)
    blk = jnp.arange(nb)[:, None, None]
    qpos = blk * ATT_BLOCK + jnp.arange(ATT_BLOCK)[None, :, None]
    kpos = (blk - 1) * ATT_BLOCK + jnp.arange(3 * ATT_BLOCK)[None, None, :]
    valid = (jnp.abs(kpos - qpos) <= WINDOW) & (kpos >= 0) & (kpos < n)
    s_band = jnp.einsum('bnqgrd,bnkgd->bngrqk', qb, kb).astype(f32) * scale
    s_band = jnp.where(valid[None, :, None, None], s_band, -jnp.inf)
    s_ctx = jnp.einsum('bnqgrd,bkgd->bngrqk', qb, kc).astype(f32) * scale
    s_sink = jnp.broadcast_to(sink_g[None, None, :, :, None, None], s_ctx.shape[:-1] + (1,))
    prob = jax.nn.softmax(jnp.concatenate([s_sink, s_ctx, s_band], axis=-1), axis=-1).astype(vl.dtype)
    o = (jnp.einsum('bngrqk,bkgd->bnqgrd', prob[..., 1:1 + lc], vc)
         + jnp.einsum('bngrqk,bnkgd->bnqgrd', prob[..., 1 + lc:], vb))
    out_l = o.reshape(bsz, n, ATT_WIDTH)

    out_c = None
    if need_ctx_out:
        qc = rms_norm(pc['att_q'].reshape(bsz, lc, ATT_Q_HEADS, dh), qn_g).reshape(bsz, lc, ATT_KV_HEADS, rep, dh)
        s_c = jnp.einsum('bqgrd,bkgd->bgrqk', qc, kc).astype(f32) * scale
        s_cs = jnp.broadcast_to(sink_g[None, :, :, None, None], s_c.shape[:-1] + (1,))
        prob_c = jax.nn.softmax(jnp.concatenate([s_cs, s_c], axis=-1), axis=-1).astype(vc.dtype)
        out_c = jnp.einsum('bgrqk,bkgd->bqgrd', prob_c[..., 1:], vc).reshape(bsz, lc, ATT_WIDTH)
    return out_l, out_c


def token_mixers(ul, uc, ml_b_i, ml_b_f, ml_norm_g, ssd_conv_w, ssd_conv_b, ssd_a_log, ssd_dt_bias,
                 ssd_d, ssd_norm_g, att_qn_g, att_kn_g, att_sink, rows, cols, need_ctx_out):
    pl, pc = split_cols(ul), split_cols(uc)
    m_l, m_c = mlstm_mixer(pl, pc, ml_b_i, ml_b_f, ml_norm_g, need_ctx_out)
    s_l, s_c = ssd_mixer(pl, pc, ssd_conv_w, ssd_conv_b, ssd_a_log, ssd_dt_bias, ssd_d, ssd_norm_g, need_ctx_out)
    a_l, a_c = window_attention(pl, pc, att_qn_g, att_kn_g, att_sink, rows, cols, need_ctx_out)
    y_l = jnp.concatenate([m_l, s_l, a_l], axis=-1)
    y_c = jnp.concatenate([m_c, s_c, a_c], axis=-1) if need_ctx_out else None
    return y_l, y_c


def sq_relu_mlp(h, w_up, w_down):
    return jnp.square(jax.nn.relu(h @ w_up)) @ w_down


def setup_inputs(seed: int = 0) -> dict:
    key = jax.random.key(seed)
    ks = jax.random.split(key, 24)
    f32 = jnp.float32

    def nrm(k, shape, scale):
        return jax.random.normal(k, shape, f32) * scale

    def gain(k, shape):
        return 1.0 + 0.02 * jax.random.normal(k, shape, f32)

    dt0 = jnp.exp(jax.random.uniform(ks[14], (DEPTH, N_DIR, SSD_HEADS), f32, math.log(1e-3), math.log(1e-1)))
    return {
        'x': nrm(ks[0], (BATCH, SEQ, D_MODEL), 1.0),
        'c': nrm(ks[1], (BATCH, D_MODEL), 1.0),
        'ctx': nrm(ks[2], (BATCH, CTX_LEN, D_MODEL), 1.0),
        'c_ctx': nrm(ks[3], (D_MODEL,), 1.0),
        'w_mod': nrm(ks[4], (DEPTH, D_MODEL, 6 * D_MODEL), D_MODEL ** -0.5),
        'b_mod': nrm(ks[5], (DEPTH, 6 * D_MODEL), 0.02),
        'norm1_g': gain(ks[6], (DEPTH, D_MODEL)),
        'w_in': nrm(ks[7], (DEPTH, D_MODEL, IN_WIDTH), D_MODEL ** -0.5),
        'ml_b_i': nrm(ks[8], (DEPTH, N_DIR, ML_HEADS), 0.1),
        'ml_b_f': jnp.linspace(3.0, 6.0, ML_HEADS, dtype=f32) + nrm(ks[9], (DEPTH, N_DIR, ML_HEADS), 0.1),
        'ml_norm_g': gain(ks[10], (DEPTH, ML_WIDTH)),
        'ssd_conv_w': nrm(ks[11], (DEPTH, SSD_CONV, SSD_XBC), SSD_CONV ** -0.5),
        'ssd_conv_b': nrm(ks[12], (DEPTH, SSD_XBC), 0.02),
        'ssd_a_log': jnp.log(jax.random.uniform(ks[13], (DEPTH, N_DIR, SSD_HEADS), f32, 1.0, 16.0)),
        'ssd_dt_bias': dt0 + jnp.log(-jnp.expm1(-dt0)),
        'ssd_d': gain(ks[15], (DEPTH, SSD_HEADS)),
        'ssd_norm_g': gain(ks[16], (DEPTH, SSD_WIDTH)),
        'att_qn_g': gain(ks[17], (DEPTH, ATT_HEAD_DIM)),
        'att_kn_g': gain(ks[18], (DEPTH, ATT_HEAD_DIM)),
        'att_sink': nrm(ks[19], (DEPTH, ATT_Q_HEADS), 0.5),
        'w_out': nrm(ks[20], (DEPTH, MIX_WIDTH, D_MODEL), MIX_WIDTH ** -0.5),
        'norm2_g': gain(ks[21], (DEPTH, D_MODEL)),
        'w_up': nrm(ks[22], (DEPTH, D_MODEL, D_FF), D_MODEL ** -0.5),
        'w_down': nrm(ks[23], (DEPTH, D_FF, D_MODEL), D_FF ** -0.5),
    }


def reference(x, c, ctx, c_ctx, w_mod, b_mod, norm1_g, w_in, ml_b_i, ml_b_f, ml_norm_g,
              ssd_conv_w, ssd_conv_b, ssd_a_log, ssd_dt_bias, ssd_d, ssd_norm_g,
              att_qn_g, att_kn_g, att_sink, w_out, norm2_g, w_up, w_down):
    n_lat = x.shape[1]
    n_rows = n_lat // GRID_W
    rows = jnp.repeat(jnp.arange(n_rows, dtype=jnp.int32), GRID_W)
    cols = jnp.tile(jnp.arange(GRID_W, dtype=jnp.int32), n_rows)
    s_lat = jax.nn.silu(c)
    s_ctx = jax.nn.silu(c_ctx)
    h_ctx = ctx
    for layer in range(DEPTH):
        need_ctx_out = layer < DEPTH - 1
        mod_l = jnp.split((s_lat @ w_mod[layer] + b_mod[layer])[:, None, :], 6, axis=-1)
        mod_c = jnp.split(s_ctx @ w_mod[layer] + b_mod[layer], 6, axis=-1)
        ul = modulate(rms_norm(x, norm1_g[layer]), mod_l[0], mod_l[1]) @ w_in[layer]
        uc = modulate(rms_norm(h_ctx, norm1_g[layer]), mod_c[0], mod_c[1]) @ w_in[layer]
        y_l, y_c = token_mixers(ul, uc, ml_b_i[layer], ml_b_f[layer], ml_norm_g[layer],
                                ssd_conv_w[layer], ssd_conv_b[layer], ssd_a_log[layer], ssd_dt_bias[layer],
                                ssd_d[layer], ssd_norm_g[layer], att_qn_g[layer], att_kn_g[layer],
                                att_sink[layer], rows, cols, need_ctx_out)
        x = x + mod_l[2] * (y_l @ w_out[layer])
        x = x + mod_l[5] * sq_relu_mlp(modulate(rms_norm(x, norm2_g[layer]), mod_l[3], mod_l[4]),
                                       w_up[layer], w_down[layer])
        if need_ctx_out:
            h_ctx = h_ctx + mod_c[2] * (y_c @ w_out[layer])
            h_ctx = h_ctx + mod_c[5] * sq_relu_mlp(modulate(rms_norm(h_ctx, norm2_g[layer]), mod_c[3], mod_c[4]),
                                                   w_up[layer], w_down[layer])
    return x
```

```cpp
#include <hip/hip_runtime.h>
#include <cstdio>
#include <cstdint>
#include <cmath>
namespace pg8 {
#define PG8_LAS __attribute__((address_space(3)))
typedef unsigned short bf16_t;
typedef short bf16x8 __attribute__((ext_vector_type(8)));
typedef float f32x4 __attribute__((ext_vector_type(4)));
typedef unsigned u32x4 __attribute__((ext_vector_type(4)));
constexpr int BM = 256, BK = 64, HALF = 128, HTB = HALF * BK * 2  , STAGE_BYTES = 8 * HTB, NXCD = 8, WGM = 8;

__host__ __device__ __forceinline__ int lds_byte(int r, int c) { const int st = (r >> 4) * 2 + (c >> 5), rr = r & 15, cc = c & 31, ob = rr * 64 + cc * 2; return st * 1024 + (ob ^ (((ob >> 9) & 1) << 5)); }
__host__ __device__ __forceinline__ void stage_rc(int b, int& R, int& C) { const int st = b / 1024, sb = b % 1024, swz = sb ^ (((sb >> 9) & 1) << 5); R = (st >> 1) * 16 + swz / 64; C = (st & 1) * 32 + (swz % 64) / 2; }
__host__ __device__ __forceinline__ int perm32(int rho) { const int n = rho >> 4, i = rho & 15; return 8 * (i >> 2) + 4 * n + (i & 3); }

struct Unit { int pm, pn; };
struct Gemm { const bf16_t* A; const bf16_t* Bt; int M, N, K; };

struct StaticOrder {
    int nM, nN, nwg, G, c;
    __host__ __device__ void init(int M, int N, int G_, int c_) { nM = M / BM; nN = N / BM; nwg = nM * nN; G = G_; c = c_; }
    __host__ __device__ bool next(int i, Unit& u) const {
        const long L = (long)i * G + c; if (L >= nwg) return false;
        int wgid = (int)L; { const int q = nwg / NXCD, r = nwg % NXCD, xcd = wgid % NXCD, off = wgid / NXCD; wgid = (xcd < r ? xcd * (q + 1) : r * (q + 1) + (xcd - r) * q) + off; }
        const int nig = WGM * nN, gid = wgid / nig, fm = gid * WGM, gsz = (nM - fm) < WGM ? (nM - fm) : WGM;
        u.pm = fm + ((wgid % nig) % gsz); u.pn = (wgid % nig) / gsz; return true;
    }
    __device__ __forceinline__ void a_ready(const Unit&) const {}
    __device__ __forceinline__ void done(const Unit&) const {}
};

__device__ __forceinline__ unsigned cvt_pk_bf16(float lo, float hi) { unsigned r; asm volatile("v_cvt_pk_bf16_f32 %0, %1, %2" : "=v"(r) : "v"(lo), "v"(hi)); return r; }
typedef float f32x2 __attribute__((ext_vector_type(2)));
__device__ __forceinline__ f32x2 gelu_pk(f32x2 v) {
    const f32x2 av = __builtin_elementwise_abs(v), d = av * 0.2316418882f + 1.0f;
    f32x2 t; t.x = __builtin_amdgcn_rcpf(d.x); t.y = __builtin_amdgcn_rcpf(d.y);
    f32x2 q = t * 0.5307027145f + (-0.7265760135f); q = q * t + 0.7107068705f; q = q * t + (-0.142248368f); q = q * t + 0.127414796f; q = q * t;
    const f32x2 s = (v * v) * (-0.72134752044f);
    f32x2 e; e.x = __builtin_amdgcn_exp2f(s.x); e.y = __builtin_amdgcn_exp2f(s.y);
    const f32x2 m = v * (q * e), r = v - m;
    f32x2 o; o.x = v.x < 0.f ? m.x : r.x; o.y = v.y < 0.f ? m.y : r.y; return o;
}

template <int ACT  > struct EpiBf16 {
    static constexpr bool PERM = true, AFTER_DRAIN = false;
    bf16_t* O; int ldc;
    __device__ __forceinline__ void operator()(const f32x4 (&acc)[2][2][4][2], const Unit& u, int wr, int wc, int fr, int fq) const {
        const int row0 = u.pm * BM + wr * 64 + fr; const int col0 = u.pn * BM + wc * 32 + 8 * fq;
#pragma unroll
        for (int ai = 0; ai < 2; ++ai)
#pragma unroll
            for (int m = 0; m < 4; ++m) { bf16_t* rowp = O + (size_t)(row0 + ai * HALF + m * 16) * ldc + col0;
#pragma unroll
                for (int bj = 0; bj < 2; ++bj) { f32x4 v0 = acc[ai][bj][m][0], v1 = acc[ai][bj][m][1];
                    if (ACT == 2) {
#pragma unroll
                        for (int e = 0; e < 4; ++e) { float a = v0[e] > 0.f ? v0[e] : 0.f; v0[e] = a * a; float b = v1[e] > 0.f ? v1[e] : 0.f; v1[e] = b * b; } }
                    u32x4 w; w.x = cvt_pk_bf16(v0[0], v0[1]); w.y = cvt_pk_bf16(v0[2], v0[3]); w.z = cvt_pk_bf16(v1[0], v1[1]); w.w = cvt_pk_bf16(v1[2], v1[3]);
                    *(u32x4*)(rowp + bj * HALF) = w; } }
    }
};
struct EpiRes {
    static constexpr bool PERM = false, AFTER_DRAIN = false;
    const float* base_l; float* out_l; const float* base_c; float* out_c; const float* gate;
    __device__ __forceinline__ void operator()(const f32x4 (&acc)[2][2][4][2], const Unit& u, int wr, int wc, int fr, int fq) const {
        const bool lat = u.pm < 64;
        const float* bs = lat ? base_l + (size_t)u.pm * BM * 1024 : base_c + (size_t)(u.pm - 64) * BM * 1024;
        float* ot = lat ? out_l + (size_t)u.pm * BM * 1024 : out_c + (size_t)(u.pm - 64) * BM * 1024;
        const float* gt = gate + (size_t)(lat ? (u.pm >> 3) : 8) * 6144;
        const int col0 = u.pn * BM + wc * 32 + 4 * fq;
        f32x4 gv[2][2];
#pragma unroll
        for (int bj = 0; bj < 2; ++bj)
#pragma unroll
            for (int n = 0; n < 2; ++n) gv[bj][n] = *(const f32x4*)(gt + col0 + bj * HALF + n * 16);
#pragma unroll
        for (int ai = 0; ai < 2; ++ai)
#pragma unroll
            for (int m = 0; m < 4; ++m) { const size_t off = (size_t)(ai * HALF + wr * 64 + m * 16 + fr) * 1024 + col0;
#pragma unroll
                for (int bj = 0; bj < 2; ++bj)
#pragma unroll
                    for (int n = 0; n < 2; ++n) { const f32x4 b = *(const f32x4*)(bs + off + bj * HALF + n * 16);
                        *(f32x4*)(ot + off + bj * HALF + n * 16) = b + gv[bj][n] * acc[ai][bj][m][n]; }
                if (m & 1) asm volatile("" ::: "memory"); }
    }
};

template <class Epi, class Sched, bool ALIGN_EPI = false, bool SP2 = false>
__device__ __forceinline__ void gemm_phase(PG8_LAS unsigned char* lds, const Gemm g, const Sched& S, const Epi& E) {
    int tid_l = threadIdx.x; asm volatile("" : "+v"(tid_l));
    const int tid = tid_l, wid = __builtin_amdgcn_readfirstlane(tid >> 6), lane = tid & 63, wr = wid >> 2, wc = wid & 3, fr = lane & 15, fq = lane >> 4;
    const int K = g.K, nt = K / BK;
    unsigned voffA[2], voffB[2];
#pragma unroll
    for (int i = 0; i < 2; ++i) { int R, C; stage_rc(tid * 16 + i * 8192, R, C); const int Rb = Epi::PERM ? ((R & ~31) + perm32(R & 31)) : R;
        voffA[i] = (unsigned)(R * K + C) * 2u; voffB[i] = (unsigned)(Rb * K + C) * 2u; }
    const size_t kstep = (size_t)(BK * 2);
    const size_t hstep = (size_t)HALF * K * 2;
    const size_t tstep = 2 * hstep;
    const unsigned ldsw = (unsigned)wid * 1024u;
    const int aoff = lds_byte(wr * 64 + fr, fq * 8), boff = lds_byte(wc * 32 + fr, fq * 8);
#define PG8_SA(b, h) (((b) * 2 + (h)) * HTB)
#define PG8_SB(b, h) ((4 + (b) * 2 + (h)) * HTB)
#define PG8_STAGE(bufoff, gbase, voff) do { _Pragma("unroll") for (int _i = 0; _i < 2; ++_i) \
        __builtin_amdgcn_global_load_lds((const unsigned*)((const char*)(gbase) + (voff)[_i]), (PG8_LAS unsigned*)(lds + (bufoff) + ldsw + _i * 8192), 16, 0, 0); } while (0)
#define PG8_LDA(dst, b, h) do { _Pragma("unroll") for (int m = 0; m < 4; ++m) _Pragma("unroll") for (int k = 0; k < 2; ++k) dst[m][k] = *(const PG8_LAS bf16x8*)(lds + PG8_SA(b, h) + aoff + m * 2048 + k * 1024); } while (0)
#define PG8_LDB(dst, b, h) do { _Pragma("unroll") for (int n = 0; n < 2; ++n) _Pragma("unroll") for (int k = 0; k < 2; ++k) dst[n][k] = *(const PG8_LAS bf16x8*)(lds + PG8_SB(b, h) + boff + n * 2048 + k * 1024); } while (0)
#define PG8_MMA(ai, bj, At, Bt) do { __builtin_amdgcn_s_setprio(1); _Pragma("unroll") for (int m = 0; m < 4; ++m) _Pragma("unroll") for (int n = 0; n < 2; ++n) _Pragma("unroll") for (int k = 0; k < 2; ++k) \
        acc[ai][bj][m][n] = __builtin_amdgcn_mfma_f32_16x16x32_bf16(Bt[n][k], At[m][k], acc[ai][bj][m][n], 0, 0, 0); __builtin_amdgcn_s_setprio(0); } while (0)
#define PG8_WAIT_V(n) asm volatile("s_waitcnt vmcnt(" #n ")" ::: "memory")
#define PG8_WAIT_L(n) asm volatile("s_waitcnt lgkmcnt(" #n ")" ::: "memory")
#define PG8_BAR __builtin_amdgcn_s_barrier()
#define PG8_SCHED __builtin_amdgcn_sched_barrier(0)
    Unit cur, nxt; int ui = 0;
    if (!S.next(0, cur)) return;
    f32x4 acc[2][2][4][2];
#pragma unroll
    for (int a = 0; a < 2; ++a)
#pragma unroll
        for (int b = 0; b < 2; ++b)
#pragma unroll
            for (int m = 0; m < 4; ++m)
#pragma unroll
                for (int n = 0; n < 2; ++n) acc[a][b][m][n] = (f32x4){0.f, 0.f, 0.f, 0.f};
    bf16x8 At[4][2], B0[2][2], B1[2][2];
    const char* cA = (const char*)g.A + (size_t)cur.pm * tstep; const char* cB = (const char*)g.Bt + (size_t)cur.pn * tstep;
    S.a_ready(cur);
    if constexpr (SP2) {
        PG8_STAGE(PG8_SB(0, 0), cB, voffB); PG8_STAGE(PG8_SB(0, 1), cB + hstep, voffB); PG8_STAGE(PG8_SA(0, 0), cA, voffA); PG8_STAGE(PG8_SA(0, 1), cA + hstep, voffA);
        if (wr == 1) PG8_BAR;
        PG8_WAIT_V(2); PG8_BAR;
        PG8_STAGE(PG8_SB(1, 0), cB + kstep, voffB); PG8_STAGE(PG8_SA(1, 0), cA + kstep, voffA); PG8_STAGE(PG8_SB(1, 1), cB + hstep + kstep, voffB);
        PG8_WAIT_V(6); PG8_BAR;
    } else {
        PG8_STAGE(PG8_SB(0, 0), cB, voffB); PG8_STAGE(PG8_SA(0, 0), cA, voffA); PG8_STAGE(PG8_SB(0, 1), cB + hstep, voffB); PG8_STAGE(PG8_SA(0, 1), cA + hstep, voffA);
        if (wr == 1) PG8_BAR;
        PG8_WAIT_V(4); PG8_BAR;
        PG8_STAGE(PG8_SB(1, 0), cB + kstep, voffB); PG8_STAGE(PG8_SA(1, 0), cA + kstep, voffA); PG8_STAGE(PG8_SB(1, 1), cB + hstep + kstep, voffB);
        PG8_WAIT_V(6); PG8_BAR;
    }
    for (;;) {
        const bool has_next = S.next(ui + 1, nxt);
        const char* nA = has_next ? (const char*)g.A + (size_t)nxt.pm * tstep : cA; const char* nB = has_next ? (const char*)g.Bt + (size_t)nxt.pn * tstep : cB;
        for (int t = 0; t < nt; t += 2) {
            const bool last = (t == nt - 2);
            const char* a1 = cA + (size_t)(t + 1) * kstep;
            const char* a2 = last ? nA : cA + (size_t)(t + 2) * kstep; const char* b2 = last ? nB : cB + (size_t)(t + 2) * kstep;
            const char* a3 = a2 + kstep; const char* b3 = b2 + kstep;
            if (last && has_next) S.a_ready(nxt);
            if constexpr (SP2) {
            PG8_LDB(B0, 0, 0); PG8_LDB(B1, 0, 1); PG8_SCHED; PG8_LDA(At, 0, 0); PG8_STAGE(PG8_SA(1, 1), a1 + hstep, voffA);
            PG8_WAIT_V(8); PG8_WAIT_L(0); PG8_BAR; PG8_MMA(0, 0, At, B0); PG8_MMA(0, 1, At, B1); PG8_BAR; PG8_SCHED;
            PG8_LDA(At, 0, 1); PG8_STAGE(PG8_SB(0, 0), b2, voffB); PG8_STAGE(PG8_SB(0, 1), b2 + hstep, voffB); PG8_STAGE(PG8_SA(0, 0), a2, voffA);
            PG8_WAIT_V(8); PG8_WAIT_L(0); PG8_BAR; PG8_MMA(1, 0, At, B0); PG8_MMA(1, 1, At, B1); PG8_BAR; PG8_SCHED;
            PG8_LDB(B0, 1, 0); PG8_LDB(B1, 1, 1); PG8_SCHED; PG8_LDA(At, 1, 0); PG8_STAGE(PG8_SA(0, 1), a2 + hstep, voffA);
            PG8_WAIT_V(8); PG8_WAIT_L(0); PG8_BAR; PG8_MMA(0, 0, At, B0); PG8_MMA(0, 1, At, B1); PG8_BAR; PG8_SCHED;
            PG8_LDA(At, 1, 1); PG8_STAGE(PG8_SB(1, 0), b3, voffB); PG8_STAGE(PG8_SB(1, 1), b3 + hstep, voffB); PG8_STAGE(PG8_SA(1, 0), a3, voffA);
            PG8_WAIT_V(8); PG8_WAIT_L(0); PG8_BAR; PG8_MMA(1, 0, At, B0); PG8_MMA(1, 1, At, B1); PG8_BAR; PG8_SCHED;
            } else {
            PG8_LDB(B0, 0, 0); PG8_SCHED; PG8_LDA(At, 0, 0); PG8_STAGE(PG8_SA(1, 1), a1 + hstep, voffA);
            PG8_WAIT_L(8); PG8_BAR; PG8_WAIT_L(0); PG8_MMA(0, 0, At, B0); PG8_BAR; PG8_SCHED;
            PG8_LDB(B1, 0, 1); PG8_STAGE(PG8_SB(0, 0), b2, voffB);
            PG8_BAR; PG8_WAIT_L(0); PG8_MMA(0, 1, At, B1); PG8_BAR;
            PG8_LDA(At, 0, 1); PG8_STAGE(PG8_SA(0, 0), a2, voffA);
            PG8_BAR; PG8_WAIT_L(0); PG8_MMA(1, 0, At, B0); PG8_BAR; PG8_SCHED;
            PG8_STAGE(PG8_SB(0, 1), b2 + hstep, voffB);
            PG8_WAIT_V(6); PG8_BAR; PG8_MMA(1, 1, At, B1); PG8_BAR;
            PG8_LDB(B0, 1, 0); PG8_SCHED; PG8_LDA(At, 1, 0); PG8_STAGE(PG8_SA(0, 1), a2 + hstep, voffA);
            PG8_WAIT_L(8); PG8_BAR; PG8_WAIT_L(0); PG8_MMA(0, 0, At, B0); PG8_BAR; PG8_SCHED;
            PG8_LDB(B1, 1, 1); PG8_STAGE(PG8_SB(1, 0), b3, voffB);
            PG8_BAR; PG8_WAIT_L(0); PG8_MMA(0, 1, At, B1); PG8_BAR;
            PG8_LDA(At, 1, 1); PG8_STAGE(PG8_SA(1, 0), a3, voffA);
            PG8_BAR; PG8_WAIT_L(0); PG8_MMA(1, 0, At, B0); PG8_BAR; PG8_SCHED;
            PG8_STAGE(PG8_SB(1, 1), b3 + hstep, voffB);
            PG8_WAIT_V(6); PG8_BAR; PG8_MMA(1, 1, At, B1); PG8_BAR;
            }
        }
        if constexpr (ALIGN_EPI) { if (wr == 0) PG8_BAR; }
        if constexpr (!Epi::AFTER_DRAIN) { E(acc, cur, wr, wc, fr, fq); S.done(cur); }
        if (!has_next) break;
#pragma unroll
        for (int a = 0; a < 2; ++a)
#pragma unroll
            for (int b = 0; b < 2; ++b)
#pragma unroll
                for (int m = 0; m < 4; ++m)
#pragma unroll
                    for (int n = 0; n < 2; ++n) acc[a][b][m][n] = (f32x4){0.f, 0.f, 0.f, 0.f};
        cur = nxt; cA = nA; cB = nB; ++ui;
        if constexpr (ALIGN_EPI) { if (wr == 1) PG8_BAR; }
    }
    PG8_WAIT_V(0);
    if constexpr (!ALIGN_EPI) { if (wr == 0) PG8_BAR; }
    PG8_BAR;
    if constexpr (Epi::AFTER_DRAIN) { E.fused(acc, cur, wr, wc, fr, fq, lds, wid, lane); S.done(cur); }
#undef PG8_SA
#undef PG8_SB
#undef PG8_STAGE
#undef PG8_LDA
#undef PG8_LDB
#undef PG8_MMA
#undef PG8_WAIT_V
#undef PG8_WAIT_L
#undef PG8_BAR
#undef PG8_SCHED
}
}
#define GAS __attribute__((address_space(1)))
#define LAS __attribute__((address_space(3)))
typedef unsigned short bf16;
typedef unsigned v4u __attribute__((ext_vector_type(4)));
typedef float f32x4 __attribute__((ext_vector_type(4)));
typedef short bf16x8 __attribute__((ext_vector_type(8)));
typedef GAS unsigned gu32;
typedef GAS unsigned long long gu64;
#define RLX_AGENT __ATOMIC_RELAXED, __HIP_MEMORY_SCOPE_AGENT
#define LDS_WAIT() asm volatile("s_waitcnt lgkmcnt(0)" ::: "memory")
#define VM_WAIT() asm volatile("s_waitcnt vmcnt(0)" ::: "memory")
__device__ __forceinline__ unsigned long long rt() { return __builtin_amdgcn_s_memrealtime(); }
__device__ __forceinline__ unsigned f2bf(float f) { unsigned u = __builtin_bit_cast(unsigned, f); return (u + 0x7fffu + ((u >> 16) & 1u)) >> 16; }
__device__ __forceinline__ unsigned pk2(float lo, float hi) { return f2bf(lo) | (f2bf(hi) << 16); }

#define XB_TMO      128
#define XB_XCNT(j)  (256  + 64 * (j))
#define XB_XSUB(j)  (1280 + 64 * (j))
#define XB_XGEN(j)  (2304 + 64 * (j))
#define XB_TOP      3328
#define XB_TOPGEN   3392
#define XCD_BAR_WORDS 3456
#define XB_SPIN_CAP (1u << 18)

__device__ __forceinline__ unsigned xb_ld(unsigned* p)              { return __hip_atomic_load(p, __ATOMIC_RELAXED, __HIP_MEMORY_SCOPE_AGENT); }
__device__ __forceinline__ unsigned xb_add(unsigned* p, unsigned v) { return __hip_atomic_fetch_add(p, v, __ATOMIC_RELAXED, __HIP_MEMORY_SCOPE_AGENT); }
__device__ __forceinline__ unsigned xb_xcc_id() { return (unsigned)__builtin_amdgcn_s_getreg((3 << 11) | 20) & 0xFu; }
#define XB_SPIN(cond, bar) do { unsigned _sp = 0; while (cond) { __builtin_amdgcn_s_sleep(1); \
    if ((++_sp & 255u) == 0u) { if (xb_ld(&(bar)[XB_TMO])) break; if (_sp > XB_SPIN_CAP) { atomicAdd(&(bar)[XB_TMO], 1u); break; } } } } while (0)

struct XcdBarrier {
    unsigned* bar; unsigned x;
    volatile LAS unsigned* st;
};

__device__ __forceinline__ XcdBarrier xcd_barrier_post(unsigned* bar, volatile LAS unsigned* st) {
    XcdBarrier b; b.bar = bar; b.x = xb_xcc_id(); b.st = st;
    if (threadIdx.x == 0) (void)xb_add(&bar[XB_XCNT(b.x)], 1u);
    return b;
}
__device__ __forceinline__ void xcd_barrier_complete(unsigned* bar, unsigned x, unsigned& nloc, unsigned& nx) {
    const unsigned G = gridDim.x * gridDim.y * gridDim.z;
    unsigned sum, cnt, mine, sp = 0u;
    for (;;) {
        sum = 0u; cnt = 0u; mine = 0u;
#pragma unroll
        for (unsigned j = 0; j < 16; ++j) { const unsigned c = xb_ld(&bar[XB_XCNT(j)]); sum += c; cnt += (c > 0u) ? 1u : 0u; mine = (j == x) ? c : mine; }
        if (sum == G) break;
        __builtin_amdgcn_s_sleep(1);
        if ((++sp & 255u) == 0u) { if (xb_ld(&bar[XB_TMO])) break; if (sp > XB_SPIN_CAP) { atomicAdd(&bar[XB_TMO], 1u); break; } }
    }
    nloc = mine > 0u ? mine : 1u; nx = cnt > 0u ? cnt : 1u;
}

__device__ __forceinline__ void xcd_barrier(const XcdBarrier& b) {
    asm volatile("s_waitcnt vmcnt(0)" ::: "memory");
    __syncthreads();
    if (threadIdx.x == 0) {
        unsigned* bar = b.bar;
        __builtin_amdgcn_s_waitcnt(0);
        unsigned nloc = b.st[0], nx = b.st[1];
        if (nloc == 0u) { xcd_barrier_complete(bar, b.x, nloc, nx); b.st[0] = nloc; b.st[1] = nx; }
        const unsigned old = xb_add(&bar[XB_XSUB(b.x)], 1u);
        const unsigned gen = old / nloc;
        if (old + 1u == (gen + 1u) * nloc) {
            __builtin_amdgcn_fence(__ATOMIC_RELEASE, "agent");
            asm volatile("s_waitcnt vmcnt(0)" ::: "memory");
            const unsigned og = xb_add(&bar[XB_TOP], 1u);
            const unsigned tg = og / nx;
            if (og + 1u == (tg + 1u) * nx) xb_add(&bar[XB_TOPGEN], 1u);
            else XB_SPIN(xb_ld(&bar[XB_TOPGEN]) == tg, bar);
            __builtin_amdgcn_fence(__ATOMIC_ACQUIRE, "agent");
            xb_add(&bar[XB_XGEN(b.x)], 1u);
            asm volatile("s_waitcnt vmcnt(0)" ::: "memory");
        } else {
            XB_SPIN(xb_ld(&bar[XB_XGEN(b.x)]) == gen, bar);
            __builtin_amdgcn_fence(__ATOMIC_ACQUIRE, "agent");
            asm volatile("s_waitcnt vmcnt(0)" ::: "memory");
        }
    }
    __syncthreads();
}

constexpr int NWAVES = 8;
constexpr int DM = 1024, NB = 8, TL = 2048, LC = 256, DFF = 4096;
constexpr int ML = NB * TL;
constexpr int MC = NB * LC;
constexpr int MT = ML + MC;
constexpr int NU = 4096;
constexpr int UQ = 0, UK = 512, UV = 1024, UO = 1536, UZ = 2048, UX = 2560, UB = 3072, UC = 3200, UAQ = 3328, UAK = 3840, UAV = 3968;
constexpr int INW = 4128;
constexpr int NY = 1536;
constexpr float EPS = 1e-6f;
constexpr int NPH = 21;

constexpr size_t MiB = 1u << 20;
constexpr size_t WS_CTL = 0, CTL_ZERO_BYTES = 1 * MiB;
constexpr size_t WS_MOD = 1 * MiB;
constexpr size_t WS_GATES = 2 * MiB;
constexpr size_t WS_KN = 5 * MiB;
constexpr size_t WS_W0 = 14 * MiB, WS_W1 = 22 * MiB;
constexpr size_t WS_CTXF = 30 * MiB;
constexpr size_t WS_A = 38 * MiB;
constexpr size_t WS_B = 92 * MiB;
constexpr size_t WS_END = 236 * MiB;
static_assert(WS_GATES + (size_t)MT * 32 * 4 <= WS_KN && WS_KN + (size_t)MT * 128 * 4 <= WS_W0 && WS_CTXF + (size_t)MC * DM * 4 <= WS_A && WS_A + (size_t)MT * NY * 2 <= WS_B && WS_B + (size_t)MT * NU * 2 <= WS_END, "d_ws map");
constexpr int CW_BAR = 4096;

constexpr int RING_OFF = 0, RING_BYTES = 131072;
constexpr int LDSCTL_OFF = RING_BYTES, MISC_OFF = LDSCTL_OFF + 320;
constexpr int LDS_BYTES = 147456;

__device__ __forceinline__ float bf2f(unsigned short h) { return __uint_as_float((unsigned)h << 16); }
__device__ __forceinline__ unsigned short f2bf_s(float f) { return (unsigned short)f2bf(f); }
__device__ __forceinline__ float wave_sum(float v) {
#pragma unroll
    for (int o = 1; o < 64; o <<= 1) v += __shfl_xor(v, o);
    return v;
}

struct Frame {
    LAS unsigned char* lds;
    volatile LAS unsigned* MISC;
    gu32* ctl;
    int tid, lane, wave, G;
    float* out;
    unsigned char* ws;
};
__device__ __forceinline__ const float* kin(int i) {
    const __attribute__((address_space(4))) char* ka = (const __attribute__((address_space(4))) char*)__builtin_amdgcn_kernarg_segment_ptr();
    asm volatile("" : "+s"(ka));
    return ((const float* const __attribute__((address_space(4)))*)ka)[i];
}
enum { I_X = 0, I_C, I_CTX, I_CCTX, I_WMOD, I_BMOD, I_N1G, I_WIN, I_MLBI, I_MLBF, I_MLNG, I_CONVW, I_CONVB, I_ALOG, I_DTB, I_SSDD, I_SSDNG, I_QNG, I_KNG, I_SINK, I_WOUT, I_N2G, I_WUP, I_WDOWN };

__device__ __forceinline__ void transpose_item(const float* W, int ldw, int src_col0, bf16* WT, int K, int dst_row0, int k0, LAS float* scr, int lane) {
#pragma unroll 8
    for (int i = 0; i < 32; ++i) { const int kk = 2 * i + (lane >> 5); scr[kk * 33 + (lane & 31)] = W[(size_t)(k0 + kk) * ldw + src_col0 + (lane & 31)]; }
    LDS_WAIT(); asm volatile("" ::: "memory");
    const int c = lane & 7;
#pragma unroll
    for (int j = 0; j < 4; ++j) { const int n = (lane >> 3) + 8 * j; const LAS float* s = scr + (8 * c) * 33 + n;
        v4u o; o.x = pk2(s[0 * 33], s[1 * 33]); o.y = pk2(s[2 * 33], s[3 * 33]); o.z = pk2(s[4 * 33], s[5 * 33]); o.w = pk2(s[6 * 33], s[7 * 33]);
        *(GAS v4u*)(WT + (size_t)(dst_row0 + n) * K + k0 + 8 * c) = o; }
    LDS_WAIT(); asm volatile("" ::: "memory");
}
__device__ __forceinline__ void convert_weight(Frame& F, const float* W, int K, int N, bf16* WT) {
    LAS float* scr = (LAS float*)(F.lds + RING_OFF + F.wave * 16384);
    const int gw = blockIdx.x * NWAVES + F.wave, NGW = F.G * NWAVES, nblk = N / 32, nitems = (K / 64) * nblk;
    for (int it = gw; it < nitems; it += NGW) { const int kb = it / nblk, nb = it % nblk; transpose_item(W, N, 32 * nb, WT, K, 32 * nb, 64 * kb, scr, F.lane); }
}
__device__ __forceinline__ void convert_win(Frame& F, const float* W, bf16* WT) {
    LAS float* scr = (LAS float*)(F.lds + RING_OFF + F.wave * 16384);
    const int gw = blockIdx.x * NWAVES + F.wave, NGW = F.G * NWAVES, nblk = NU / 32, nitems = (DM / 64) * nblk;
    for (int it = gw; it < nitems; it += NGW) { const int kb = it / nblk, nb = it % nblk, d0 = 32 * nb, s0 = d0 + (d0 < 2048 ? 0 : (d0 < 3328 ? 16 : 32));
        transpose_item(W, INW, s0, WT, DM, d0, 64 * kb, scr, F.lane); }
}

__device__ __forceinline__ void phase_mod(Frame& F) {
    LAS float* s = (LAS float*)(F.lds + RING_OFF);
    LAS float* red = (LAS float*)(F.lds + RING_OFF + 36864);
    float* MOD = (float*)(F.ws + WS_MOD);
    for (int i = F.tid; i < 9 * 1024; i += NWAVES * 64) { const int r = i >> 10, k = i & 1023; const float v = r < 8 ? kin(I_C)[r * 1024 + k] : kin(I_CCTX)[k]; s[i] = v / (1.f + expf(-v)); }
    __syncthreads();
    for (int u = blockIdx.x; u < 192; u += F.G) {
        const int L = u / 96, cg = u % 96, col = cg * 64 + F.lane, kq = F.wave;
        const float* w = kin(I_WMOD) + (size_t)L * 1024 * 6144 + col;
        float acc[9];
#pragma unroll
        for (int r = 0; r < 9; ++r) acc[r] = 0.f;
#pragma unroll 4
        for (int k = kq * 128; k < kq * 128 + 128; ++k) { const float wv = w[(size_t)k * 6144];
#pragma unroll
            for (int r = 0; r < 9; ++r) acc[r] += s[r * 1024 + k] * wv; }
#pragma unroll
        for (int r = 0; r < 9; ++r) red[(kq * 9 + r) * 64 + F.lane] = acc[r];
        __syncthreads();
        for (int i = F.tid; i < 576; i += NWAVES * 64) { const int r = i >> 6, c = i & 63; float a = kin(I_BMOD)[L * 6144 + cg * 64 + c];
#pragma unroll
            for (int q = 0; q < 8; ++q) a += red[(q * 9 + r) * 64 + c];
            MOD[(size_t)(L * 9 + r) * 6144 + cg * 64 + c] = a; }
        __syncthreads();
    }
}

template <bool WITH_GATES>
__device__ __forceinline__ void norm_rows(Frame& F, int L, int nrows, const float* xl, const float* xc, const float* g, int chunk0, bf16* XN, LAS float* gwl) {
    const float* MODL = (const float*)(F.ws + WS_MOD) + (size_t)L * 9 * 6144;
    float* GATES = (float*)(F.ws + WS_GATES);
    const int gw = blockIdx.x * NWAVES + F.wave, NGW = F.G * NWAVES, lane = F.lane;
    for (int r = gw; r < nrows; r += NGW) {
        const bool lat = r < ML;
        const float* xr = lat ? xl + (size_t)r * DM : xc + (size_t)(r - ML) * DM;
        const float* md = MODL + (size_t)(lat ? (r >> 11) : 8) * 6144 + chunk0 * 1024;
        f32x4 v[4]; float ss = 0.f;
#pragma unroll
        for (int j = 0; j < 4; ++j) { v[j] = *(const f32x4*)(xr + 256 * j + 4 * lane); ss += (v[j].x * v[j].x + v[j].y * v[j].y) + (v[j].z * v[j].z + v[j].w * v[j].w); }
        const float rstd = 1.0f / sqrtf(wave_sum(ss) * (1.f / DM) + EPS);
#pragma unroll
        for (int j = 0; j < 4; ++j) { const int e = 256 * j + 4 * lane; const f32x4 gg = *(const f32x4*)(g + e), sh = *(const f32x4*)(md + e), sc = *(const f32x4*)(md + 1024 + e);
            v[j] = (v[j] * rstd) * gg * (sc + 1.0f) + sh;
            unsigned long long o = (unsigned long long)pk2(v[j].x, v[j].y) | ((unsigned long long)pk2(v[j].z, v[j].w) << 32);
            *(unsigned long long*)(XN + (size_t)r * DM + e) = o; }
        if (WITH_GATES) {
            float mine = 0.f;
#pragma unroll 4
            for (int jj = 0; jj < 32; ++jj) { float p = 0.f;
#pragma unroll
                for (int j = 0; j < 4; ++j) { const f32x4 w = *(const LAS f32x4*)(gwl + jj * 1024 + 256 * j + 4 * lane); p += (v[j].x * w.x + v[j].y * w.y) + (v[j].z * w.z + v[j].w * w.w); }
                p = wave_sum(p); if (lane == jj) mine = p; }
            if (lane < 32) { float o;
                if (lane < 8) o = mine + kin(I_MLBI)[L * 8 + lane];
                else if (lane < 16) { const float z = mine + kin(I_MLBF)[L * 8 + lane - 8]; o = fminf(z, 0.f) - log1pf(expf(-fabsf(z))); }
                else { const float z = mine + kin(I_DTB)[L * 16 + lane - 16]; o = fmaxf(z, 0.f) + log1pf(expf(-fabsf(z))); }
                GATES[(size_t)r * 32 + lane] = o; }
        }
    }
}

__device__ __forceinline__ void phase_kn(Frame& F, int L) {
    const bf16* U = (const bf16*)(F.ws + WS_B); float* KN = (float*)(F.ws + WS_KN);
    const int gw = blockIdx.x * NWAVES + F.wave, NGW = F.G * NWAVES, lane = F.lane;
    const int gh = lane >> 5, p = lane & 31, fi = p & 15, d1 = (p < 16) ? p : 32 + (p - 16), d2 = d1 + 16;
    const float g1 = kin(I_KNG)[L * 64 + d1], g2 = kin(I_KNG)[L * 64 + d2];
    const float inv = exp2f(-(float)fi * (13.287712379549449f / 16.0f));
    for (int r = gw; r < MT; r += NGW) {
        const bf16* kr = U + (size_t)r * NU + UAK + gh * 64;
        float x1 = bf2f(kr[d1]), x2 = bf2f(kr[d2]);
        float ss = x1 * x1 + x2 * x2;
#pragma unroll
        for (int o = 1; o < 32; o <<= 1) ss += __shfl_xor(ss, o);
        const float rs = 1.0f / sqrtf(ss * (1.f / 64.f) + EPS);
        x1 = x1 * rs * g1; x2 = x2 * rs * g2;
        float o1 = x1, o2 = x2;
        if (r < ML) { const int t = r & 2047; const float pos = (float)((p < 16) ? (t >> 6) : (t & 63)); const float ang = pos * inv; const float cs = __cosf(ang), sn = __sinf(ang);
            o1 = x1 * cs - x2 * sn; o2 = x2 * cs + x1 * sn; }
        KN[(size_t)r * 128 + gh * 64 + d1] = o1; KN[(size_t)r * 128 + gh * 64 + d2] = o2;
    }
}

__device__ __forceinline__ int scan_row(int s, int d, int b) {
    if (s < LC) { const int t = d ? (LC - 1 - s) : s; return ML + b * LC + t; }
    int t = s - LC; if (d) t = TL - 1 - t; return b * TL + t;
}

__device__ __forceinline__ void mlstm_unit(Frame& F, int L, int d, int unit) {
    const int vq = unit & 3, h = (unit >> 2) & 3, b = unit >> 4, lane = F.lane, kh = lane >> 5, vv = lane & 31, gi = d * 4 + h;
    const bf16* U = (const bf16*)(F.ws + WS_B); const float* GATES = (const float*)(F.ws + WS_GATES); bf16* Y = (bf16*)(F.ws + WS_A);
    LAS float* buf = (LAS float*)(F.lds + RING_OFF + F.wave * 16384);
    constexpr int ST = 320;
    constexpr float KSC = 0.08838834764831845f;
    float C[64];
#pragma unroll
    for (int i = 0; i < 64; ++i) C[i] = 0.f;
    float n0 = 0.f, n1 = 0.f, m = 0.f;
    unsigned qd[8], kd[8]; unsigned short vd[8]; float pli[8], plf[8];
#define ML_LOAD(nb_) do { _Pragma("unroll") for (int i = 0; i < 8; ++i) { const int r_ = scan_row((nb_) * 8 + i, d, b); const bf16* ur_ = U + (size_t)r_ * NU + h * 128; \
        qd[i] = *(const unsigned*)(ur_ + UQ + 2 * lane); kd[i] = *(const unsigned*)(ur_ + UK + 2 * lane); vd[i] = ur_[UV + vq * 32 + vv]; \
        pli[i] = GATES[(size_t)r_ * 32 + gi]; plf[i] = GATES[(size_t)r_ * 32 + 8 + gi]; } } while (0)
    ML_LOAD(0);
    for (int nb = 0; nb < (LC + TL) / 8; ++nb) {
#pragma unroll
        for (int i = 0; i < 8; ++i) { LAS float* sl = buf + i * ST;
            sl[2 * lane] = __uint_as_float(qd[i] << 16); sl[2 * lane + 1] = __uint_as_float(qd[i] & 0xffff0000u);
            sl[128 + 2 * lane] = __uint_as_float(kd[i] << 16) * KSC; sl[128 + 2 * lane + 1] = __uint_as_float(kd[i] & 0xffff0000u) * KSC;
            if (lane < 32) sl[256 + lane] = bf2f(vd[i]);
            if (lane == 0) { sl[288] = pli[i]; sl[289] = plf[i]; } }
        if (nb + 1 < (LC + TL) / 8) ML_LOAD(nb + 1);
#pragma unroll 1
        for (int i = 0; i < 8; ++i) { const LAS float* sl = buf + i * ST;
            const float li = sl[288], lf = sl[289], vval = sl[256 + vv];
            const float mn = fmaxf(lf + m, li), dec = __expf(lf + m - mn), iw = __expf(li - mn); m = mn;
            const float ivk = iw * vval; float num = 0.f;
#pragma unroll
            for (int j = 0; j < 16; ++j) { const f32x4 kv = *(const LAS f32x4*)(sl + 128 + kh * 64 + 4 * j), qv = *(const LAS f32x4*)(sl + kh * 64 + 4 * j);
                C[4 * j + 0] = dec * C[4 * j + 0] + ivk * kv.x; num += qv.x * C[4 * j + 0];
                C[4 * j + 1] = dec * C[4 * j + 1] + ivk * kv.y; num += qv.y * C[4 * j + 1];
                C[4 * j + 2] = dec * C[4 * j + 2] + ivk * kv.z; num += qv.z * C[4 * j + 2];
                C[4 * j + 3] = dec * C[4 * j + 3] + ivk * kv.w; num += qv.w * C[4 * j + 3]; }
            num += __shfl_xor(num, 32);
            n0 = dec * n0 + iw * sl[128 + lane]; n1 = dec * n1 + iw * sl[192 + lane];
            const float den = wave_sum(sl[lane] * n0 + sl[64 + lane] * n1);
            const float hv = num / fmaxf(fabsf(den), __expf(-mn));
            const int s = nb * 8 + i;
            if ((s >= LC || L == 0) && lane < 32) { const int r = scan_row(s, d, b); bf16* yp = Y + (size_t)r * NY + h * 128 + vq * 32 + vv;
                if (d == 0) *yp = f2bf_s(hv); else *yp = f2bf_s(bf2f(*yp) + hv); }
        }
    }
#undef ML_LOAD
}

__device__ __forceinline__ void ssd_unit(Frame& F, int L, int d, int unit) {
    const int h = unit & 7, b = unit >> 3, g = h >> 2, lane = F.lane;
    const bf16* U = (const bf16*)(F.ws + WS_B); const float* GATES = (const float*)(F.ws + WS_GATES); bf16* Y = (bf16*)(F.ws + WS_A);
    LAS float* buf = (LAS float*)(F.lds + RING_OFF + F.wave * 16384);
    constexpr int ST = 200;
    const int cx = h * 64 + lane, cb = 512 + g * 64 + lane, cc = 640 + g * 64 + lane;
    const float* cw = kin(I_CONVW) + (size_t)L * 3 * 768; const float* cbias = kin(I_CONVB) + (size_t)L * 768;
    const float wx0 = cw[cx], wx1 = cw[768 + cx], wx2 = cw[1536 + cx], bx = cbias[cx];
    const float wb0 = cw[cb], wb1 = cw[768 + cb], wb2 = cw[1536 + cb], bb = cbias[cb];
    const float wc0 = cw[cc], wc1 = cw[768 + cc], wc2 = cw[1536 + cc], bc = cbias[cc];
    const float a_neg = -expf(kin(I_ALOG)[L * 16 + d * 8 + h]);
    const float dsk = kin(I_SSDD)[L * 8 + h];
    float hs[64];
#pragma unroll
    for (int i = 0; i < 64; ++i) hs[i] = 0.f;
    unsigned short rx[10], rb[10], rc[10]; float pdt[8];
#define SSD_LOAD(nb_) do { const int s0_ = (nb_) * 8; const bool cx_ = s0_ < LC; const int seglen_ = cx_ ? LC : TL; int tf_ = cx_ ? s0_ : s0_ - LC; const int tlo_ = d ? seglen_ - 8 - tf_ : tf_; \
        const size_t rb0_ = cx_ ? (size_t)(ML + b * LC) : (size_t)(b * TL); \
        _Pragma("unroll") for (int i = 0; i < 10; ++i) { const int t_ = tlo_ - 1 + i; const bool ok_ = t_ >= 0 && t_ < seglen_; const bf16* ur_ = U + (rb0_ + (ok_ ? t_ : 0)) * NU + UX; \
            rx[i] = ok_ ? ur_[cx] : (unsigned short)0; rb[i] = ok_ ? ur_[cb] : (unsigned short)0; rc[i] = ok_ ? ur_[cc] : (unsigned short)0; } \
        _Pragma("unroll") for (int i = 0; i < 8; ++i) { const int r_ = scan_row(s0_ + i, d, b); pdt[i] = GATES[(size_t)r_ * 32 + 16 + d * 8 + h]; } } while (0)
    SSD_LOAD(0);
    for (int nb = 0; nb < (LC + TL) / 8; ++nb) {
#pragma unroll
        for (int i = 0; i < 8; ++i) { const int j = d ? 7 - i : i;
            LAS float* sl = buf + i * ST;
            float xv = wx0 * bf2f(rx[j]) + wx1 * bf2f(rx[j + 1]) + wx2 * bf2f(rx[j + 2]) + bx; xv = xv / (1.f + __expf(-xv));
            float bv = wb0 * bf2f(rb[j]) + wb1 * bf2f(rb[j + 1]) + wb2 * bf2f(rb[j + 2]) + bb; bv = bv / (1.f + __expf(-bv));
            float cv = wc0 * bf2f(rc[j]) + wc1 * bf2f(rc[j + 1]) + wc2 * bf2f(rc[j + 2]) + bc; cv = cv / (1.f + __expf(-cv));
            sl[lane] = bv; sl[64 + lane] = cv; sl[128 + lane] = xv; if (lane == 0) sl[192] = pdt[i]; }
        if (nb + 1 < (LC + TL) / 8) SSD_LOAD(nb + 1);
#pragma unroll 1
        for (int i = 0; i < 8; ++i) { const LAS float* sl = buf + i * ST;
            const float dt = sl[192], xv = sl[128 + lane], dA = __expf(dt * a_neg), dbx = dt * xv; float y = 0.f;
#pragma unroll
            for (int j = 0; j < 16; ++j) { const f32x4 Bv = *(const LAS f32x4*)(sl + 4 * j), Cv = *(const LAS f32x4*)(sl + 64 + 4 * j);
                hs[4 * j + 0] = dA * hs[4 * j + 0] + dbx * Bv.x; y += Cv.x * hs[4 * j + 0];
                hs[4 * j + 1] = dA * hs[4 * j + 1] + dbx * Bv.y; y += Cv.y * hs[4 * j + 1];
                hs[4 * j + 2] = dA * hs[4 * j + 2] + dbx * Bv.z; y += Cv.z * hs[4 * j + 2];
                hs[4 * j + 3] = dA * hs[4 * j + 3] + dbx * Bv.w; y += Cv.w * hs[4 * j + 3]; }
            const int s = nb * 8 + i;
            if (s >= LC || L == 0) { const int r = scan_row(s, d, b); bf16* yp = Y + (size_t)r * NY + 512 + h * 64 + lane;
                if (d == 0) *yp = f2bf_s(y); else *yp = f2bf_s(bf2f(*yp) + y + dsk * xv); }
        }
    }
#undef SSD_LOAD
}

__device__ __forceinline__ void attn_unit(Frame& F, int L, int unit) {
    const bf16* U = (const bf16*)(F.ws + WS_B); const float* KN = (const float*)(F.ws + WS_KN); bf16* Y = (bf16*)(F.ws + WS_A);
    const int lane = F.lane, qi = lane >> 2, hh = lane & 3;
    const bool lat = unit < 2048;
    int b, g, t0;
    if (lat) { b = unit >> 8; g = (unit >> 7) & 1; t0 = (unit & 127) * 16; } else { const int u2 = unit - 2048; b = u2 >> 5; g = (u2 >> 4) & 1; t0 = (u2 & 15) * 16; }
    const int head = g * 4 + hh, t = t0 + qi;
    const size_t qrow = lat ? (size_t)(b * TL + t) : (size_t)(ML + b * LC + t);
    float q[64];
    { const bf16* qp = U + qrow * NU + UAQ + head * 64; float ss = 0.f;
#pragma unroll
      for (int j = 0; j < 8; ++j) { const v4u w = *(const v4u*)(qp + 8 * j);
          q[8 * j + 0] = __uint_as_float(w.x << 16); q[8 * j + 1] = __uint_as_float(w.x & 0xffff0000u); q[8 * j + 2] = __uint_as_float(w.y << 16); q[8 * j + 3] = __uint_as_float(w.y & 0xffff0000u);
          q[8 * j + 4] = __uint_as_float(w.z << 16); q[8 * j + 5] = __uint_as_float(w.z & 0xffff0000u); q[8 * j + 6] = __uint_as_float(w.w << 16); q[8 * j + 7] = __uint_as_float(w.w & 0xffff0000u); }
#pragma unroll
      for (int j = 0; j < 64; ++j) ss += q[j] * q[j];
      const float rs = 1.0f / sqrtf(ss * (1.f / 64.f) + EPS);
#pragma unroll
      for (int j = 0; j < 64; ++j) q[j] = q[j] * rs * kin(I_QNG)[L * 64 + j];
      if (lat) { const float prow = (float)(t >> 6), pcol = (float)(t & 63);
#pragma unroll
          for (int i = 0; i < 16; ++i) { const float inv = exp2f(-(float)i * (13.287712379549449f / 16.0f));
              { const float a = prow * inv, cs = __cosf(a), sn = __sinf(a), x1 = q[i], x2 = q[i + 16]; q[i] = x1 * cs - x2 * sn; q[i + 16] = x2 * cs + x1 * sn; }
              { const float a = pcol * inv, cs = __cosf(a), sn = __sinf(a), x1 = q[32 + i], x2 = q[48 + i]; q[32 + i] = x1 * cs - x2 * sn; q[48 + i] = x2 * cs + x1 * sn; } } }
#pragma unroll
      for (int j = 0; j < 64; ++j) q[j] *= 0.125f; }
    float o[64];
#pragma unroll
    for (int j = 0; j < 64; ++j) o[j] = 0.f;
    float mrun = kin(I_SINK)[L * 8 + head], lrun = 1.f;
    int s_lo = 0, s_hi = -1;
    if (lat) { s_lo = t0 - 128 < 0 ? 0 : t0 - 128; s_hi = t0 + 15 + 128 > TL - 1 ? TL - 1 : t0 + 15 + 128; }
    const int nkeys = LC + (s_hi - s_lo + 1);
#pragma unroll 1
    for (int kk = 0; kk < nkeys; ++kk) {
        const bool isc = kk < LC; const int s = isc ? kk : s_lo + (kk - LC);
        const size_t krow = isc ? (size_t)(ML + b * LC + s) : (size_t)(b * TL + s);
        const float* kp = KN + krow * 128 + g * 64; const bf16* vp = U + krow * NU + UAV + g * 64;
        float sc = 0.f;
#pragma unroll
        for (int j = 0; j < 16; ++j) { const f32x4 kv = *(const f32x4*)(kp + 4 * j); sc += (q[4 * j] * kv.x + q[4 * j + 1] * kv.y) + (q[4 * j + 2] * kv.z + q[4 * j + 3] * kv.w); }
        if (!isc) { const int dd = s - t; if (dd > 128 || dd < -128) sc = -INFINITY; }
        const float mn = fmaxf(mrun, sc), al = __expf(mrun - mn), pw = __expf(sc - mn); mrun = mn; lrun = lrun * al + pw;
#pragma unroll
        for (int j = 0; j < 8; ++j) { const v4u w = *(const v4u*)(vp + 8 * j);
            o[8 * j + 0] = o[8 * j + 0] * al + pw * __uint_as_float(w.x << 16); o[8 * j + 1] = o[8 * j + 1] * al + pw * __uint_as_float(w.x & 0xffff0000u);
            o[8 * j + 2] = o[8 * j + 2] * al + pw * __uint_as_float(w.y << 16); o[8 * j + 3] = o[8 * j + 3] * al + pw * __uint_as_float(w.y & 0xffff0000u);
            o[8 * j + 4] = o[8 * j + 4] * al + pw * __uint_as_float(w.z << 16); o[8 * j + 5] = o[8 * j + 5] * al + pw * __uint_as_float(w.z & 0xffff0000u);
            o[8 * j + 6] = o[8 * j + 6] * al + pw * __uint_as_float(w.w << 16); o[8 * j + 7] = o[8 * j + 7] * al + pw * __uint_as_float(w.w & 0xffff0000u); }
    }
    const float il = 1.f / lrun;
    bf16* yp = Y + qrow * NY + 1024 + head * 64;
#pragma unroll
    for (int j = 0; j < 8; ++j) { v4u w; w.x = pk2(o[8 * j] * il, o[8 * j + 1] * il); w.y = pk2(o[8 * j + 2] * il, o[8 * j + 3] * il); w.z = pk2(o[8 * j + 4] * il, o[8 * j + 5] * il); w.w = pk2(o[8 * j + 6] * il, o[8 * j + 7] * il);
        *(v4u*)(yp + 8 * j) = w; }
}

__device__ __forceinline__ void phase_finish(Frame& F, int L) {
    const bf16* U = (const bf16*)(F.ws + WS_B); bf16* Y = (bf16*)(F.ws + WS_A);
    const int gw = blockIdx.x * NWAVES + F.wave, NGW = F.G * NWAVES, lane = F.lane, nrows = (L == 0) ? MT : ML;
    float g1[8], g2[8];
#pragma unroll
    for (int j = 0; j < 8; ++j) { g1[j] = kin(I_MLNG)[L * 512 + 8 * lane + j]; g2[j] = kin(I_SSDNG)[L * 512 + 8 * lane + j]; }
    for (int r = gw; r < nrows; r += NGW) {
        bf16* yr = Y + (size_t)r * NY; const bf16* ur = U + (size_t)r * NU;
        { const v4u hw = *(const v4u*)(yr + 8 * lane), ow = *(const v4u*)(ur + UO + 8 * lane);
          float hv[8], ov[8];
          hv[0] = __uint_as_float(hw.x << 16); hv[1] = __uint_as_float(hw.x & 0xffff0000u); hv[2] = __uint_as_float(hw.y << 16); hv[3] = __uint_as_float(hw.y & 0xffff0000u);
          hv[4] = __uint_as_float(hw.z << 16); hv[5] = __uint_as_float(hw.z & 0xffff0000u); hv[6] = __uint_as_float(hw.w << 16); hv[7] = __uint_as_float(hw.w & 0xffff0000u);
          ov[0] = __uint_as_float(ow.x << 16); ov[1] = __uint_as_float(ow.x & 0xffff0000u); ov[2] = __uint_as_float(ow.y << 16); ov[3] = __uint_as_float(ow.y & 0xffff0000u);
          ov[4] = __uint_as_float(ow.z << 16); ov[5] = __uint_as_float(ow.z & 0xffff0000u); ov[6] = __uint_as_float(ow.w << 16); ov[7] = __uint_as_float(ow.w & 0xffff0000u);
          float ss = 0.f;
#pragma unroll
          for (int j = 0; j < 8; ++j) ss += hv[j] * hv[j];
#pragma unroll
          for (int o = 1; o < 16; o <<= 1) ss += __shfl_xor(ss, o);
          const float rs = 1.0f / sqrtf(ss * (1.f / 128.f) + EPS);
          float rv[8];
#pragma unroll
          for (int j = 0; j < 8; ++j) rv[j] = hv[j] * rs * g1[j] / (1.f + __expf(-ov[j]));
          v4u w; w.x = pk2(rv[0], rv[1]); w.y = pk2(rv[2], rv[3]); w.z = pk2(rv[4], rv[5]); w.w = pk2(rv[6], rv[7]);
          *(v4u*)(yr + 8 * lane) = w; }
        { const v4u hw = *(const v4u*)(yr + 512 + 8 * lane), zw = *(const v4u*)(ur + UZ + 8 * lane);
          float hv[8], zv[8];
          hv[0] = __uint_as_float(hw.x << 16); hv[1] = __uint_as_float(hw.x & 0xffff0000u); hv[2] = __uint_as_float(hw.y << 16); hv[3] = __uint_as_float(hw.y & 0xffff0000u);
          hv[4] = __uint_as_float(hw.z << 16); hv[5] = __uint_as_float(hw.z & 0xffff0000u); hv[6] = __uint_as_float(hw.w << 16); hv[7] = __uint_as_float(hw.w & 0xffff0000u);
          zv[0] = __uint_as_float(zw.x << 16); zv[1] = __uint_as_float(zw.x & 0xffff0000u); zv[2] = __uint_as_float(zw.y << 16); zv[3] = __uint_as_float(zw.y & 0xffff0000u);
          zv[4] = __uint_as_float(zw.z << 16); zv[5] = __uint_as_float(zw.z & 0xffff0000u); zv[6] = __uint_as_float(zw.w << 16); zv[7] = __uint_as_float(zw.w & 0xffff0000u);
          float ss = 0.f;
#pragma unroll
          for (int j = 0; j < 8; ++j) { hv[j] = hv[j] * zv[j] / (1.f + __expf(-zv[j])); ss += hv[j] * hv[j]; }
          ss = wave_sum(ss);
          const float rs = 1.0f / sqrtf(ss * (1.f / 512.f) + EPS);
          v4u w; w.x = pk2(hv[0] * rs * g2[0], hv[1] * rs * g2[1]); w.y = pk2(hv[2] * rs * g2[2], hv[3] * rs * g2[3]); w.z = pk2(hv[4] * rs * g2[4], hv[5] * rs * g2[5]); w.w = pk2(hv[6] * rs * g2[6], hv[7] * rs * g2[7]);
          *(v4u*)(yr + 512 + 8 * lane) = w; }
    }
}

#ifdef NO_MLSTM
#define MLSTM_CALL(d)
#else
#define MLSTM_CALL(d) if (u < 128) mlstm_unit(F, L, d, u);
#endif
#ifdef NO_SSD
#define SSD_CALL(d)
#else
#define SSD_CALL(d) if (u >= 128) ssd_unit(F, L, d, u - 128);
#endif
#ifdef NO_ATTN
#define ATTN_CALL ;
#else
#define ATTN_CALL attn_unit(F, L, u);
#endif
struct Args { const float* in[24]; float* out; unsigned char* ws; int ph_lo, ph_hi; };
__global__ void __launch_bounds__(NWAVES * 64, 2) mk_fwd(Args args) {
    extern __shared__ __attribute__((aligned(16))) unsigned char lds[];
    Frame F;
    F.lds = (LAS unsigned char*)lds;
    F.MISC = (volatile LAS unsigned*)(F.lds + MISC_OFF);
    F.tid = threadIdx.x; F.lane = F.tid & 63; F.wave = __builtin_amdgcn_readfirstlane(F.tid >> 6);
    F.G = gridDim.x;
    F.ws = args.ws; F.out = args.out; F.ctl = (gu32*)(args.ws + WS_CTL);
    for (int u = F.tid; u < (LDS_BYTES - LDSCTL_OFF) / 4; u += NWAVES * 64) ((LAS unsigned*)(F.lds + LDSCTL_OFF))[u] = 0u;
    __syncthreads();
    const int lo = args.ph_lo, hi = args.ph_hi;
    const bool use_bar = (hi - lo) > 1;
    XcdBarrier bar; bar.bar = (unsigned*)(F.ctl + CW_BAR); bar.x = 0; bar.st = nullptr;
    if (use_bar) bar = xcd_barrier_post((unsigned*)(F.ctl + CW_BAR), F.MISC + 8);
#define IN(k) (lo <= (k) && (k) < hi)
#define XL ((L == 0) ? kin(I_X) : (const float*)F.out)
#define XC ((L == 0) ? kin(I_CTX) : (const float*)(F.ws + WS_CTXF))
#define SEAM(k) do { if (IN(k) && IN((k) + 1)) xcd_barrier(bar); asm volatile("" : "+v"(F.lane), "+v"(F.tid)); F.wave = __builtin_amdgcn_readfirstlane(F.tid >> 6); } while (0)

    bf16* W0 = (bf16*)(F.ws + WS_W0); bf16* W1 = (bf16*)(F.ws + WS_W1);
    bf16* RA = (bf16*)(F.ws + WS_A); bf16* RB = (bf16*)(F.ws + WS_B);
    float* CTXF = (float*)(F.ws + WS_CTXF);
    const float* MOD = (const float*)(F.ws + WS_MOD);

    #ifndef NO_MOD
    if (IN(0)) { phase_mod(F); }
#endif
    SEAM(0);

    for (int L = 0; L < 2; ++L) {
        const int p0 = 1 + 10 * L;
        const int Mout = (L == 0) ? MT : ML;
#ifndef NO_A
        if (IN(p0 + 0)) {
            convert_win(F, kin(I_WIN) + (size_t)L * DM * INW, W0);
            convert_weight(F, kin(I_WOUT) + (size_t)L * NY * DM, NY, DM, W1);
            __syncthreads();
            LAS float* gwl = (LAS float*)(F.lds + RING_OFF);
            const float* win = kin(I_WIN) + (size_t)L * DM * INW;
            for (int i = F.tid; i < 32 * 1024; i += NWAVES * 64) { const int j = i & 31, k = i >> 5; gwl[j * 1024 + k] = win[(size_t)k * INW + (j < 16 ? 2048 + j : 3344 + (j - 16))]; }
            __syncthreads();
            norm_rows<true>(F, L, MT, XL, XC, kin(I_N1G) + L * DM, 0, RA, gwl);
            __syncthreads();
        }
#endif
        SEAM(p0 + 0);
#ifndef NO_GB
        if (IN(p0 + 1)) {
            pg8::Gemm g{RA, W0, MT, NU, DM}; pg8::StaticOrder S; S.init(MT, NU, F.G, (int)blockIdx.x);
            pg8::EpiBf16<0> E{RB, NU};
            pg8::gemm_phase<pg8::EpiBf16<0>, pg8::StaticOrder, true, true>(F.lds + RING_OFF, g, S, E);
        }
#endif
        SEAM(p0 + 1);
#ifndef NO_KN
        if (IN(p0 + 2)) { phase_kn(F, L); }
#endif
        SEAM(p0 + 2);
        if (IN(p0 + 3)) {
            if (F.wave == 0) { for (int u = blockIdx.x; u < 192; u += F.G) { MLSTM_CALL(0) SSD_CALL(0) } }
            else { const int nun = (L == 0) ? 2304 : 2048; for (int u = blockIdx.x * 7 + (F.wave - 1); u < nun; u += F.G * 7) ATTN_CALL }
            __syncthreads();
        }
        SEAM(p0 + 3);
        if (IN(p0 + 4)) {
            if (F.wave == 0) { for (int u = blockIdx.x; u < 192; u += F.G) { MLSTM_CALL(1) SSD_CALL(1) } }
            __syncthreads();
        }
        SEAM(p0 + 4);
#ifndef NO_FIN
        if (IN(p0 + 5)) { phase_finish(F, L); }
#endif
        SEAM(p0 + 5);
#ifndef NO_GD
        if (IN(p0 + 6)) {
            pg8::Gemm g{RA, W1, Mout, DM, NY}; pg8::StaticOrder S; S.init(Mout, DM, F.G, (int)blockIdx.x);
            pg8::EpiRes E{XL, F.out, XC, CTXF, MOD + (size_t)L * 9 * 6144 + 2 * 1024};
            pg8::gemm_phase<pg8::EpiRes, pg8::StaticOrder, true, true>(F.lds + RING_OFF, g, S, E);
        }
#endif
        SEAM(p0 + 6);
#ifndef NO_E
        if (IN(p0 + 7)) {
            convert_weight(F, kin(I_WUP) + (size_t)L * DM * DFF, DM, DFF, W0);
            convert_weight(F, kin(I_WDOWN) + (size_t)L * DFF * DM, DFF, DM, W1);
            norm_rows<false>(F, L, Mout, (const float*)F.out, (const float*)CTXF, kin(I_N2G) + L * DM, 3, RA, nullptr);
        }
#endif
        SEAM(p0 + 7);
#ifndef NO_GF
        if (IN(p0 + 8)) {
            pg8::Gemm g{RA, W0, Mout, DFF, DM}; pg8::StaticOrder S; S.init(Mout, DFF, F.G, (int)blockIdx.x);
            pg8::EpiBf16<2> E{RB, DFF};
            pg8::gemm_phase<pg8::EpiBf16<2>, pg8::StaticOrder, true, true>(F.lds + RING_OFF, g, S, E);
        }
#endif
        SEAM(p0 + 8);
#ifndef NO_GG
        if (IN(p0 + 9)) {
            pg8::Gemm g{RB, W1, Mout, DM, DFF}; pg8::StaticOrder S; S.init(Mout, DM, F.G, (int)blockIdx.x);
            pg8::EpiRes E{(const float*)F.out, F.out, (const float*)CTXF, CTXF, MOD + (size_t)L * 9 * 6144 + 5 * 1024};
            pg8::gemm_phase<pg8::EpiRes, pg8::StaticOrder, true, true>(F.lds + RING_OFF, g, S, E);
        }
#endif
        SEAM(p0 + 9);
    }
#undef IN
#undef SEAM
}

#ifndef MK_N_LAUNCHES
#define MK_N_LAUNCHES 1
#endif
extern "C" void kernel_launch(void* const* d_in, const int* in_sizes, int n_in, void* d_out, int out_size, void* d_ws, size_t ws_size, hipStream_t stream) {
    static int grid = 0;
    if (grid == 0) {
        if (n_in != 24 || out_size != ML * DM || ws_size < WS_END) { fprintf(stderr, "kernel_launch: unexpected shapes (n_in %d out %d ws %zu)\n", n_in, out_size, ws_size); grid = -1; return; }
        int dev = 0, cus = 0, per_cu = 0;
        if (hipGetDevice(&dev) != hipSuccess || hipDeviceGetAttribute(&cus, hipDeviceAttributeMultiprocessorCount, dev) != hipSuccess) { grid = -1; return; }
        if (hipFuncSetAttribute((const void*)mk_fwd, hipFuncAttributeMaxDynamicSharedMemorySize, LDS_BYTES) != hipSuccess) { fprintf(stderr, "kernel_launch: hipFuncSetAttribute failed\n"); grid = -1; return; }
        if (hipOccupancyMaxActiveBlocksPerMultiprocessor(&per_cu, (const void*)mk_fwd, NWAVES * 64, LDS_BYTES) != hipSuccess || per_cu < 1) fprintf(stderr, "kernel_launch: occupancy query reports %d\n", per_cu);
        (void)hipGetLastError();
        grid = cus;
    }
    if (grid < 0) return;
    if (hipMemsetAsync((char*)d_ws + WS_CTL, 0, CTL_ZERO_BYTES, stream) != hipSuccess) return;
    Args a{};
    for (int i = 0; i < 24; ++i) a.in[i] = (const float*)d_in[i];
    a.out = (float*)d_out; a.ws = (unsigned char*)d_ws;
    if (MK_N_LAUNCHES == 1) { a.ph_lo = 0; a.ph_hi = NPH; hipLaunchKernelGGL(mk_fwd, dim3(grid), dim3(NWAVES * 64), LDS_BYTES, stream, a); }
    else { for (int p = 0; p < NPH; ++p) { a.ph_lo = p; a.ph_hi = p + 1; hipLaunchKernelGGL(mk_fwd, dim3(grid), dim3(NWAVES * 64), LDS_BYTES, stream, a); } }
}
```

```cpp
#include <hip/hip_runtime.h>
#include <cstdio>
#include <cstdint>
#include <cmath>
namespace pg8 {
#define PG8_LAS __attribute__((address_space(3)))
typedef unsigned short bf16_t;
typedef short bf16x8 __attribute__((ext_vector_type(8)));
typedef float f32x4 __attribute__((ext_vector_type(4)));
typedef unsigned u32x4 __attribute__((ext_vector_type(4)));
constexpr int BM = 256, BK = 64, HALF = 128, HTB = HALF * BK * 2  , STAGE_BYTES = 8 * HTB, NXCD = 8, WGM = 8;

__host__ __device__ __forceinline__ int lds_byte(int r, int c) { const int st = (r >> 4) * 2 + (c >> 5), rr = r & 15, cc = c & 31, ob = rr * 64 + cc * 2; return st * 1024 + (ob ^ (((ob >> 9) & 1) << 5)); }
__host__ __device__ __forceinline__ void stage_rc(int b, int& R, int& C) { const int st = b / 1024, sb = b % 1024, swz = sb ^ (((sb >> 9) & 1) << 5); R = (st >> 1) * 16 + swz / 64; C = (st & 1) * 32 + (swz % 64) / 2; }
__host__ __device__ __forceinline__ int perm32(int rho) { const int n = rho >> 4, i = rho & 15; return 8 * (i >> 2) + 4 * n + (i & 3); }

struct Unit { int pm, pn; };
struct Gemm { const bf16_t* A; const bf16_t* Bt; int M, N, K; };

struct StaticOrder {
    int nM, nN, nwg, G, c;
    __host__ __device__ void init(int M, int N, int G_, int c_) { nM = M / BM; nN = N / BM; nwg = nM * nN; G = G_; c = c_; }
    __host__ __device__ bool next(int i, Unit& u) const {
        const long L = (long)i * G + c; if (L >= nwg) return false;
        int wgid = (int)L; { const int q = nwg / NXCD, r = nwg % NXCD, xcd = wgid % NXCD, off = wgid / NXCD; wgid = (xcd < r ? xcd * (q + 1) : r * (q + 1) + (xcd - r) * q) + off; }
        const int nig = WGM * nN, gid = wgid / nig, fm = gid * WGM, gsz = (nM - fm) < WGM ? (nM - fm) : WGM;
        u.pm = fm + ((wgid % nig) % gsz); u.pn = (wgid % nig) / gsz; return true;
    }
    __device__ __forceinline__ void a_ready(const Unit&) const {}
    __device__ __forceinline__ void done(const Unit&) const {}
};

__device__ __forceinline__ unsigned cvt_pk_bf16(float lo, float hi) { unsigned r; asm volatile("v_cvt_pk_bf16_f32 %0, %1, %2" : "=v"(r) : "v"(lo), "v"(hi)); return r; }
typedef float f32x2 __attribute__((ext_vector_type(2)));
__device__ __forceinline__ f32x2 gelu_pk(f32x2 v) {
    const f32x2 av = __builtin_elementwise_abs(v), d = av * 0.2316418882f + 1.0f;
    f32x2 t; t.x = __builtin_amdgcn_rcpf(d.x); t.y = __builtin_amdgcn_rcpf(d.y);
    f32x2 q = t * 0.5307027145f + (-0.7265760135f); q = q * t + 0.7107068705f; q = q * t + (-0.142248368f); q = q * t + 0.127414796f; q = q * t;
    const f32x2 s = (v * v) * (-0.72134752044f);
    f32x2 e; e.x = __builtin_amdgcn_exp2f(s.x); e.y = __builtin_amdgcn_exp2f(s.y);
    const f32x2 m = v * (q * e), r = v - m;
    f32x2 o; o.x = v.x < 0.f ? m.x : r.x; o.y = v.y < 0.f ? m.y : r.y; return o;
}

template <int ACT  > struct EpiBf16 {
    static constexpr bool PERM = true, AFTER_DRAIN = false;
    bf16_t* O; int ldc;
    __device__ __forceinline__ void operator()(const f32x4 (&acc)[2][2][4][2], const Unit& u, int wr, int wc, int fr, int fq) const {
        const int row0 = u.pm * BM + wr * 64 + fr; const int col0 = u.pn * BM + wc * 32 + 8 * fq;
#pragma unroll
        for (int ai = 0; ai < 2; ++ai)
#pragma unroll
            for (int m = 0; m < 4; ++m) { bf16_t* rowp = O + (size_t)(row0 + ai * HALF + m * 16) * ldc + col0;
#pragma unroll
                for (int bj = 0; bj < 2; ++bj) { f32x4 v0 = acc[ai][bj][m][0], v1 = acc[ai][bj][m][1];
                    if (ACT == 2) {
#pragma unroll
                        for (int e = 0; e < 4; ++e) { float a = v0[e] > 0.f ? v0[e] : 0.f; v0[e] = a * a; float b = v1[e] > 0.f ? v1[e] : 0.f; v1[e] = b * b; } }
                    u32x4 w; w.x = cvt_pk_bf16(v0[0], v0[1]); w.y = cvt_pk_bf16(v0[2], v0[3]); w.z = cvt_pk_bf16(v1[0], v1[1]); w.w = cvt_pk_bf16(v1[2], v1[3]);
                    *(u32x4*)(rowp + bj * HALF) = w; } }
    }
};
struct EpiRes {
    static constexpr bool PERM = false, AFTER_DRAIN = false;
    const float* base_l; float* out_l; const float* base_c; float* out_c; const float* gate;
    __device__ __forceinline__ void operator()(const f32x4 (&acc)[2][2][4][2], const Unit& u, int wr, int wc, int fr, int fq) const {
        const bool lat = u.pm < 64;
        const float* bs = lat ? base_l + (size_t)u.pm * BM * 1024 : base_c + (size_t)(u.pm - 64) * BM * 1024;
        float* ot = lat ? out_l + (size_t)u.pm * BM * 1024 : out_c + (size_t)(u.pm - 64) * BM * 1024;
        const float* gt = gate + (size_t)(lat ? (u.pm >> 3) : 8) * 6144;
        const int col0 = u.pn * BM + wc * 32 + 4 * fq;
        f32x4 gv[2][2];
#pragma unroll
        for (int bj = 0; bj < 2; ++bj)
#pragma unroll
            for (int n = 0; n < 2; ++n) gv[bj][n] = *(const f32x4*)(gt + col0 + bj * HALF + n * 16);
#pragma unroll
        for (int ai = 0; ai < 2; ++ai)
#pragma unroll
            for (int m = 0; m < 4; ++m) { const size_t off = (size_t)(ai * HALF + wr * 64 + m * 16 + fr) * 1024 + col0;
#pragma unroll
                for (int bj = 0; bj < 2; ++bj)
#pragma unroll
                    for (int n = 0; n < 2; ++n) { const f32x4 b = *(const f32x4*)(bs + off + bj * HALF + n * 16);
                        *(f32x4*)(ot + off + bj * HALF + n * 16) = b + gv[bj][n] * acc[ai][bj][m][n]; }
                if (m & 1) asm volatile("" ::: "memory"); }
    }
};

template <class Epi, class Sched, bool ALIGN_EPI = false, bool SP2 = false>
__device__ __forceinline__ void gemm_phase(PG8_LAS unsigned char* lds, const Gemm g, const Sched& S, const Epi& E) {
    int tid_l = threadIdx.x; asm volatile("" : "+v"(tid_l));
    const int tid = tid_l, wid = __builtin_amdgcn_readfirstlane(tid >> 6), lane = tid & 63, wr = wid >> 2, wc = wid & 3, fr = lane & 15, fq = lane >> 4;
    const int K = g.K, nt = K / BK;
    unsigned voffA[2], voffB[2];
#pragma unroll
    for (int i = 0; i < 2; ++i) { int R, C; stage_rc(tid * 16 + i * 8192, R, C); const int Rb = Epi::PERM ? ((R & ~31) + perm32(R & 31)) : R;
        voffA[i] = (unsigned)(R * K + C) * 2u; voffB[i] = (unsigned)(Rb * K + C) * 2u; }
    const size_t kstep = (size_t)(BK * 2);
    const size_t hstep = (size_t)HALF * K * 2;
    const size_t tstep = 2 * hstep;
    const unsigned ldsw = (unsigned)wid * 1024u;
    const int aoff = lds_byte(wr * 64 + fr, fq * 8), boff = lds_byte(wc * 32 + fr, fq * 8);
#define PG8_SA(b, h) (((b) * 2 + (h)) * HTB)
#define PG8_SB(b, h) ((4 + (b) * 2 + (h)) * HTB)
#define PG8_STAGE(bufoff, gbase, voff) do { _Pragma("unroll") for (int _i = 0; _i < 2; ++_i) \
        __builtin_amdgcn_global_load_lds((const unsigned*)((const char*)(gbase) + (voff)[_i]), (PG8_LAS unsigned*)(lds + (bufoff) + ldsw + _i * 8192), 16, 0, 0); } while (0)
#define PG8_LDA(dst, b, h) do { _Pragma("unroll") for (int m = 0; m < 4; ++m) _Pragma("unroll") for (int k = 0; k < 2; ++k) dst[m][k] = *(const PG8_LAS bf16x8*)(lds + PG8_SA(b, h) + aoff + m * 2048 + k * 1024); } while (0)
#define PG8_LDB(dst, b, h) do { _Pragma("unroll") for (int n = 0; n < 2; ++n) _Pragma("unroll") for (int k = 0; k < 2; ++k) dst[n][k] = *(const PG8_LAS bf16x8*)(lds + PG8_SB(b, h) + boff + n * 2048 + k * 1024); } while (0)
#define PG8_MMA(ai, bj, At, Bt) do { __builtin_amdgcn_s_setprio(1); _Pragma("unroll") for (int m = 0; m < 4; ++m) _Pragma("unroll") for (int n = 0; n < 2; ++n) _Pragma("unroll") for (int k = 0; k < 2; ++k) \
        acc[ai][bj][m][n] = __builtin_amdgcn_mfma_f32_16x16x32_bf16(Bt[n][k], At[m][k], acc[ai][bj][m][n], 0, 0, 0); __builtin_amdgcn_s_setprio(0); } while (0)
#define PG8_WAIT_V(n) asm volatile("s_waitcnt vmcnt(" #n ")" ::: "memory")
#define PG8_WAIT_L(n) asm volatile("s_waitcnt lgkmcnt(" #n ")" ::: "memory")
#define PG8_BAR __builtin_amdgcn_s_barrier()
#define PG8_SCHED __builtin_amdgcn_sched_barrier(0)
    Unit cur, nxt; int ui = 0;
    if (!S.next(0, cur)) return;
    f32x4 acc[2][2][4][2];
#pragma unroll
    for (int a = 0; a < 2; ++a)
#pragma unroll
        for (int b = 0; b < 2; ++b)
#pragma unroll
            for (int m = 0; m < 4; ++m)
#pragma unroll
                for (int n = 0; n < 2; ++n) acc[a][b][m][n] = (f32x4){0.f, 0.f, 0.f, 0.f};
    bf16x8 At[4][2], B0[2][2], B1[2][2];
    const char* cA = (const char*)g.A + (size_t)cur.pm * tstep; const char* cB = (const char*)g.Bt + (size_t)cur.pn * tstep;
    S.a_ready(cur);
    if constexpr (SP2) {
        PG8_STAGE(PG8_SB(0, 0), cB, voffB); PG8_STAGE(PG8_SB(0, 1), cB + hstep, voffB); PG8_STAGE(PG8_SA(0, 0), cA, voffA); PG8_STAGE(PG8_SA(0, 1), cA + hstep, voffA);
        if (wr == 1) PG8_BAR;
        PG8_WAIT_V(2); PG8_BAR;
        PG8_STAGE(PG8_SB(1, 0), cB + kstep, voffB); PG8_STAGE(PG8_SA(1, 0), cA + kstep, voffA); PG8_STAGE(PG8_SB(1, 1), cB + hstep + kstep, voffB);
        PG8_WAIT_V(6); PG8_BAR;
    } else {
        PG8_STAGE(PG8_SB(0, 0), cB, voffB); PG8_STAGE(PG8_SA(0, 0), cA, voffA); PG8_STAGE(PG8_SB(0, 1), cB + hstep, voffB); PG8_STAGE(PG8_SA(0, 1), cA + hstep, voffA);
        if (wr == 1) PG8_BAR;
        PG8_WAIT_V(4); PG8_BAR;
        PG8_STAGE(PG8_SB(1, 0), cB + kstep, voffB); PG8_STAGE(PG8_SA(1, 0), cA + kstep, voffA); PG8_STAGE(PG8_SB(1, 1), cB + hstep + kstep, voffB);
        PG8_WAIT_V(6); PG8_BAR;
    }
    for (;;) {
        const bool has_next = S.next(ui + 1, nxt);
        const char* nA = has_next ? (const char*)g.A + (size_t)nxt.pm * tstep : cA; const char* nB = has_next ? (const char*)g.Bt + (size_t)nxt.pn * tstep : cB;
        for (int t = 0; t < nt; t += 2) {
            const bool last = (t == nt - 2);
            const char* a1 = cA + (size_t)(t + 1) * kstep;
            const char* a2 = last ? nA : cA + (size_t)(t + 2) * kstep; const char* b2 = last ? nB : cB + (size_t)(t + 2) * kstep;
            const char* a3 = a2 + kstep; const char* b3 = b2 + kstep;
            if (last && has_next) S.a_ready(nxt);
            if constexpr (SP2) {
            PG8_LDB(B0, 0, 0); PG8_LDB(B1, 0, 1); PG8_SCHED; PG8_LDA(At, 0, 0); PG8_STAGE(PG8_SA(1, 1), a1 + hstep, voffA);
            PG8_WAIT_V(8); PG8_WAIT_L(0); PG8_BAR; PG8_MMA(0, 0, At, B0); PG8_MMA(0, 1, At, B1); PG8_BAR; PG8_SCHED;
            PG8_LDA(At, 0, 1); PG8_STAGE(PG8_SB(0, 0), b2, voffB); PG8_STAGE(PG8_SB(0, 1), b2 + hstep, voffB); PG8_STAGE(PG8_SA(0, 0), a2, voffA);
            PG8_WAIT_V(8); PG8_WAIT_L(0); PG8_BAR; PG8_MMA(1, 0, At, B0); PG8_MMA(1, 1, At, B1); PG8_BAR; PG8_SCHED;
            PG8_LDB(B0, 1, 0); PG8_LDB(B1, 1, 1); PG8_SCHED; PG8_LDA(At, 1, 0); PG8_STAGE(PG8_SA(0, 1), a2 + hstep, voffA);
            PG8_WAIT_V(8); PG8_WAIT_L(0); PG8_BAR; PG8_MMA(0, 0, At, B0); PG8_MMA(0, 1, At, B1); PG8_BAR; PG8_SCHED;
            PG8_LDA(At, 1, 1); PG8_STAGE(PG8_SB(1, 0), b3, voffB); PG8_STAGE(PG8_SB(1, 1), b3 + hstep, voffB); PG8_STAGE(PG8_SA(1, 0), a3, voffA);
            PG8_WAIT_V(8); PG8_WAIT_L(0); PG8_BAR; PG8_MMA(1, 0, At, B0); PG8_MMA(1, 1, At, B1); PG8_BAR; PG8_SCHED;
            } else {
            PG8_LDB(B0, 0, 0); PG8_SCHED; PG8_LDA(At, 0, 0); PG8_STAGE(PG8_SA(1, 1), a1 + hstep, voffA);
            PG8_WAIT_L(8); PG8_BAR; PG8_WAIT_L(0); PG8_MMA(0, 0, At, B0); PG8_BAR; PG8_SCHED;
            PG8_LDB(B1, 0, 1); PG8_STAGE(PG8_SB(0, 0), b2, voffB);
            PG8_BAR; PG8_WAIT_L(0); PG8_MMA(0, 1, At, B1); PG8_BAR;
            PG8_LDA(At, 0, 1); PG8_STAGE(PG8_SA(0, 0), a2, voffA);
            PG8_BAR; PG8_WAIT_L(0); PG8_MMA(1, 0, At, B0); PG8_BAR; PG8_SCHED;
            PG8_STAGE(PG8_SB(0, 1), b2 + hstep, voffB);
            PG8_WAIT_V(6); PG8_BAR; PG8_MMA(1, 1, At, B1); PG8_BAR;
            PG8_LDB(B0, 1, 0); PG8_SCHED; PG8_LDA(At, 1, 0); PG8_STAGE(PG8_SA(0, 1), a2 + hstep, voffA);
            PG8_WAIT_L(8); PG8_BAR; PG8_WAIT_L(0); PG8_MMA(0, 0, At, B0); PG8_BAR; PG8_SCHED;
            PG8_LDB(B1, 1, 1); PG8_STAGE(PG8_SB(1, 0), b3, voffB);
            PG8_BAR; PG8_WAIT_L(0); PG8_MMA(0, 1, At, B1); PG8_BAR;
            PG8_LDA(At, 1, 1); PG8_STAGE(PG8_SA(1, 0), a3, voffA);
            PG8_BAR; PG8_WAIT_L(0); PG8_MMA(1, 0, At, B0); PG8_BAR; PG8_SCHED;
            PG8_STAGE(PG8_SB(1, 1), b3 + hstep, voffB);
            PG8_WAIT_V(6); PG8_BAR; PG8_MMA(1, 1, At, B1); PG8_BAR;
            }
        }
        if constexpr (ALIGN_EPI) { if (wr == 0) PG8_BAR; }
        if constexpr (!Epi::AFTER_DRAIN) { E(acc, cur, wr, wc, fr, fq); S.done(cur); }
        if (!has_next) break;
#pragma unroll
        for (int a = 0; a < 2; ++a)
#pragma unroll
            for (int b = 0; b < 2; ++b)
#pragma unroll
                for (int m = 0; m < 4; ++m)
#pragma unroll
                    for (int n = 0; n < 2; ++n) acc[a][b][m][n] = (f32x4){0.f, 0.f, 0.f, 0.f};
        cur = nxt; cA = nA; cB = nB; ++ui;
        if constexpr (ALIGN_EPI) { if (wr == 1) PG8_BAR; }
    }
    PG8_WAIT_V(0);
    if constexpr (!ALIGN_EPI) { if (wr == 0) PG8_BAR; }
    PG8_BAR;
    if constexpr (Epi::AFTER_DRAIN) { E.fused(acc, cur, wr, wc, fr, fq, lds, wid, lane); S.done(cur); }
#undef PG8_SA
#undef PG8_SB
#undef PG8_STAGE
#undef PG8_LDA
#undef PG8_LDB
#undef PG8_MMA
#undef PG8_WAIT_V
#undef PG8_WAIT_L
#undef PG8_BAR
#undef PG8_SCHED
}
}
#define GAS __attribute__((address_space(1)))
#define LAS __attribute__((address_space(3)))
typedef unsigned short bf16;
typedef unsigned v4u __attribute__((ext_vector_type(4)));
typedef float f32x4 __attribute__((ext_vector_type(4)));
typedef short bf16x8 __attribute__((ext_vector_type(8)));
typedef GAS unsigned gu32;
typedef GAS unsigned long long gu64;
#define RLX_AGENT __ATOMIC_RELAXED, __HIP_MEMORY_SCOPE_AGENT
#define LDS_WAIT() asm volatile("s_waitcnt lgkmcnt(0)" ::: "memory")
#define VM_WAIT() asm volatile("s_waitcnt vmcnt(0)" ::: "memory")
__device__ __forceinline__ unsigned long long rt() { return __builtin_amdgcn_s_memrealtime(); }
__device__ __forceinline__ unsigned f2bf(float f) { unsigned u = __builtin_bit_cast(unsigned, f); return (u + 0x7fffu + ((u >> 16) & 1u)) >> 16; }
__device__ __forceinline__ unsigned pk2(float lo, float hi) { return f2bf(lo) | (f2bf(hi) << 16); }

#define XB_TMO      128
#define XB_XCNT(j)  (256  + 64 * (j))
#define XB_XSUB(j)  (1280 + 64 * (j))
#define XB_XGEN(j)  (2304 + 64 * (j))
#define XB_TOP      3328
#define XB_TOPGEN   3392
#define XCD_BAR_WORDS 3456
#define XB_SPIN_CAP (1u << 18)

__device__ __forceinline__ unsigned xb_ld(unsigned* p)              { return __hip_atomic_load(p, __ATOMIC_RELAXED, __HIP_MEMORY_SCOPE_AGENT); }
__device__ __forceinline__ unsigned xb_add(unsigned* p, unsigned v) { return __hip_atomic_fetch_add(p, v, __ATOMIC_RELAXED, __HIP_MEMORY_SCOPE_AGENT); }
__device__ __forceinline__ unsigned xb_xcc_id() { return (unsigned)__builtin_amdgcn_s_getreg((3 << 11) | 20) & 0xFu; }
#define XB_SPIN(cond, bar) do { unsigned _sp = 0; while (cond) { __builtin_amdgcn_s_sleep(1); \
    if ((++_sp & 255u) == 0u) { if (xb_ld(&(bar)[XB_TMO])) break; if (_sp > XB_SPIN_CAP) { atomicAdd(&(bar)[XB_TMO], 1u); break; } } } } while (0)

struct XcdBarrier {
    unsigned* bar; unsigned x;
    volatile LAS unsigned* st;
};

__device__ __forceinline__ XcdBarrier xcd_barrier_post(unsigned* bar, volatile LAS unsigned* st) {
    XcdBarrier b; b.bar = bar; b.x = xb_xcc_id(); b.st = st;
    if (threadIdx.x == 0) (void)xb_add(&bar[XB_XCNT(b.x)], 1u);
    return b;
}
__device__ __forceinline__ void xcd_barrier_complete(unsigned* bar, unsigned x, unsigned& nloc, unsigned& nx) {
    const unsigned G = gridDim.x * gridDim.y * gridDim.z;
    unsigned sum, cnt, mine, sp = 0u;
    for (;;) {
        sum = 0u; cnt = 0u; mine = 0u;
#pragma unroll
        for (unsigned j = 0; j < 16; ++j) { const unsigned c = xb_ld(&bar[XB_XCNT(j)]); sum += c; cnt += (c > 0u) ? 1u : 0u; mine = (j == x) ? c : mine; }
        if (sum == G) break;
        __builtin_amdgcn_s_sleep(1);
        if ((++sp & 255u) == 0u) { if (xb_ld(&bar[XB_TMO])) break; if (sp > XB_SPIN_CAP) { atomicAdd(&bar[XB_TMO], 1u); break; } }
    }
    nloc = mine > 0u ? mine : 1u; nx = cnt > 0u ? cnt : 1u;
}

__device__ __forceinline__ void xcd_barrier(const XcdBarrier& b) {
    asm volatile("s_waitcnt vmcnt(0)" ::: "memory");
    __syncthreads();
    if (threadIdx.x == 0) {
        unsigned* bar = b.bar;
        __builtin_amdgcn_s_waitcnt(0);
        unsigned nloc = b.st[0], nx = b.st[1];
        if (nloc == 0u) { xcd_barrier_complete(bar, b.x, nloc, nx); b.st[0] = nloc; b.st[1] = nx; }
        const unsigned old = xb_add(&bar[XB_XSUB(b.x)], 1u);
        const unsigned gen = old / nloc;
        if (old + 1u == (gen + 1u) * nloc) {
            __builtin_amdgcn_fence(__ATOMIC_RELEASE, "agent");
            asm volatile("s_waitcnt vmcnt(0)" ::: "memory");
            const unsigned og = xb_add(&bar[XB_TOP], 1u);
            const unsigned tg = og / nx;
            if (og + 1u == (tg + 1u) * nx) xb_add(&bar[XB_TOPGEN], 1u);
            else XB_SPIN(xb_ld(&bar[XB_TOPGEN]) == tg, bar);
            __builtin_amdgcn_fence(__ATOMIC_ACQUIRE, "agent");
            xb_add(&bar[XB_XGEN(b.x)], 1u);
            asm volatile("s_waitcnt vmcnt(0)" ::: "memory");
        } else {
            XB_SPIN(xb_ld(&bar[XB_XGEN(b.x)]) == gen, bar);
            __builtin_amdgcn_fence(__ATOMIC_ACQUIRE, "agent");
            asm volatile("s_waitcnt vmcnt(0)" ::: "memory");
        }
    }
    __syncthreads();
}

constexpr int NWAVES = 8;
constexpr int DM = 1024, NB = 8, TL = 2048, LC = 256, DFF = 4096;
constexpr int ML = NB * TL;
constexpr int MC = NB * LC;
constexpr int MT = ML + MC;
constexpr int NU = 4096;
constexpr int UQ = 0, UK = 512, UV = 1024, UO = 1536, UZ = 2048, UX = 2560, UB = 3072, UC = 3200, UAQ = 3328, UAK = 3840, UAV = 3968;
constexpr int INW = 4128;
constexpr int NY = 1536;
constexpr float EPS = 1e-6f;
constexpr int NPH = 21;

constexpr size_t MiB = 1u << 20;
constexpr size_t WS_CTL = 0, CTL_ZERO_BYTES = 1 * MiB;
constexpr size_t WS_MOD = 1 * MiB;
constexpr size_t WS_GATES = 2 * MiB;
constexpr size_t WS_KN = 5 * MiB;
constexpr size_t WS_W0 = 14 * MiB, WS_W1 = 22 * MiB;
constexpr size_t WS_CTXF = 30 * MiB;
constexpr size_t WS_A = 38 * MiB;
constexpr size_t WS_B = 92 * MiB;
constexpr size_t WS_END = 236 * MiB;
static_assert(WS_GATES + (size_t)MT * 32 * 4 <= WS_KN && WS_KN + (size_t)MT * 128 * 4 <= WS_W0 && WS_CTXF + (size_t)MC * DM * 4 <= WS_A && WS_A + (size_t)MT * NY * 2 <= WS_B && WS_B + (size_t)MT * NU * 2 <= WS_END, "d_ws map");
constexpr int CW_BAR = 4096;

constexpr int RING_OFF = 0, RING_BYTES = 131072;
constexpr int LDSCTL_OFF = RING_BYTES, MISC_OFF = LDSCTL_OFF + 320;
constexpr int LDS_BYTES = 147456;

__device__ __forceinline__ float bf2f(unsigned short h) { return __uint_as_float((unsigned)h << 16); }
__device__ __forceinline__ unsigned short f2bf_s(float f) { return (unsigned short)f2bf(f); }
__device__ __forceinline__ float wave_sum(float v) {
#pragma unroll
    for (int o = 1; o < 64; o <<= 1) v += __shfl_xor(v, o);
    return v;
}

struct Frame {
    LAS unsigned char* lds;
    volatile LAS unsigned* MISC;
    gu32* ctl;
    int tid, lane, wave, G;
    float* out;
    unsigned char* ws;
};
__device__ __forceinline__ const float* kin(int i) {
    const __attribute__((address_space(4))) char* ka = (const __attribute__((address_space(4))) char*)__builtin_amdgcn_kernarg_segment_ptr();
    asm volatile("" : "+s"(ka));
    return ((const float* const __attribute__((address_space(4)))*)ka)[i];
}
enum { I_X = 0, I_C, I_CTX, I_CCTX, I_WMOD, I_BMOD, I_N1G, I_WIN, I_MLBI, I_MLBF, I_MLNG, I_CONVW, I_CONVB, I_ALOG, I_DTB, I_SSDD, I_SSDNG, I_QNG, I_KNG, I_SINK, I_WOUT, I_N2G, I_WUP, I_WDOWN };

__device__ __forceinline__ void transpose_item(const float* W, int ldw, int src_col0, bf16* WT, int K, int dst_row0, int k0, LAS float* scr, int lane) {
#pragma unroll 8
    for (int i = 0; i < 32; ++i) { const int kk = 2 * i + (lane >> 5); scr[kk * 33 + (lane & 31)] = W[(size_t)(k0 + kk) * ldw + src_col0 + (lane & 31)]; }
    LDS_WAIT(); asm volatile("" ::: "memory");
    const int c = lane & 7;
#pragma unroll
    for (int j = 0; j < 4; ++j) { const int n = (lane >> 3) + 8 * j; const LAS float* s = scr + (8 * c) * 33 + n;
        v4u o; o.x = pk2(s[0 * 33], s[1 * 33]); o.y = pk2(s[2 * 33], s[3 * 33]); o.z = pk2(s[4 * 33], s[5 * 33]); o.w = pk2(s[6 * 33], s[7 * 33]);
        *(GAS v4u*)(WT + (size_t)(dst_row0 + n) * K + k0 + 8 * c) = o; }
    LDS_WAIT(); asm volatile("" ::: "memory");
}
__device__ __forceinline__ void convert_weight(Frame& F, const float* W, int K, int N, bf16* WT) {
    LAS float* scr = (LAS float*)(F.lds + RING_OFF + F.wave * 16384);
    const int gw = blockIdx.x * NWAVES + F.wave, NGW = F.G * NWAVES, nblk = N / 32, nitems = (K / 64) * nblk;
    for (int it = gw; it < nitems; it += NGW) { const int kb = it / nblk, nb = it % nblk; transpose_item(W, N, 32 * nb, WT, K, 32 * nb, 64 * kb, scr, F.lane); }
}
__device__ __forceinline__ void convert_win(Frame& F, const float* W, bf16* WT) {
    LAS float* scr = (LAS float*)(F.lds + RING_OFF + F.wave * 16384);
    const int gw = blockIdx.x * NWAVES + F.wave, NGW = F.G * NWAVES, nblk = NU / 32, nitems = (DM / 64) * nblk;
    for (int it = gw; it < nitems; it += NGW) { const int kb = it / nblk, nb = it % nblk, d0 = 32 * nb, s0 = d0 + (d0 < 2048 ? 0 : (d0 < 3328 ? 16 : 32));
        transpose_item(W, INW, s0, WT, DM, d0, 64 * kb, scr, F.lane); }
}

__device__ __forceinline__ void phase_mod(Frame& F) {
    LAS float* s = (LAS float*)(F.lds + RING_OFF);
    LAS float* red = (LAS float*)(F.lds + RING_OFF + 36864);
    float* MOD = (float*)(F.ws + WS_MOD);
    for (int i = F.tid; i < 9 * 1024; i += NWAVES * 64) { const int r = i >> 10, k = i & 1023; const float v = r < 8 ? kin(I_C)[r * 1024 + k] : kin(I_CCTX)[k]; s[i] = v / (1.f + expf(-v)); }
    __syncthreads();
    for (int u = blockIdx.x; u < 192; u += F.G) {
        const int L = u / 96, cg = u % 96, col = cg * 64 + F.lane, kq = F.wave;
        const float* w = kin(I_WMOD) + (size_t)L * 1024 * 6144 + col;
        float acc[9];
#pragma unroll
        for (int r = 0; r < 9; ++r) acc[r] = 0.f;
#pragma unroll 4
        for (int k = kq * 128; k < kq * 128 + 128; ++k) { const float wv = w[(size_t)k * 6144];
#pragma unroll
            for (int r = 0; r < 9; ++r) acc[r] += s[r * 1024 + k] * wv; }
#pragma unroll
        for (int r = 0; r < 9; ++r) red[(kq * 9 + r) * 64 + F.lane] = acc[r];
        __syncthreads();
        for (int i = F.tid; i < 576; i += NWAVES * 64) { const int r = i >> 6, c = i & 63; float a = kin(I_BMOD)[L * 6144 + cg * 64 + c];
#pragma unroll
            for (int q = 0; q < 8; ++q) a += red[(q * 9 + r) * 64 + c];
            MOD[(size_t)(L * 9 + r) * 6144 + cg * 64 + c] = a; }
        __syncthreads();
    }
}

template <bool WITH_GATES>
__device__ __forceinline__ void norm_rows(Frame& F, int L, int nrows, const float* xl, const float* xc, const float* g, int chunk0, bf16* XN, LAS float* gwl) {
    const float* MODL = (const float*)(F.ws + WS_MOD) + (size_t)L * 9 * 6144;
    float* GATES = (float*)(F.ws + WS_GATES);
    const int gw = blockIdx.x * NWAVES + F.wave, NGW = F.G * NWAVES, lane = F.lane;
    for (int r = gw; r < nrows; r += NGW) {
        const bool lat = r < ML;
        const float* xr = lat ? xl + (size_t)r * DM : xc + (size_t)(r - ML) * DM;
        const float* md = MODL + (size_t)(lat ? (r >> 11) : 8) * 6144 + chunk0 * 1024;
        f32x4 v[4]; float ss = 0.f;
#pragma unroll
        for (int j = 0; j < 4; ++j) { v[j] = *(const f32x4*)(xr + 256 * j + 4 * lane); ss += (v[j].x * v[j].x + v[j].y * v[j].y) + (v[j].z * v[j].z + v[j].w * v[j].w); }
        const float rstd = 1.0f / sqrtf(wave_sum(ss) * (1.f / DM) + EPS);
#pragma unroll
        for (int j = 0; j < 4; ++j) { const int e = 256 * j + 4 * lane; const f32x4 gg = *(const f32x4*)(g + e), sh = *(const f32x4*)(md + e), sc = *(const f32x4*)(md + 1024 + e);
            v[j] = (v[j] * rstd) * gg * (sc + 1.0f) + sh;
            unsigned long long o = (unsigned long long)pk2(v[j].x, v[j].y) | ((unsigned long long)pk2(v[j].z, v[j].w) << 32);
            *(unsigned long long*)(XN + (size_t)r * DM + e) = o; }
        if (WITH_GATES) {
            float mine = 0.f;
#pragma unroll 4
            for (int jj = 0; jj < 32; ++jj) { float p = 0.f;
#pragma unroll
                for (int j = 0; j < 4; ++j) { const f32x4 w = *(const LAS f32x4*)(gwl + jj * 1024 + 256 * j + 4 * lane); p += (v[j].x * w.x + v[j].y * w.y) + (v[j].z * w.z + v[j].w * w.w); }
                p = wave_sum(p); if (lane == jj) mine = p; }
            if (lane < 32) { float o;
                if (lane < 8) o = mine + kin(I_MLBI)[L * 8 + lane];
                else if (lane < 16) { const float z = mine + kin(I_MLBF)[L * 8 + lane - 8]; o = fminf(z, 0.f) - log1pf(expf(-fabsf(z))); }
                else { const float z = mine + kin(I_DTB)[L * 16 + lane - 16]; o = fmaxf(z, 0.f) + log1pf(expf(-fabsf(z))); }
                GATES[(size_t)r * 32 + lane] = o; }
        }
    }
}

__device__ __forceinline__ void phase_qkn(Frame& F, int L) {
    bf16* U = (bf16*)(F.ws + WS_B);
    const int gw = blockIdx.x * NWAVES + F.wave, NGW = F.G * NWAVES, lane = F.lane;
    const int gh = lane >> 5, p = lane & 31, fi = p & 15, d1 = (p < 16) ? p : 32 + (p - 16), d2 = d1 + 16;
    const float gq1 = kin(I_QNG)[L * 64 + d1], gq2 = kin(I_QNG)[L * 64 + d2], gk1 = kin(I_KNG)[L * 64 + d1], gk2 = kin(I_KNG)[L * 64 + d2];
    const float inv = exp2f(-(float)fi * (13.287712379549449f / 16.0f));
    const int nrows = (L == 0) ? MT : MT;
    for (int r = gw; r < nrows; r += NGW) {
        float cs = 1.f, sn = 0.f;
        if (r < ML) { const int t = r & 2047; const float pos = (float)((p < 16) ? (t >> 6) : (t & 63)); const float ang = pos * inv; cs = __cosf(ang); sn = __sinf(ang); }
#pragma unroll
        for (int j = 0; j < 5; ++j) {
            const int c = 2 * j + gh;
            bf16* kr = U + (size_t)r * NU + UAQ + c * 64;
            float x1 = bf2f(kr[d1]), x2 = bf2f(kr[d2]);
            float ss = x1 * x1 + x2 * x2;
#pragma unroll
            for (int o = 1; o < 32; o <<= 1) ss += __shfl_xor(ss, o);
            const float rs = 1.0f / sqrtf(ss * (1.f / 64.f) + EPS);
            const bool isq = c < 8; const float sc = isq ? 0.125f * 1.4426950408889634f : 1.0f;
            x1 = x1 * rs * (isq ? gq1 : gk1) * sc; x2 = x2 * rs * (isq ? gq2 : gk2) * sc;
            kr[d1] = f2bf_s(x1 * cs - x2 * sn); kr[d2] = f2bf_s(x2 * cs + x1 * sn);
        }
    }
}

__device__ __forceinline__ int scan_row(int s, int d, int b) {
    if (s < LC) { const int t = d ? (LC - 1 - s) : s; return ML + b * LC + t; }
    int t = s - LC; if (d) t = TL - 1 - t; return b * TL + t;
}

__device__ __forceinline__ void mlstm_unit(Frame& F, int L, int d, int unit) {
    const int vq = unit & 3, h = (unit >> 2) & 3, b = unit >> 4, lane = F.lane, kh = lane >> 5, vv = lane & 31, gi = d * 4 + h;
    const bf16* U = (const bf16*)(F.ws + WS_B); const float* GATES = (const float*)(F.ws + WS_GATES); bf16* Y = (bf16*)(F.ws + WS_A);
    LAS float* buf = (LAS float*)(F.lds + RING_OFF + F.wave * 16384);
    constexpr int ST = 320;
    constexpr float KSC = 0.08838834764831845f;
    float C[64];
#pragma unroll
    for (int i = 0; i < 64; ++i) C[i] = 0.f;
    float n0 = 0.f, n1 = 0.f, m = 0.f;
    unsigned qd[8], kd[8]; unsigned short vd[8]; float pli[8], plf[8];
#define ML_LOAD(nb_) do { _Pragma("unroll") for (int i = 0; i < 8; ++i) { const int r_ = scan_row((nb_) * 8 + i, d, b); const bf16* ur_ = U + (size_t)r_ * NU + h * 128; \
        qd[i] = *(const unsigned*)(ur_ + UQ + 2 * lane); kd[i] = *(const unsigned*)(ur_ + UK + 2 * lane); vd[i] = ur_[UV + vq * 32 + vv]; \
        pli[i] = GATES[(size_t)r_ * 32 + gi]; plf[i] = GATES[(size_t)r_ * 32 + 8 + gi]; } } while (0)
    ML_LOAD(0);
    for (int nb = 0; nb < (LC + TL) / 8; ++nb) {
#pragma unroll
        for (int i = 0; i < 8; ++i) { LAS float* sl = buf + i * ST;
            sl[2 * lane] = __uint_as_float(qd[i] << 16); sl[2 * lane + 1] = __uint_as_float(qd[i] & 0xffff0000u);
            sl[128 + 2 * lane] = __uint_as_float(kd[i] << 16) * KSC; sl[128 + 2 * lane + 1] = __uint_as_float(kd[i] & 0xffff0000u) * KSC;
            if (lane < 32) sl[256 + lane] = bf2f(vd[i]);
            if (lane == 0) { sl[288] = pli[i]; sl[289] = plf[i]; } }
        if (nb + 1 < (LC + TL) / 8) ML_LOAD(nb + 1);
#pragma unroll 1
        for (int i = 0; i < 8; ++i) { const LAS float* sl = buf + i * ST;
            const float li = sl[288], lf = sl[289], vval = sl[256 + vv];
            const float mn = fmaxf(lf + m, li), dec = __expf(lf + m - mn), iw = __expf(li - mn); m = mn;
            const float ivk = iw * vval; float num = 0.f;
#pragma unroll
            for (int j = 0; j < 16; ++j) { const f32x4 kv = *(const LAS f32x4*)(sl + 128 + kh * 64 + 4 * j), qv = *(const LAS f32x4*)(sl + kh * 64 + 4 * j);
                C[4 * j + 0] = dec * C[4 * j + 0] + ivk * kv.x; num += qv.x * C[4 * j + 0];
                C[4 * j + 1] = dec * C[4 * j + 1] + ivk * kv.y; num += qv.y * C[4 * j + 1];
                C[4 * j + 2] = dec * C[4 * j + 2] + ivk * kv.z; num += qv.z * C[4 * j + 2];
                C[4 * j + 3] = dec * C[4 * j + 3] + ivk * kv.w; num += qv.w * C[4 * j + 3]; }
            num += __shfl_xor(num, 32);
            n0 = dec * n0 + iw * sl[128 + lane]; n1 = dec * n1 + iw * sl[192 + lane];
            const float den = wave_sum(sl[lane] * n0 + sl[64 + lane] * n1);
            const float hv = num / fmaxf(fabsf(den), __expf(-mn));
            const int s = nb * 8 + i;
            if ((s >= LC || L == 0) && lane < 32) { const int r = scan_row(s, d, b); bf16* yp = Y + (size_t)r * NY + h * 128 + vq * 32 + vv;
                if (d == 0) *yp = f2bf_s(hv); else *yp = f2bf_s(bf2f(*yp) + hv); }
        }
    }
#undef ML_LOAD
}

constexpr int MP_Q = 272, MP_S = 144;
constexpr int MO_QS = 0, MO_KS = 17408, MO_KW = 34816, MO_VT = 53248, MO_SP = 71680, MO_CT = 80896, MO_SC = 115712;
static_assert(MO_SC + 2064 <= RING_BYTES, "mLSTM LDS map");
__device__ __forceinline__ void mlstm_block_unit(Frame& F, int L, int d, int unit) {
    const int h = unit & 3, b = unit >> 2, tid = F.tid, lane = F.lane, w = F.wave, fr = lane & 15, fq = lane >> 4, gi = d * 4 + h;
    const bf16* U = (const bf16*)(F.ws + WS_B); const float* GATES = (const float*)(F.ws + WS_GATES); bf16* Y = (bf16*)(F.ws + WS_A);
    LAS unsigned char* lds = F.lds + RING_OFF;
    LAS float* sc_a = (LAS float*)(lds + MO_SC); LAS float* sc_mx = sc_a + 64; LAS float* sc_g = sc_a + 128; LAS float* sc_w = sc_a + 192; LAS float* sc_emt = sc_a + 256; LAS float* sc_rd = sc_a + 320;
    LAS float* sc_n = sc_a + 384; LAS float* sc_s = sc_a + 512;
    constexpr float KSC = 0.08838834764831845f;
    typedef unsigned u32x2 __attribute__((ext_vector_type(2)));
    __syncthreads();
    for (int i = tid; i < 128 * MP_Q / 16; i += NWAVES * 64) *(LAS v4u*)(lds + MO_CT + i * 16) = (v4u){0u, 0u, 0u, 0u};
    if (tid < 128) sc_n[tid] = 0.f;
    if (tid == 0) { sc_s[0] = 0.f; sc_s[1] = 0.f; }
    f32x4 C[8];
#pragma unroll
    for (int j = 0; j < 8; ++j) C[j] = (f32x4){0.f, 0.f, 0.f, 0.f};
    const int srow = tid >> 3, part = tid & 7;
    v4u pq0, pq1, pk0, pk1, pv0, pv1; float gli = 0.f, glf = 0.f;
#define MB_LOAD(c_) do { const int r_ = scan_row((c_) * 64 + srow, d, b); const bf16* ur_ = U + (size_t)r_ * NU + h * 128 + 16 * part; \
        pq0 = *(const v4u*)(ur_ + UQ); pq1 = *(const v4u*)(ur_ + UQ + 8); pk0 = *(const v4u*)(ur_ + UK); pk1 = *(const v4u*)(ur_ + UK + 8); pv0 = *(const v4u*)(ur_ + UV); pv1 = *(const v4u*)(ur_ + UV + 8); \
        if (w == 0) { const int r2_ = scan_row((c_) * 64 + lane, d, b); gli = GATES[(size_t)r2_ * 32 + gi]; glf = GATES[(size_t)r2_ * 32 + 8 + gi]; } } while (0)
    MB_LOAD(0);
    __syncthreads();
    for (int c = 0; c < (LC + TL) / 64; ++c) {
        if (w == 0) {
            float bc = glf;
#pragma unroll
            for (int o = 1; o < 64; o <<= 1) { const float t_ = __shfl_up(bc, o); if (lane >= o) bc += t_; }
            const float a = gli - bc; float am = a;
#pragma unroll
            for (int o = 1; o < 64; o <<= 1) { const float t_ = __shfl_up(am, o); if (lane >= o) am = fmaxf(am, t_); }
            const float m_in = sc_s[0], mx = fmaxf(m_in, am), g = __expf(m_in - mx), mx63 = __shfl(mx, 63), wv = __expf(a - mx63), mt = bc + mx;
            sc_a[lane] = a; sc_mx[lane] = mx; sc_g[lane] = g; sc_w[lane] = wv; sc_emt[lane] = __expf(-mt);
            if (lane == 63) { sc_s[0] = mt; sc_s[1] = g; }
        }
        __syncthreads();
        {
            *(LAS v4u*)(lds + MO_QS + srow * MP_Q + part * 32) = pq0; *(LAS v4u*)(lds + MO_QS + srow * MP_Q + part * 32 + 16) = pq1;
            *(LAS v4u*)(lds + MO_KS + srow * MP_Q + part * 32) = pk0; *(LAS v4u*)(lds + MO_KS + srow * MP_Q + part * 32 + 16) = pk1;
            const float wk = sc_w[srow] * KSC;
            LAS unsigned short* kw = (LAS unsigned short*)(lds + MO_KW + (16 * part) * MP_S + srow * 2);
            LAS unsigned short* vt = (LAS unsigned short*)(lds + MO_VT + (16 * part) * MP_S + srow * 2);
            const unsigned kk[8] = {pk0.x, pk0.y, pk0.z, pk0.w, pk1.x, pk1.y, pk1.z, pk1.w};
            const unsigned vv[8] = {pv0.x, pv0.y, pv0.z, pv0.w, pv1.x, pv1.y, pv1.z, pv1.w};
#pragma unroll
            for (int e = 0; e < 8; ++e) {
                kw[(2 * e) * (MP_S / 2)] = f2bf_s(__uint_as_float(kk[e] << 16) * wk); kw[(2 * e + 1) * (MP_S / 2)] = f2bf_s(__uint_as_float(kk[e] & 0xffff0000u) * wk);
                vt[(2 * e) * (MP_S / 2)] = (unsigned short)(vv[e] & 0xffffu); vt[(2 * e + 1) * (MP_S / 2)] = (unsigned short)(vv[e] >> 16); }
        }
        if (c + 1 < (LC + TL) / 64) MB_LOAD(c + 1);
        __syncthreads();
        {
            const int ms = w >> 1, nt0 = 2 * (w & 1);
            f32x4 acc[2] = {(f32x4){0.f, 0.f, 0.f, 0.f}, (f32x4){0.f, 0.f, 0.f, 0.f}};
#pragma unroll
            for (int kk2 = 0; kk2 < 4; ++kk2) {
                const bf16x8 af = *(const LAS bf16x8*)(lds + MO_KS + (16 * ms + fr) * MP_Q + (32 * kk2 + 8 * fq) * 2);
#pragma unroll
                for (int j = 0; j < 2; ++j) { const bf16x8 bfv = *(const LAS bf16x8*)(lds + MO_QS + (16 * (nt0 + j) + fr) * MP_Q + (32 * kk2 + 8 * fq) * 2);
                    acc[j] = __builtin_amdgcn_mfma_f32_16x16x32_bf16(af, bfv, acc[j], 0, 0, 0); }
            }
            const int s0 = 16 * ms + 4 * fq;
            const f32x4 av = *(const LAS f32x4*)(sc_a + s0);
#pragma unroll
            for (int j = 0; j < 2; ++j) { const int t = 16 * (nt0 + j) + fr; const float mxt = sc_mx[t];
                float v0 = (s0 + 0 <= t) ? acc[j][0] * KSC * __expf(av[0] - mxt) : 0.f, v1 = (s0 + 1 <= t) ? acc[j][1] * KSC * __expf(av[1] - mxt) : 0.f;
                float v2 = (s0 + 2 <= t) ? acc[j][2] * KSC * __expf(av[2] - mxt) : 0.f, v3 = (s0 + 3 <= t) ? acc[j][3] * KSC * __expf(av[3] - mxt) : 0.f;
                u32x2 o; o.x = pk2(v0, v1); o.y = pk2(v2, v3);
                *(LAS u32x2*)(lds + MO_SP + t * MP_S + s0 * 2) = o; }
        }
        __syncthreads();
        {
            const int t = srow;
            const v4u sp = *(const LAS v4u*)(lds + MO_SP + t * MP_S + part * 16);
            float ssum = (__uint_as_float(sp.x << 16) + __uint_as_float(sp.x & 0xffff0000u)) + (__uint_as_float(sp.y << 16) + __uint_as_float(sp.y & 0xffff0000u))
                       + (__uint_as_float(sp.z << 16) + __uint_as_float(sp.z & 0xffff0000u)) + (__uint_as_float(sp.w << 16) + __uint_as_float(sp.w & 0xffff0000u));
            const v4u q0 = *(const LAS v4u*)(lds + MO_QS + t * MP_Q + part * 32), q1 = *(const LAS v4u*)(lds + MO_QS + t * MP_Q + part * 32 + 16);
            const unsigned qq[8] = {q0.x, q0.y, q0.z, q0.w, q1.x, q1.y, q1.z, q1.w};
            float qn = 0.f;
#pragma unroll
            for (int e = 0; e < 8; ++e) qn += __uint_as_float(qq[e] << 16) * sc_n[16 * part + 2 * e] + __uint_as_float(qq[e] & 0xffff0000u) * sc_n[16 * part + 2 * e + 1];
            ssum += __shfl_xor(ssum, 1); ssum += __shfl_xor(ssum, 2); ssum += __shfl_xor(ssum, 4);
            qn += __shfl_xor(qn, 1); qn += __shfl_xor(qn, 2); qn += __shfl_xor(qn, 4);
            if (part == 0) { const float den = ssum + sc_g[t] * qn; sc_rd[t] = 1.0f / fmaxf(fabsf(den), sc_emt[t]); }
        }
        __syncthreads();
        if (c >= LC / 64 || L == 0) {
            const int mv = w;
            f32x4 a1[4], a2[4];
#pragma unroll
            for (int j = 0; j < 4; ++j) { a1[j] = (f32x4){0.f, 0.f, 0.f, 0.f}; a2[j] = (f32x4){0.f, 0.f, 0.f, 0.f}; }
#pragma unroll
            for (int kk2 = 0; kk2 < 2; ++kk2) {
                const bf16x8 af = *(const LAS bf16x8*)(lds + MO_VT + (16 * mv + fr) * MP_S + (32 * kk2 + 8 * fq) * 2);
#pragma unroll
                for (int j = 0; j < 4; ++j) { const bf16x8 bfv = *(const LAS bf16x8*)(lds + MO_SP + (16 * j + fr) * MP_S + (32 * kk2 + 8 * fq) * 2);
                    a1[j] = __builtin_amdgcn_mfma_f32_16x16x32_bf16(af, bfv, a1[j], 0, 0, 0); }
            }
#pragma unroll
            for (int kk2 = 0; kk2 < 4; ++kk2) {
                const bf16x8 af = *(const LAS bf16x8*)(lds + MO_CT + (16 * mv + fr) * MP_Q + (32 * kk2 + 8 * fq) * 2);
#pragma unroll
                for (int j = 0; j < 4; ++j) { const bf16x8 bfv = *(const LAS bf16x8*)(lds + MO_QS + (16 * j + fr) * MP_Q + (32 * kk2 + 8 * fq) * 2);
                    a2[j] = __builtin_amdgcn_mfma_f32_16x16x32_bf16(af, bfv, a2[j], 0, 0, 0); }
            }
#pragma unroll
            for (int j = 0; j < 4; ++j) { const int t = 16 * j + fr; const float g = sc_g[t], rd = sc_rd[t];
                const int row = scan_row(c * 64 + t, d, b);
                bf16* yp = Y + (size_t)row * NY + h * 128 + 16 * mv + 4 * fq;
                float h0 = (a1[j][0] + g * a2[j][0]) * rd, h1 = (a1[j][1] + g * a2[j][1]) * rd, h2 = (a1[j][2] + g * a2[j][2]) * rd, h3 = (a1[j][3] + g * a2[j][3]) * rd;
                if (d == 1) { const u32x2 old = *(const u32x2*)yp; h0 += __uint_as_float(old.x << 16); h1 += __uint_as_float(old.x & 0xffff0000u); h2 += __uint_as_float(old.y << 16); h3 += __uint_as_float(old.y & 0xffff0000u); }
                u32x2 o; o.x = pk2(h0, h1); o.y = pk2(h2, h3); *(u32x2*)yp = o; }
        }
        __syncthreads();
        {
            const float decay = sc_s[1]; const int mk = w;
#pragma unroll
            for (int j = 0; j < 8; ++j) C[j] = C[j] * decay;
#pragma unroll
            for (int kk2 = 0; kk2 < 2; ++kk2) {
                const bf16x8 af = *(const LAS bf16x8*)(lds + MO_KW + (16 * mk + fr) * MP_S + (32 * kk2 + 8 * fq) * 2);
#pragma unroll
                for (int j = 0; j < 8; ++j) { const bf16x8 bfv = *(const LAS bf16x8*)(lds + MO_VT + (16 * j + fr) * MP_S + (32 * kk2 + 8 * fq) * 2);
                    C[j] = __builtin_amdgcn_mfma_f32_16x16x32_bf16(af, bfv, C[j], 0, 0, 0); }
            }
#pragma unroll
            for (int j = 0; j < 8; ++j) { u32x2 o; o.x = pk2(C[j][0], C[j][1]); o.y = pk2(C[j][2], C[j][3]);
                *(LAS u32x2*)(lds + MO_CT + (16 * j + fr) * MP_Q + (16 * mk + 4 * fq) * 2) = o; }
            if (tid < 128) { float sm = 0.f;
#pragma unroll
                for (int e = 0; e < 8; ++e) { const v4u x = *(const LAS v4u*)(lds + MO_KW + tid * MP_S + e * 16);
                    sm += (__uint_as_float(x.x << 16) + __uint_as_float(x.x & 0xffff0000u)) + (__uint_as_float(x.y << 16) + __uint_as_float(x.y & 0xffff0000u))
                        + (__uint_as_float(x.z << 16) + __uint_as_float(x.z & 0xffff0000u)) + (__uint_as_float(x.w << 16) + __uint_as_float(x.w & 0xffff0000u)); }
                sc_n[tid] = decay * sc_n[tid] + sm; }
        }
        __syncthreads();
    }
#undef MB_LOAD
}

constexpr int SP_P = 144;
constexpr int SO_BS = 0, SO_CS = 9216, SO_BT = 18432, SO_HD = 27648, SO_HSTRIDE = 36864, SO_SP = 0, SO_XT = 9216, SO_XW = 18432, SO_HB = 27648, SO_SC = 101376, SO_CW = 103488;
static_assert(SO_CW + 4096 <= RING_BYTES, "SSD LDS map");
__device__ __forceinline__ void ssd_block_unit(Frame& F, int L, int d, int unit) {
    const int hp = unit & 3, b = unit >> 2, g = hp >> 1, tid = F.tid, lane = F.lane, w = F.wave, fr = lane & 15, fq = lane >> 4;
    const bf16* U = (const bf16*)(F.ws + WS_B); const float* GATES = (const float*)(F.ws + WS_GATES); bf16* Y = (bf16*)(F.ws + WS_A);
    LAS unsigned char* lds = F.lds + RING_OFF;
    LAS float* scb = (LAS float*)(lds + SO_SC);
    LAS float* cwt = (LAS float*)(lds + SO_CW);
    typedef unsigned u32x2 __attribute__((ext_vector_type(2)));
    __syncthreads();
    if (tid < 256) { const int ch = tid < 128 ? (2 * hp) * 64 + tid : (tid < 192 ? 512 + g * 64 + (tid - 128) : 640 + g * 64 + (tid - 192));
        const float* cw = kin(I_CONVW) + (size_t)L * 3 * 768;
        cwt[tid * 4 + 0] = cw[ch]; cwt[tid * 4 + 1] = cw[768 + ch]; cwt[tid * 4 + 2] = cw[1536 + ch]; cwt[tid * 4 + 3] = kin(I_CONVB)[L * 768 + ch]; }
    for (int i = tid; i < 2 * 9216 / 16; i += NWAVES * 64) { const int hl = i / 576, o = i % 576; *(LAS v4u*)(lds + SO_HD + hl * SO_HSTRIDE + SO_HB + o * 16) = (v4u){0u, 0u, 0u, 0u}; }
    const int hl = w >> 2, wq = w & 3, head = 2 * hp + hl;
    const float a_neg = -expf(kin(I_ALOG)[L * 16 + d * 8 + head]);
    const float dsk = kin(I_SSDD)[L * 8 + head];
    f32x4 Hs[4];
#pragma unroll
    for (int j = 0; j < 4; ++j) Hs[j] = (f32x4){0.f, 0.f, 0.f, 0.f};
    const int tokq = tid >> 5, c8 = tid & 31;
    const int ucol = c8 < 16 ? UX + (2 * hp) * 64 + 8 * c8 : (c8 < 24 ? UB + g * 64 + 8 * (c8 - 16) : UC + g * 64 + 8 * (c8 - 24));
    v4u raw[6]; float gdt = 0.f;
#define SB_LOAD(c_) do { const int s0_ = (c_) * 64; const bool cx_ = s0_ < LC; const int seglen_ = cx_ ? LC : TL; const int tf_ = cx_ ? s0_ : s0_ - LC; const int tlo_ = d ? seglen_ - 64 - tf_ : tf_; \
        const size_t rb0_ = cx_ ? (size_t)(ML + b * LC) : (size_t)(b * TL); \
        _Pragma("unroll") for (int r_ = 0; r_ < 6; ++r_) { const int t_ = tlo_ + 4 * tokq - 1 + r_; const bool ok_ = t_ >= 0 && t_ < seglen_; \
            raw[r_] = ok_ ? *(const v4u*)(U + (rb0_ + t_) * NU + ucol) : (v4u){0u, 0u, 0u, 0u}; } \
        if (w < 2) { const int r2_ = scan_row(s0_ + lane, d, b); gdt = GATES[(size_t)r2_ * 32 + 16 + d * 8 + 2 * hp + w]; } } while (0)
    SB_LOAD(0);
    __syncthreads();
    for (int c = 0; c < (LC + TL) / 64; ++c) {
        const bool need_out = (c >= LC / 64) || (L == 0);
        if (w < 2) {
            const float a_w = -expf(kin(I_ALOG)[L * 16 + d * 8 + 2 * hp + w]);
            float ac = gdt * a_w;
#pragma unroll
            for (int o = 1; o < 64; o <<= 1) { const float t_ = __shfl_up(ac, o); if (lane >= o) ac += t_; }
            const float aend = __shfl(ac, 63);
            LAS float* sb = scb + w * 256;
            sb[lane] = ac; sb[64 + lane] = gdt; sb[128 + lane] = __expf(aend - ac) * gdt; sb[192 + lane] = __expf(ac);
            if (lane == 0) scb[512 + w] = __expf(aend);
        }
        __syncthreads();
        {
            float val[4][8];
#pragma unroll
            for (int e = 0; e < 8; ++e) { const f32x4 cw = *(const LAS f32x4*)(cwt + (8 * c8 + e) * 4);
                float rv[6];
#pragma unroll
                for (int r_ = 0; r_ < 6; ++r_) { const unsigned x = (e < 2) ? raw[r_].x : (e < 4 ? raw[r_].y : (e < 6 ? raw[r_].z : raw[r_].w)); rv[r_] = (e & 1) ? __uint_as_float(x & 0xffff0000u) : __uint_as_float(x << 16); }
#pragma unroll
                for (int jj = 0; jj < 4; ++jj) { float v = cw[0] * rv[jj] + cw[1] * rv[jj + 1] + cw[2] * rv[jj + 2] + cw[3]; val[jj][e] = v / (1.f + __expf(-v)); } }
            const int i0 = d ? 60 - 4 * tokq : 4 * tokq;
            if (c8 < 16) {
                const int hx = c8 >> 3, p0 = 8 * (c8 & 7);
                LAS unsigned char* hb = lds + SO_HD + hx * SO_HSTRIDE; const LAS float* wv = scb + hx * 256 + 128;
                const float w0 = wv[i0], w1 = wv[i0 + 1], w2 = wv[i0 + 2], w3 = wv[i0 + 3];
#pragma unroll
                for (int e = 0; e < 8; ++e) { const float x0 = val[d ? 3 : 0][e], x1 = val[d ? 2 : 1][e], x2 = val[d ? 1 : 2][e], x3 = val[d ? 0 : 3][e];
                    u32x2 o; o.x = pk2(x0, x1); o.y = pk2(x2, x3); *(LAS u32x2*)(hb + SO_XT + (p0 + e) * SP_P + i0 * 2) = o;
                    u32x2 q; q.x = pk2(x0 * w0, x1 * w1); q.y = pk2(x2 * w2, x3 * w3); *(LAS u32x2*)(hb + SO_XW + (p0 + e) * SP_P + i0 * 2) = q; }
            } else if (c8 < 24) {
                const int n0 = 8 * (c8 - 16);
#pragma unroll
                for (int q = 0; q < 4; ++q) { const int jj = d ? 3 - q : q; v4u o; o.x = pk2(val[jj][0], val[jj][1]); o.y = pk2(val[jj][2], val[jj][3]); o.z = pk2(val[jj][4], val[jj][5]); o.w = pk2(val[jj][6], val[jj][7]);
                    *(LAS v4u*)(lds + SO_BS + (i0 + q) * SP_P + n0 * 2) = o; }
#pragma unroll
                for (int e = 0; e < 8; ++e) { u32x2 o; o.x = pk2(val[d ? 3 : 0][e], val[d ? 2 : 1][e]); o.y = pk2(val[d ? 1 : 2][e], val[d ? 0 : 3][e]);
                    *(LAS u32x2*)(lds + SO_BT + (n0 + e) * SP_P + i0 * 2) = o; }
            } else {
                const int n0 = 8 * (c8 - 24);
#pragma unroll
                for (int q = 0; q < 4; ++q) { const int jj = d ? 3 - q : q; v4u o; o.x = pk2(val[jj][0], val[jj][1]); o.y = pk2(val[jj][2], val[jj][3]); o.z = pk2(val[jj][4], val[jj][5]); o.w = pk2(val[jj][6], val[jj][7]);
                    *(LAS v4u*)(lds + SO_CS + (i0 + q) * SP_P + n0 * 2) = o; }
            }
        }
        if (c + 1 < (LC + TL) / 64) SB_LOAD(c + 1);
        __syncthreads();
        if (need_out) {
            const int ms = w >> 1, nt0 = 2 * (w & 1);
            f32x4 acc[2] = {(f32x4){0.f, 0.f, 0.f, 0.f}, (f32x4){0.f, 0.f, 0.f, 0.f}};
#pragma unroll
            for (int kk2 = 0; kk2 < 2; ++kk2) {
                const bf16x8 af = *(const LAS bf16x8*)(lds + SO_BS + (16 * ms + fr) * SP_P + (32 * kk2 + 8 * fq) * 2);
#pragma unroll
                for (int j = 0; j < 2; ++j) { const bf16x8 bfv = *(const LAS bf16x8*)(lds + SO_CS + (16 * (nt0 + j) + fr) * SP_P + (32 * kk2 + 8 * fq) * 2);
                    acc[j] = __builtin_amdgcn_mfma_f32_16x16x32_bf16(af, bfv, acc[j], 0, 0, 0); }
            }
            const int s0 = 16 * ms + 4 * fq;
#pragma unroll
            for (int hx = 0; hx < 2; ++hx) { const LAS float* sb = scb + hx * 256;
                const f32x4 as = *(const LAS f32x4*)(sb + s0), ds = *(const LAS f32x4*)(sb + 64 + s0);
#pragma unroll
                for (int j = 0; j < 2; ++j) { const int t = 16 * (nt0 + j) + fr; const float at = sb[t];
                    float v0 = (s0 + 0 <= t) ? acc[j][0] * __expf(at - as[0]) * ds[0] : 0.f, v1 = (s0 + 1 <= t) ? acc[j][1] * __expf(at - as[1]) * ds[1] : 0.f;
                    float v2 = (s0 + 2 <= t) ? acc[j][2] * __expf(at - as[2]) * ds[2] : 0.f, v3 = (s0 + 3 <= t) ? acc[j][3] * __expf(at - as[3]) * ds[3] : 0.f;
                    u32x2 o; o.x = pk2(v0, v1); o.y = pk2(v2, v3);
                    *(LAS u32x2*)(lds + SO_HD + hx * SO_HSTRIDE + SO_SP + t * SP_P + s0 * 2) = o; } }
        }
        __syncthreads();
        if (need_out) {
            LAS unsigned char* hb = lds + SO_HD + hl * SO_HSTRIDE; const LAS float* sb = scb + hl * 256;
            f32x4 a1[4], a2[4];
#pragma unroll
            for (int j = 0; j < 4; ++j) { a1[j] = (f32x4){0.f, 0.f, 0.f, 0.f}; a2[j] = (f32x4){0.f, 0.f, 0.f, 0.f}; }
#pragma unroll
            for (int kk2 = 0; kk2 < 2; ++kk2) {
                const bf16x8 ax = *(const LAS bf16x8*)(hb + SO_XT + (16 * wq + fr) * SP_P + (32 * kk2 + 8 * fq) * 2);
                const bf16x8 ah = *(const LAS bf16x8*)(hb + SO_HB + (16 * wq + fr) * SP_P + (32 * kk2 + 8 * fq) * 2);
#pragma unroll
                for (int j = 0; j < 4; ++j) { const bf16x8 bs = *(const LAS bf16x8*)(hb + SO_SP + (16 * j + fr) * SP_P + (32 * kk2 + 8 * fq) * 2);
                    const bf16x8 bc = *(const LAS bf16x8*)(lds + SO_CS + (16 * j + fr) * SP_P + (32 * kk2 + 8 * fq) * 2);
                    a1[j] = __builtin_amdgcn_mfma_f32_16x16x32_bf16(ax, bs, a1[j], 0, 0, 0);
                    a2[j] = __builtin_amdgcn_mfma_f32_16x16x32_bf16(ah, bc, a2[j], 0, 0, 0); }
            }
#pragma unroll
            for (int j = 0; j < 4; ++j) { const int t = 16 * j + fr; const float et = sb[192 + t];
                const int row = scan_row(c * 64 + t, d, b); const int p0 = 16 * wq + 4 * fq;
                bf16* yp = Y + (size_t)row * NY + 512 + head * 64 + p0;
                float y0 = a1[j][0] + et * a2[j][0], y1 = a1[j][1] + et * a2[j][1], y2 = a1[j][2] + et * a2[j][2], y3 = a1[j][3] + et * a2[j][3];
                if (d == 1) { const u32x2 old = *(const u32x2*)yp; const LAS unsigned short* xp = (const LAS unsigned short*)(hb + SO_XT + p0 * SP_P + t * 2);
                    y0 += __uint_as_float(old.x << 16) + dsk * bf2f(xp[0]); y1 += __uint_as_float(old.x & 0xffff0000u) + dsk * bf2f(xp[SP_P / 2]);
                    y2 += __uint_as_float(old.y << 16) + dsk * bf2f(xp[2 * (SP_P / 2)]); y3 += __uint_as_float(old.y & 0xffff0000u) + dsk * bf2f(xp[3 * (SP_P / 2)]); }
                u32x2 o; o.x = pk2(y0, y1); o.y = pk2(y2, y3); *(u32x2*)yp = o; }
        }
        __syncthreads();
        {
            LAS unsigned char* hb = lds + SO_HD + hl * SO_HSTRIDE; const float dA = scb[512 + hl];
#pragma unroll
            for (int j = 0; j < 4; ++j) Hs[j] = Hs[j] * dA;
#pragma unroll
            for (int kk2 = 0; kk2 < 2; ++kk2) {
                const bf16x8 af = *(const LAS bf16x8*)(lds + SO_BT + (16 * wq + fr) * SP_P + (32 * kk2 + 8 * fq) * 2);
#pragma unroll
                for (int j = 0; j < 4; ++j) { const bf16x8 bfv = *(const LAS bf16x8*)(hb + SO_XW + (16 * j + fr) * SP_P + (32 * kk2 + 8 * fq) * 2);
                    Hs[j] = __builtin_amdgcn_mfma_f32_16x16x32_bf16(af, bfv, Hs[j], 0, 0, 0); }
            }
#pragma unroll
            for (int j = 0; j < 4; ++j) { u32x2 o; o.x = pk2(Hs[j][0], Hs[j][1]); o.y = pk2(Hs[j][2], Hs[j][3]);
                *(LAS u32x2*)(hb + SO_HB + (16 * j + fr) * SP_P + (16 * wq + 4 * fq) * 2) = o; }
        }
        __syncthreads();
    }
#undef SB_LOAD
    (void)a_neg;
}

__device__ __forceinline__ void ssd_unit(Frame& F, int L, int d, int unit) {
    const int h = unit & 7, b = unit >> 3, g = h >> 2, lane = F.lane;
    const bf16* U = (const bf16*)(F.ws + WS_B); const float* GATES = (const float*)(F.ws + WS_GATES); bf16* Y = (bf16*)(F.ws + WS_A);
    LAS float* buf = (LAS float*)(F.lds + RING_OFF + F.wave * 16384);
    constexpr int ST = 200;
    const int cx = h * 64 + lane, cb = 512 + g * 64 + lane, cc = 640 + g * 64 + lane;
    const float* cw = kin(I_CONVW) + (size_t)L * 3 * 768; const float* cbias = kin(I_CONVB) + (size_t)L * 768;
    const float wx0 = cw[cx], wx1 = cw[768 + cx], wx2 = cw[1536 + cx], bx = cbias[cx];
    const float wb0 = cw[cb], wb1 = cw[768 + cb], wb2 = cw[1536 + cb], bb = cbias[cb];
    const float wc0 = cw[cc], wc1 = cw[768 + cc], wc2 = cw[1536 + cc], bc = cbias[cc];
    const float a_neg = -expf(kin(I_ALOG)[L * 16 + d * 8 + h]);
    const float dsk = kin(I_SSDD)[L * 8 + h];
    float hs[64];
#pragma unroll
    for (int i = 0; i < 64; ++i) hs[i] = 0.f;
    unsigned short rx[10], rb[10], rc[10]; float pdt[8];
#define SSD_LOAD(nb_) do { const int s0_ = (nb_) * 8; const bool cx_ = s0_ < LC; const int seglen_ = cx_ ? LC : TL; int tf_ = cx_ ? s0_ : s0_ - LC; const int tlo_ = d ? seglen_ - 8 - tf_ : tf_; \
        const size_t rb0_ = cx_ ? (size_t)(ML + b * LC) : (size_t)(b * TL); \
        _Pragma("unroll") for (int i = 0; i < 10; ++i) { const int t_ = tlo_ - 1 + i; const bool ok_ = t_ >= 0 && t_ < seglen_; const bf16* ur_ = U + (rb0_ + (ok_ ? t_ : 0)) * NU + UX; \
            rx[i] = ok_ ? ur_[cx] : (unsigned short)0; rb[i] = ok_ ? ur_[cb] : (unsigned short)0; rc[i] = ok_ ? ur_[cc] : (unsigned short)0; } \
        _Pragma("unroll") for (int i = 0; i < 8; ++i) { const int r_ = scan_row(s0_ + i, d, b); pdt[i] = GATES[(size_t)r_ * 32 + 16 + d * 8 + h]; } } while (0)
    SSD_LOAD(0);
    for (int nb = 0; nb < (LC + TL) / 8; ++nb) {
#pragma unroll
        for (int i = 0; i < 8; ++i) { const int j = d ? 7 - i : i;
            LAS float* sl = buf + i * ST;
            float xv = wx0 * bf2f(rx[j]) + wx1 * bf2f(rx[j + 1]) + wx2 * bf2f(rx[j + 2]) + bx; xv = xv / (1.f + __expf(-xv));
            float bv = wb0 * bf2f(rb[j]) + wb1 * bf2f(rb[j + 1]) + wb2 * bf2f(rb[j + 2]) + bb; bv = bv / (1.f + __expf(-bv));
            float cv = wc0 * bf2f(rc[j]) + wc1 * bf2f(rc[j + 1]) + wc2 * bf2f(rc[j + 2]) + bc; cv = cv / (1.f + __expf(-cv));
            sl[lane] = bv; sl[64 + lane] = cv; sl[128 + lane] = xv; if (lane == 0) sl[192] = pdt[i]; }
        if (nb + 1 < (LC + TL) / 8) SSD_LOAD(nb + 1);
#pragma unroll 1
        for (int i = 0; i < 8; ++i) { const LAS float* sl = buf + i * ST;
            const float dt = sl[192], xv = sl[128 + lane], dA = __expf(dt * a_neg), dbx = dt * xv; float y = 0.f;
#pragma unroll
            for (int j = 0; j < 16; ++j) { const f32x4 Bv = *(const LAS f32x4*)(sl + 4 * j), Cv = *(const LAS f32x4*)(sl + 64 + 4 * j);
                hs[4 * j + 0] = dA * hs[4 * j + 0] + dbx * Bv.x; y += Cv.x * hs[4 * j + 0];
                hs[4 * j + 1] = dA * hs[4 * j + 1] + dbx * Bv.y; y += Cv.y * hs[4 * j + 1];
                hs[4 * j + 2] = dA * hs[4 * j + 2] + dbx * Bv.z; y += Cv.z * hs[4 * j + 2];
                hs[4 * j + 3] = dA * hs[4 * j + 3] + dbx * Bv.w; y += Cv.w * hs[4 * j + 3]; }
            const int s = nb * 8 + i;
            if (s >= LC || L == 0) { const int r = scan_row(s, d, b); bf16* yp = Y + (size_t)r * NY + 512 + h * 64 + lane;
                if (d == 0) *yp = f2bf_s(y); else *yp = f2bf_s(bf2f(*yp) + y + dsk * xv); }
        }
    }
#undef SSD_LOAD
}

typedef float f32x16 __attribute__((ext_vector_type(16)));
constexpr int AT_KP = 144, AT_VP = 136;
constexpr int AT_KB = 64 * AT_KP, AT_VB = 64 * AT_VP;
__device__ __forceinline__ void attn_block_unit(Frame& F, int L, int unit) {
    const bf16* U = (const bf16*)(F.ws + WS_B); bf16* Y = (bf16*)(F.ws + WS_A);
    const int tid = F.tid, lane = F.lane, w = F.wave, r = lane & 31, hf = lane >> 5;
    const bool lat = unit < 512;
    int b, g, qt;
    if (lat) { b = unit >> 6; g = (unit >> 5) & 1; qt = unit & 31; } else { const int u2 = unit - 512; b = u2 >> 3; g = (u2 >> 2) & 1; qt = u2 & 3; }
    const int t0 = qt * 64, hh = w >> 1, qh = w & 1, head = g * 4 + hh, t = t0 + 32 * qh + r;
    const size_t qrow = lat ? (size_t)(b * TL + t) : (size_t)(ML + b * LC + t);
    LAS unsigned char* Kt = F.lds + RING_OFF;
    LAS unsigned char* Vt = F.lds + RING_OFF + 2 * AT_KB;
    bf16x8 qf[4];
#pragma unroll
    for (int ks = 0; ks < 4; ++ks) qf[ks] = *(const bf16x8*)(U + qrow * NU + UAQ + head * 64 + 16 * ks + 8 * hf);
    const int rel_lo = lat ? (qt < 2 ? -qt : -2) : 0, rel_hi = lat ? (31 - qt < 2 ? 31 - qt : 2) : -1;
    const int ntiles = 4 + (rel_hi - rel_lo + 1);
    f32x16 o0, o1;
#pragma unroll
    for (int i = 0; i < 16; ++i) { o0[i] = 0.f; o1[i] = 0.f; }
    float mrun = kin(I_SINK)[L * 8 + head] * 1.4426950408889634f, lrun = (hf == 0) ? 1.f : 0.f;
    const int skk = tid >> 3, sc8 = tid & 7;
    v4u pk, pv;
#define AT_LOAD(i_) do { const int i__ = (i_); const size_t base_ = (i__ < 4) ? (size_t)(ML + b * LC + 64 * i__) : (size_t)(b * TL + t0 + 64 * (rel_lo + i__ - 4)); \
        const bf16* kp_ = U + (base_ + skk) * NU + g * 64 + 8 * sc8; pk = *(const v4u*)(kp_ + UAK); pv = *(const v4u*)(kp_ + UAV); } while (0)
#define AT_STORE(buf_) do { *(LAS v4u*)(Kt + (buf_) * AT_KB + skk * AT_KP + sc8 * 16) = pk; LAS unsigned short* vb_ = (LAS unsigned short*)(Vt + (buf_) * AT_VB + (8 * sc8) * AT_VP + skk * 2); \
        vb_[0 * (AT_VP / 2)] = (unsigned short)(pv.x & 0xffffu); vb_[1 * (AT_VP / 2)] = (unsigned short)(pv.x >> 16); vb_[2 * (AT_VP / 2)] = (unsigned short)(pv.y & 0xffffu); vb_[3 * (AT_VP / 2)] = (unsigned short)(pv.y >> 16); \
        vb_[4 * (AT_VP / 2)] = (unsigned short)(pv.z & 0xffffu); vb_[5 * (AT_VP / 2)] = (unsigned short)(pv.z >> 16); vb_[6 * (AT_VP / 2)] = (unsigned short)(pv.w & 0xffffu); vb_[7 * (AT_VP / 2)] = (unsigned short)(pv.w >> 16); } while (0)
    __syncthreads();
    AT_LOAD(0); AT_STORE(0);
    __syncthreads();
    for (int i = 0; i < ntiles; ++i) {
        const int buf = i & 1;
        if (i + 1 < ntiles) AT_LOAD(i + 1);
        const LAS unsigned char* kb = Kt + buf * AT_KB; const LAS unsigned char* vb = Vt + buf * AT_VB;
        f32x16 s0, s1;
#pragma unroll
        for (int e = 0; e < 16; ++e) { s0[e] = 0.f; s1[e] = 0.f; }
#pragma unroll
        for (int ks = 0; ks < 4; ++ks) {
            const bf16x8 k0 = *(const LAS bf16x8*)(kb + r * AT_KP + (16 * ks + 8 * hf) * 2), k1 = *(const LAS bf16x8*)(kb + (32 + r) * AT_KP + (16 * ks + 8 * hf) * 2);
            s0 = __builtin_amdgcn_mfma_f32_32x32x16_bf16(k0, qf[ks], s0, 0, 0, 0);
            s1 = __builtin_amdgcn_mfma_f32_32x32x16_bf16(k1, qf[ks], s1, 0, 0, 0);
        }
        if (i >= 4) { const int rel = rel_lo + i - 4;
            if (rel == 2 || rel == -2) { const int dbase = 64 * rel - 32 * qh - r + 4 * hf;
#pragma unroll
                for (int e = 0; e < 16; ++e) { const int d0 = dbase + (e & 3) + 8 * (e >> 2), d1 = d0 + 32;
                    if (d0 > 128 || d0 < -128) s0[e] = -INFINITY; if (d1 > 128 || d1 < -128) s1[e] = -INFINITY; } } }
        float tm = s0[0];
#pragma unroll
        for (int e = 1; e < 16; ++e) tm = fmaxf(tm, s0[e]);
#pragma unroll
        for (int e = 0; e < 16; ++e) tm = fmaxf(tm, s1[e]);
        tm = fmaxf(tm, __shfl_xor(tm, 32));
        const float mn = fmaxf(mrun, tm), al = __builtin_amdgcn_exp2f(mrun - mn); mrun = mn;
        float ps = 0.f;
#pragma unroll
        for (int e = 0; e < 16; ++e) { s0[e] = __builtin_amdgcn_exp2f(s0[e] - mn); s1[e] = __builtin_amdgcn_exp2f(s1[e] - mn); ps += s0[e] + s1[e]; }
        lrun = lrun * al + ps;
#pragma unroll
        for (int e = 0; e < 16; ++e) { o0[e] *= al; o1[e] *= al; }
        bf16x8 pf[4];
#pragma unroll
        for (int s2 = 0; s2 < 2; ++s2) {
            unsigned a0 = pk2(s0[8 * s2 + 0], s0[8 * s2 + 1]), a1 = pk2(s0[8 * s2 + 2], s0[8 * s2 + 3]), a2 = pk2(s0[8 * s2 + 4], s0[8 * s2 + 5]), a3 = pk2(s0[8 * s2 + 6], s0[8 * s2 + 7]);
            unsigned c0 = pk2(s1[8 * s2 + 0], s1[8 * s2 + 1]), c1 = pk2(s1[8 * s2 + 2], s1[8 * s2 + 3]), c2 = pk2(s1[8 * s2 + 4], s1[8 * s2 + 5]), c3 = pk2(s1[8 * s2 + 6], s1[8 * s2 + 7]);
            v4u x; x.x = a0; x.y = a1; x.z = a2; x.w = a3; pf[s2] = __builtin_bit_cast(bf16x8, x);
            v4u y; y.x = c0; y.y = c1; y.z = c2; y.w = c3; pf[2 + s2] = __builtin_bit_cast(bf16x8, y);
        }
#pragma unroll
        for (int ks = 0; ks < 4; ++ks) {
            const int kofs = (16 * ks + 4 * hf) * 2;
            typedef unsigned u32x2 __attribute__((ext_vector_type(2)));
            const u32x2 a_lo0 = *(const LAS u32x2*)(vb + r * AT_VP + kofs), a_hi0 = *(const LAS u32x2*)(vb + r * AT_VP + kofs + 16);
            const u32x2 a_lo1 = *(const LAS u32x2*)(vb + (32 + r) * AT_VP + kofs), a_hi1 = *(const LAS u32x2*)(vb + (32 + r) * AT_VP + kofs + 16);
            v4u va; va.x = a_lo0.x; va.y = a_lo0.y; va.z = a_hi0.x; va.w = a_hi0.y;
            v4u vc; vc.x = a_lo1.x; vc.y = a_lo1.y; vc.z = a_hi1.x; vc.w = a_hi1.y;
            o0 = __builtin_amdgcn_mfma_f32_32x32x16_bf16(__builtin_bit_cast(bf16x8, va), pf[ks], o0, 0, 0, 0);
            o1 = __builtin_amdgcn_mfma_f32_32x32x16_bf16(__builtin_bit_cast(bf16x8, vc), pf[ks], o1, 0, 0, 0);
        }
        if (i + 1 < ntiles) AT_STORE(buf ^ 1);
        __syncthreads();
    }
#undef AT_LOAD
#undef AT_STORE
    const float il = 1.f / (lrun + __shfl_xor(lrun, 32));
    bf16* yp = Y + qrow * NY + 1024 + head * 64 + 4 * hf;
    typedef unsigned u32x2s __attribute__((ext_vector_type(2)));
#pragma unroll
    for (int gq = 0; gq < 4; ++gq) {
        u32x2s w0; w0.x = pk2(o0[4 * gq] * il, o0[4 * gq + 1] * il); w0.y = pk2(o0[4 * gq + 2] * il, o0[4 * gq + 3] * il);
        u32x2s w1; w1.x = pk2(o1[4 * gq] * il, o1[4 * gq + 1] * il); w1.y = pk2(o1[4 * gq + 2] * il, o1[4 * gq + 3] * il);
        *(u32x2s*)(yp + 8 * gq) = w0; *(u32x2s*)(yp + 32 + 8 * gq) = w1;
    }
}

__device__ __forceinline__ void phase_finish(Frame& F, int L) {
    const bf16* U = (const bf16*)(F.ws + WS_B); bf16* Y = (bf16*)(F.ws + WS_A);
    const int gw = blockIdx.x * NWAVES + F.wave, NGW = F.G * NWAVES, lane = F.lane, nrows = (L == 0) ? MT : ML;
    float g1[8], g2[8];
#pragma unroll
    for (int j = 0; j < 8; ++j) { g1[j] = kin(I_MLNG)[L * 512 + 8 * lane + j]; g2[j] = kin(I_SSDNG)[L * 512 + 8 * lane + j]; }
    for (int r = gw; r < nrows; r += NGW) {
        bf16* yr = Y + (size_t)r * NY; const bf16* ur = U + (size_t)r * NU;
        { const v4u hw = *(const v4u*)(yr + 8 * lane), ow = *(const v4u*)(ur + UO + 8 * lane);
          float hv[8], ov[8];
          hv[0] = __uint_as_float(hw.x << 16); hv[1] = __uint_as_float(hw.x & 0xffff0000u); hv[2] = __uint_as_float(hw.y << 16); hv[3] = __uint_as_float(hw.y & 0xffff0000u);
          hv[4] = __uint_as_float(hw.z << 16); hv[5] = __uint_as_float(hw.z & 0xffff0000u); hv[6] = __uint_as_float(hw.w << 16); hv[7] = __uint_as_float(hw.w & 0xffff0000u);
          ov[0] = __uint_as_float(ow.x << 16); ov[1] = __uint_as_float(ow.x & 0xffff0000u); ov[2] = __uint_as_float(ow.y << 16); ov[3] = __uint_as_float(ow.y & 0xffff0000u);
          ov[4] = __uint_as_float(ow.z << 16); ov[5] = __uint_as_float(ow.z & 0xffff0000u); ov[6] = __uint_as_float(ow.w << 16); ov[7] = __uint_as_float(ow.w & 0xffff0000u);
          float ss = 0.f;
#pragma unroll
          for (int j = 0; j < 8; ++j) ss += hv[j] * hv[j];
#pragma unroll
          for (int o = 1; o < 16; o <<= 1) ss += __shfl_xor(ss, o);
          const float rs = 1.0f / sqrtf(ss * (1.f / 128.f) + EPS);
          float rv[8];
#pragma unroll
          for (int j = 0; j < 8; ++j) rv[j] = hv[j] * rs * g1[j] / (1.f + __expf(-ov[j]));
          v4u w; w.x = pk2(rv[0], rv[1]); w.y = pk2(rv[2], rv[3]); w.z = pk2(rv[4], rv[5]); w.w = pk2(rv[6], rv[7]);
          *(v4u*)(yr + 8 * lane) = w; }
        { const v4u hw = *(const v4u*)(yr + 512 + 8 * lane), zw = *(const v4u*)(ur + UZ + 8 * lane);
          float hv[8], zv[8];
          hv[0] = __uint_as_float(hw.x << 16); hv[1] = __uint_as_float(hw.x & 0xffff0000u); hv[2] = __uint_as_float(hw.y << 16); hv[3] = __uint_as_float(hw.y & 0xffff0000u);
          hv[4] = __uint_as_float(hw.z << 16); hv[5] = __uint_as_float(hw.z & 0xffff0000u); hv[6] = __uint_as_float(hw.w << 16); hv[7] = __uint_as_float(hw.w & 0xffff0000u);
          zv[0] = __uint_as_float(zw.x << 16); zv[1] = __uint_as_float(zw.x & 0xffff0000u); zv[2] = __uint_as_float(zw.y << 16); zv[3] = __uint_as_float(zw.y & 0xffff0000u);
          zv[4] = __uint_as_float(zw.z << 16); zv[5] = __uint_as_float(zw.z & 0xffff0000u); zv[6] = __uint_as_float(zw.w << 16); zv[7] = __uint_as_float(zw.w & 0xffff0000u);
          float ss = 0.f;
#pragma unroll
          for (int j = 0; j < 8; ++j) { hv[j] = hv[j] * zv[j] / (1.f + __expf(-zv[j])); ss += hv[j] * hv[j]; }
          ss = wave_sum(ss);
          const float rs = 1.0f / sqrtf(ss * (1.f / 512.f) + EPS);
          v4u w; w.x = pk2(hv[0] * rs * g2[0], hv[1] * rs * g2[1]); w.y = pk2(hv[2] * rs * g2[2], hv[3] * rs * g2[3]); w.z = pk2(hv[4] * rs * g2[4], hv[5] * rs * g2[5]); w.w = pk2(hv[6] * rs * g2[6], hv[7] * rs * g2[7]);
          *(v4u*)(yr + 512 + 8 * lane) = w; }
    }
}

#ifdef NO_MLSTM
#define MLSTM_CALL(d)
#else
#define MLSTM_CALL(d) if (u < 128) mlstm_unit(F, L, d, u);
#endif
#ifdef NO_MLSTMB
#define MLSTMB_CALL(d, u)
#else
#define MLSTMB_CALL(d, u) mlstm_block_unit(F, L, d, u);
#endif
#ifdef NO_SSDB
#define SSDB_CALL(d, u)
#else
#define SSDB_CALL(d, u) ssd_block_unit(F, L, d, u);
#endif
#ifdef NO_SSD
#define SSD_CALL(d)
#else
#define SSD_CALL(d) if (u >= 128) ssd_unit(F, L, d, u - 128);
#endif
#ifdef NO_ATTN
#define ATTN_CALL ;
#else
#define ATTN_CALL attn_block_unit(F, L, u);
#endif
struct Args { const float* in[24]; float* out; unsigned char* ws; int ph_lo, ph_hi; };
__global__ void __launch_bounds__(NWAVES * 64, 2) mk_fwd(Args args) {
    extern __shared__ __attribute__((aligned(16))) unsigned char lds[];
    Frame F;
    F.lds = (LAS unsigned char*)lds;
    F.MISC = (volatile LAS unsigned*)(F.lds + MISC_OFF);
    F.tid = threadIdx.x; F.lane = F.tid & 63; F.wave = __builtin_amdgcn_readfirstlane(F.tid >> 6);
    F.G = gridDim.x;
    F.ws = args.ws; F.out = args.out; F.ctl = (gu32*)(args.ws + WS_CTL);
    for (int u = F.tid; u < (LDS_BYTES - LDSCTL_OFF) / 4; u += NWAVES * 64) ((LAS unsigned*)(F.lds + LDSCTL_OFF))[u] = 0u;
    __syncthreads();
    const int lo = args.ph_lo, hi = args.ph_hi;
    const bool use_bar = (hi - lo) > 1;
    XcdBarrier bar; bar.bar = (unsigned*)(F.ctl + CW_BAR); bar.x = 0; bar.st = nullptr;
    if (use_bar) bar = xcd_barrier_post((unsigned*)(F.ctl + CW_BAR), F.MISC + 8);
#define IN(k) (lo <= (k) && (k) < hi)
#define XL ((L == 0) ? kin(I_X) : (const float*)F.out)
#define XC ((L == 0) ? kin(I_CTX) : (const float*)(F.ws + WS_CTXF))
#define SEAM(k) do { if (IN(k) && IN((k) + 1)) xcd_barrier(bar); asm volatile("" : "+v"(F.lane), "+v"(F.tid)); F.wave = __builtin_amdgcn_readfirstlane(F.tid >> 6); } while (0)

    bf16* W0 = (bf16*)(F.ws + WS_W0); bf16* W1 = (bf16*)(F.ws + WS_W1);
    bf16* RA = (bf16*)(F.ws + WS_A); bf16* RB = (bf16*)(F.ws + WS_B);
    float* CTXF = (float*)(F.ws + WS_CTXF);
    const float* MOD = (const float*)(F.ws + WS_MOD);

    #ifndef NO_MOD
    if (IN(0)) { phase_mod(F); }
#endif
    SEAM(0);

    for (int L = 0; L < 2; ++L) {
        const int p0 = 1 + 10 * L;
        const int Mout = (L == 0) ? MT : ML;
#ifndef NO_A
        if (IN(p0 + 0)) {
            convert_win(F, kin(I_WIN) + (size_t)L * DM * INW, W0);
            convert_weight(F, kin(I_WOUT) + (size_t)L * NY * DM, NY, DM, W1);
            __syncthreads();
            LAS float* gwl = (LAS float*)(F.lds + RING_OFF);
            const float* win = kin(I_WIN) + (size_t)L * DM * INW;
            for (int i = F.tid; i < 32 * 1024; i += NWAVES * 64) { const int j = i & 31, k = i >> 5; gwl[j * 1024 + k] = win[(size_t)k * INW + (j < 16 ? 2048 + j : 3344 + (j - 16))]; }
            __syncthreads();
            norm_rows<true>(F, L, MT, XL, XC, kin(I_N1G) + L * DM, 0, RA, gwl);
            __syncthreads();
        }
#endif
        SEAM(p0 + 0);
#ifndef NO_GB
        if (IN(p0 + 1)) {
            pg8::Gemm g{RA, W0, MT, NU, DM}; pg8::StaticOrder S; S.init(MT, NU, F.G, (int)blockIdx.x);
            pg8::EpiBf16<0> E{RB, NU};
            pg8::gemm_phase<pg8::EpiBf16<0>, pg8::StaticOrder, true, true>(F.lds + RING_OFF, g, S, E);
        }
#endif
        SEAM(p0 + 1);
#ifndef NO_KN
        if (IN(p0 + 2)) { phase_qkn(F, L); }
#endif
        SEAM(p0 + 2);
        if (IN(p0 + 3)) {
            if (blockIdx.x < 32) { MLSTMB_CALL(0, blockIdx.x) }
            else if (blockIdx.x < 64) { SSDB_CALL(0, blockIdx.x - 32) }
            else { const int nun = (L == 0) ? 576 : 512; for (int u = blockIdx.x - 64; u < nun; u += F.G - 64) { ATTN_CALL } }
            __syncthreads();
        }
        SEAM(p0 + 3);
        if (IN(p0 + 4)) {
            if (blockIdx.x < 32) { MLSTMB_CALL(1, blockIdx.x) }
            else if (blockIdx.x < 64) { SSDB_CALL(1, blockIdx.x - 32) }
            __syncthreads();
        }
        SEAM(p0 + 4);
#ifndef NO_FIN
        if (IN(p0 + 5)) { phase_finish(F, L); }
#endif
        SEAM(p0 + 5);
#ifndef NO_GD
        if (IN(p0 + 6)) {
            pg8::Gemm g{RA, W1, Mout, DM, NY}; pg8::StaticOrder S; S.init(Mout, DM, F.G, (int)blockIdx.x);
            pg8::EpiRes E{XL, F.out, XC, CTXF, MOD + (size_t)L * 9 * 6144 + 2 * 1024};
            pg8::gemm_phase<pg8::EpiRes, pg8::StaticOrder, true, true>(F.lds + RING_OFF, g, S, E);
        }
#endif
        SEAM(p0 + 6);
#ifndef NO_E
        if (IN(p0 + 7)) {
            convert_weight(F, kin(I_WUP) + (size_t)L * DM * DFF, DM, DFF, W0);
            convert_weight(F, kin(I_WDOWN) + (size_t)L * DFF * DM, DFF, DM, W1);
            norm_rows<false>(F, L, Mout, (const float*)F.out, (const float*)CTXF, kin(I_N2G) + L * DM, 3, RA, nullptr);
        }
#endif
        SEAM(p0 + 7);
#ifndef NO_GF
        if (IN(p0 + 8)) {
            pg8::Gemm g{RA, W0, Mout, DFF, DM}; pg8::StaticOrder S; S.init(Mout, DFF, F.G, (int)blockIdx.x);
            pg8::EpiBf16<2> E{RB, DFF};
            pg8::gemm_phase<pg8::EpiBf16<2>, pg8::StaticOrder, true, true>(F.lds + RING_OFF, g, S, E);
        }
#endif
        SEAM(p0 + 8);
#ifndef NO_GG
        if (IN(p0 + 9)) {
            pg8::Gemm g{RB, W1, Mout, DM, DFF}; pg8::StaticOrder S; S.init(Mout, DM, F.G, (int)blockIdx.x);
            pg8::EpiRes E{(const float*)F.out, F.out, (const float*)CTXF, CTXF, MOD + (size_t)L * 9 * 6144 + 5 * 1024};
            pg8::gemm_phase<pg8::EpiRes, pg8::StaticOrder, true, true>(F.lds + RING_OFF, g, S, E);
        }
#endif
        SEAM(p0 + 9);
    }
#undef IN
#undef SEAM
}

#ifndef MK_N_LAUNCHES
#define MK_N_LAUNCHES 1
#endif
extern "C" void kernel_launch(void* const* d_in, const int* in_sizes, int n_in, void* d_out, int out_size, void* d_ws, size_t ws_size, hipStream_t stream) {
    static int grid = 0;
    if (grid == 0) {
        if (n_in != 24 || out_size != ML * DM || ws_size < WS_END) { fprintf(stderr, "kernel_launch: unexpected shapes (n_in %d out %d ws %zu)\n", n_in, out_size, ws_size); grid = -1; return; }
        int dev = 0, cus = 0, per_cu = 0;
        if (hipGetDevice(&dev) != hipSuccess || hipDeviceGetAttribute(&cus, hipDeviceAttributeMultiprocessorCount, dev) != hipSuccess) { grid = -1; return; }
        if (hipFuncSetAttribute((const void*)mk_fwd, hipFuncAttributeMaxDynamicSharedMemorySize, LDS_BYTES) != hipSuccess) { fprintf(stderr, "kernel_launch: hipFuncSetAttribute failed\n"); grid = -1; return; }
        if (hipOccupancyMaxActiveBlocksPerMultiprocessor(&per_cu, (const void*)mk_fwd, NWAVES * 64, LDS_BYTES) != hipSuccess || per_cu < 1) fprintf(stderr, "kernel_launch: occupancy query reports %d\n", per_cu);
        (void)hipGetLastError();
        grid = cus;
    }
    if (grid < 0) return;
    if (hipMemsetAsync((char*)d_ws + WS_CTL, 0, CTL_ZERO_BYTES, stream) != hipSuccess) return;
    Args a{};
    for (int i = 0; i < 24; ++i) a.in[i] = (const float*)d_in[i];
    a.out = (float*)d_out; a.ws = (unsigned char*)d_ws;
    if (MK_N_LAUNCHES == 1) { a.ph_lo = 0; a.ph_hi = NPH; hipLaunchKernelGGL(mk_fwd, dim3(grid), dim3(NWAVES * 64), LDS_BYTES, stream, a); }
    else { for (int p = 0; p < NPH; ++p) { a.ph_lo = p; a.ph_hi = p + 1; hipLaunchKernelGGL(mk_fwd, dim3(grid), dim3(NWAVES * 64), LDS_BYTES, stream, a); } }
}
```

```cpp
#include <hip/hip_runtime.h>
#include <cstdio>
#include <cstdint>
#include <cmath>
namespace pg8 {
#define PG8_LAS __attribute__((address_space(3)))
typedef unsigned short bf16_t;
typedef short bf16x8 __attribute__((ext_vector_type(8)));
typedef float f32x4 __attribute__((ext_vector_type(4)));
typedef unsigned u32x4 __attribute__((ext_vector_type(4)));
constexpr int BM = 256, BK = 64, HALF = 128, HTB = HALF * BK * 2  , STAGE_BYTES = 8 * HTB, NXCD = 8, WGM = 8;

__host__ __device__ __forceinline__ int lds_byte(int r, int c) { const int st = (r >> 4) * 2 + (c >> 5), rr = r & 15, cc = c & 31, ob = rr * 64 + cc * 2; return st * 1024 + (ob ^ (((ob >> 9) & 1) << 5)); }
__host__ __device__ __forceinline__ void stage_rc(int b, int& R, int& C) { const int st = b / 1024, sb = b % 1024, swz = sb ^ (((sb >> 9) & 1) << 5); R = (st >> 1) * 16 + swz / 64; C = (st & 1) * 32 + (swz % 64) / 2; }
__host__ __device__ __forceinline__ int perm32(int rho) { const int n = rho >> 4, i = rho & 15; return 8 * (i >> 2) + 4 * n + (i & 3); }

struct Unit { int pm, pn; };
struct Gemm { const bf16_t* A; const bf16_t* Bt; int M, N, K; };

struct StaticOrder {
    int nM, nN, nwg, G, c;
    __host__ __device__ void init(int M, int N, int G_, int c_) { nM = M / BM; nN = N / BM; nwg = nM * nN; G = G_; c = c_; }
    __host__ __device__ bool next(int i, Unit& u) const {
        const long L = (long)i * G + c; if (L >= nwg) return false;
        int wgid = (int)L; { const int q = nwg / NXCD, r = nwg % NXCD, xcd = wgid % NXCD, off = wgid / NXCD; wgid = (xcd < r ? xcd * (q + 1) : r * (q + 1) + (xcd - r) * q) + off; }
        const int nig = WGM * nN, gid = wgid / nig, fm = gid * WGM, gsz = (nM - fm) < WGM ? (nM - fm) : WGM;
        u.pm = fm + ((wgid % nig) % gsz); u.pn = (wgid % nig) / gsz; return true;
    }
    __device__ __forceinline__ void a_ready(const Unit&) const {}
    __device__ __forceinline__ void done(const Unit&) const {}
};

__device__ __forceinline__ unsigned cvt_pk_bf16(float lo, float hi) { unsigned r; asm volatile("v_cvt_pk_bf16_f32 %0, %1, %2" : "=v"(r) : "v"(lo), "v"(hi)); return r; }
typedef float f32x2 __attribute__((ext_vector_type(2)));
__device__ __forceinline__ f32x2 gelu_pk(f32x2 v) {
    const f32x2 av = __builtin_elementwise_abs(v), d = av * 0.2316418882f + 1.0f;
    f32x2 t; t.x = __builtin_amdgcn_rcpf(d.x); t.y = __builtin_amdgcn_rcpf(d.y);
    f32x2 q = t * 0.5307027145f + (-0.7265760135f); q = q * t + 0.7107068705f; q = q * t + (-0.142248368f); q = q * t + 0.127414796f; q = q * t;
    const f32x2 s = (v * v) * (-0.72134752044f);
    f32x2 e; e.x = __builtin_amdgcn_exp2f(s.x); e.y = __builtin_amdgcn_exp2f(s.y);
    const f32x2 m = v * (q * e), r = v - m;
    f32x2 o; o.x = v.x < 0.f ? m.x : r.x; o.y = v.y < 0.f ? m.y : r.y; return o;
}

template <int ACT  > struct EpiBf16 {
    static constexpr bool PERM = true, AFTER_DRAIN = false;
    bf16_t* O; int ldc;
    __device__ __forceinline__ void operator()(const f32x4 (&acc)[2][2][4][2], const Unit& u, int wr, int wc, int fr, int fq) const {
        const int row0 = u.pm * BM + wr * 64 + fr; const int col0 = u.pn * BM + wc * 32 + 8 * fq;
#pragma unroll
        for (int ai = 0; ai < 2; ++ai)
#pragma unroll
            for (int m = 0; m < 4; ++m) { bf16_t* rowp = O + (size_t)(row0 + ai * HALF + m * 16) * ldc + col0;
#pragma unroll
                for (int bj = 0; bj < 2; ++bj) { f32x4 v0 = acc[ai][bj][m][0], v1 = acc[ai][bj][m][1];
                    if (ACT == 2) {
#pragma unroll
                        for (int e = 0; e < 4; ++e) { float a = v0[e] > 0.f ? v0[e] : 0.f; v0[e] = a * a; float b = v1[e] > 0.f ? v1[e] : 0.f; v1[e] = b * b; } }
                    u32x4 w; w.x = cvt_pk_bf16(v0[0], v0[1]); w.y = cvt_pk_bf16(v0[2], v0[3]); w.z = cvt_pk_bf16(v1[0], v1[1]); w.w = cvt_pk_bf16(v1[2], v1[3]);
                    *(u32x4*)(rowp + bj * HALF) = w; } }
    }
};
struct EpiRes {
    static constexpr bool PERM = false, AFTER_DRAIN = false;
    const float* base_l; float* out_l; const float* base_c; float* out_c; const float* gate;
    __device__ __forceinline__ void operator()(const f32x4 (&acc)[2][2][4][2], const Unit& u, int wr, int wc, int fr, int fq) const {
        const bool lat = u.pm < 64;
        const float* bs = lat ? base_l + (size_t)u.pm * BM * 1024 : base_c + (size_t)(u.pm - 64) * BM * 1024;
        float* ot = lat ? out_l + (size_t)u.pm * BM * 1024 : out_c + (size_t)(u.pm - 64) * BM * 1024;
        const float* gt = gate + (size_t)(lat ? (u.pm >> 3) : 8) * 6144;
        const int col0 = u.pn * BM + wc * 32 + 4 * fq;
        f32x4 gv[2][2];
#pragma unroll
        for (int bj = 0; bj < 2; ++bj)
#pragma unroll
            for (int n = 0; n < 2; ++n) gv[bj][n] = *(const f32x4*)(gt + col0 + bj * HALF + n * 16);
#pragma unroll
        for (int ai = 0; ai < 2; ++ai)
#pragma unroll
            for (int m = 0; m < 4; ++m) { const size_t off = (size_t)(ai * HALF + wr * 64 + m * 16 + fr) * 1024 + col0;
#pragma unroll
                for (int bj = 0; bj < 2; ++bj)
#pragma unroll
                    for (int n = 0; n < 2; ++n) { const f32x4 b = *(const f32x4*)(bs + off + bj * HALF + n * 16);
                        *(f32x4*)(ot + off + bj * HALF + n * 16) = b + gv[bj][n] * acc[ai][bj][m][n]; }
                if (m & 1) asm volatile("" ::: "memory"); }
    }
};

template <class Epi, class Sched, bool ALIGN_EPI = false, bool SP2 = false>
__device__ __forceinline__ void gemm_phase(PG8_LAS unsigned char* lds, const Gemm g, const Sched& S, const Epi& E) {
    int tid_l = threadIdx.x; asm volatile("" : "+v"(tid_l));
    const int tid = tid_l, wid = __builtin_amdgcn_readfirstlane(tid >> 6), lane = tid & 63, wr = wid >> 2, wc = wid & 3, fr = lane & 15, fq = lane >> 4;
    const int K = g.K, nt = K / BK;
    unsigned voffA[2], voffB[2];
#pragma unroll
    for (int i = 0; i < 2; ++i) { int R, C; stage_rc(tid * 16 + i * 8192, R, C); const int Rb = Epi::PERM ? ((R & ~31) + perm32(R & 31)) : R;
        voffA[i] = (unsigned)(R * K + C) * 2u; voffB[i] = (unsigned)(Rb * K + C) * 2u; }
    const size_t kstep = (size_t)(BK * 2);
    const size_t hstep = (size_t)HALF * K * 2;
    const size_t tstep = 2 * hstep;
    const unsigned ldsw = (unsigned)wid * 1024u;
    const int aoff = lds_byte(wr * 64 + fr, fq * 8), boff = lds_byte(wc * 32 + fr, fq * 8);
#define PG8_SA(b, h) (((b) * 2 + (h)) * HTB)
#define PG8_SB(b, h) ((4 + (b) * 2 + (h)) * HTB)
#define PG8_STAGE(bufoff, gbase, voff) do { _Pragma("unroll") for (int _i = 0; _i < 2; ++_i) \
        __builtin_amdgcn_global_load_lds((const unsigned*)((const char*)(gbase) + (voff)[_i]), (PG8_LAS unsigned*)(lds + (bufoff) + ldsw + _i * 8192), 16, 0, 0); } while (0)
#define PG8_LDA(dst, b, h) do { _Pragma("unroll") for (int m = 0; m < 4; ++m) _Pragma("unroll") for (int k = 0; k < 2; ++k) dst[m][k] = *(const PG8_LAS bf16x8*)(lds + PG8_SA(b, h) + aoff + m * 2048 + k * 1024); } while (0)
#define PG8_LDB(dst, b, h) do { _Pragma("unroll") for (int n = 0; n < 2; ++n) _Pragma("unroll") for (int k = 0; k < 2; ++k) dst[n][k] = *(const PG8_LAS bf16x8*)(lds + PG8_SB(b, h) + boff + n * 2048 + k * 1024); } while (0)
#define PG8_MMA(ai, bj, At, Bt) do { __builtin_amdgcn_s_setprio(1); _Pragma("unroll") for (int m = 0; m < 4; ++m) _Pragma("unroll") for (int n = 0; n < 2; ++n) _Pragma("unroll") for (int k = 0; k < 2; ++k) \
        acc[ai][bj][m][n] = __builtin_amdgcn_mfma_f32_16x16x32_bf16(Bt[n][k], At[m][k], acc[ai][bj][m][n], 0, 0, 0); __builtin_amdgcn_s_setprio(0); } while (0)
#define PG8_WAIT_V(n) asm volatile("s_waitcnt vmcnt(" #n ")" ::: "memory")
#define PG8_WAIT_L(n) asm volatile("s_waitcnt lgkmcnt(" #n ")" ::: "memory")
#define PG8_BAR __builtin_amdgcn_s_barrier()
#define PG8_SCHED __builtin_amdgcn_sched_barrier(0)
    Unit cur, nxt; int ui = 0;
    if (!S.next(0, cur)) return;
    f32x4 acc[2][2][4][2];
#pragma unroll
    for (int a = 0; a < 2; ++a)
#pragma unroll
        for (int b = 0; b < 2; ++b)
#pragma unroll
            for (int m = 0; m < 4; ++m)
#pragma unroll
                for (int n = 0; n < 2; ++n) acc[a][b][m][n] = (f32x4){0.f, 0.f, 0.f, 0.f};
    bf16x8 At[4][2], B0[2][2], B1[2][2];
    const char* cA = (const char*)g.A + (size_t)cur.pm * tstep; const char* cB = (const char*)g.Bt + (size_t)cur.pn * tstep;
    S.a_ready(cur);
    if constexpr (SP2) {
        PG8_STAGE(PG8_SB(0, 0), cB, voffB); PG8_STAGE(PG8_SB(0, 1), cB + hstep, voffB); PG8_STAGE(PG8_SA(0, 0), cA, voffA); PG8_STAGE(PG8_SA(0, 1), cA + hstep, voffA);
        if (wr == 1) PG8_BAR;
        PG8_WAIT_V(2); PG8_BAR;
        PG8_STAGE(PG8_SB(1, 0), cB + kstep, voffB); PG8_STAGE(PG8_SA(1, 0), cA + kstep, voffA); PG8_STAGE(PG8_SB(1, 1), cB + hstep + kstep, voffB);
        PG8_WAIT_V(6); PG8_BAR;
    } else {
        PG8_STAGE(PG8_SB(0, 0), cB, voffB); PG8_STAGE(PG8_SA(0, 0), cA, voffA); PG8_STAGE(PG8_SB(0, 1), cB + hstep, voffB); PG8_STAGE(PG8_SA(0, 1), cA + hstep, voffA);
        if (wr == 1) PG8_BAR;
        PG8_WAIT_V(4); PG8_BAR;
        PG8_STAGE(PG8_SB(1, 0), cB + kstep, voffB); PG8_STAGE(PG8_SA(1, 0), cA + kstep, voffA); PG8_STAGE(PG8_SB(1, 1), cB + hstep + kstep, voffB);
        PG8_WAIT_V(6); PG8_BAR;
    }
    for (;;) {
        const bool has_next = S.next(ui + 1, nxt);
        const char* nA = has_next ? (const char*)g.A + (size_t)nxt.pm * tstep : cA; const char* nB = has_next ? (const char*)g.Bt + (size_t)nxt.pn * tstep : cB;
        for (int t = 0; t < nt; t += 2) {
            const bool last = (t == nt - 2);
            const char* a1 = cA + (size_t)(t + 1) * kstep;
            const char* a2 = last ? nA : cA + (size_t)(t + 2) * kstep; const char* b2 = last ? nB : cB + (size_t)(t + 2) * kstep;
            const char* a3 = a2 + kstep; const char* b3 = b2 + kstep;
            if (last && has_next) S.a_ready(nxt);
            if constexpr (SP2) {
            PG8_LDB(B0, 0, 0); PG8_LDB(B1, 0, 1); PG8_SCHED; PG8_LDA(At, 0, 0); PG8_STAGE(PG8_SA(1, 1), a1 + hstep, voffA);
            PG8_WAIT_V(8); PG8_WAIT_L(0); PG8_BAR; PG8_MMA(0, 0, At, B0); PG8_MMA(0, 1, At, B1); PG8_BAR; PG8_SCHED;
            PG8_LDA(At, 0, 1); PG8_STAGE(PG8_SB(0, 0), b2, voffB); PG8_STAGE(PG8_SB(0, 1), b2 + hstep, voffB); PG8_STAGE(PG8_SA(0, 0), a2, voffA);
            PG8_WAIT_V(8); PG8_WAIT_L(0); PG8_BAR; PG8_MMA(1, 0, At, B0); PG8_MMA(1, 1, At, B1); PG8_BAR; PG8_SCHED;
            PG8_LDB(B0, 1, 0); PG8_LDB(B1, 1, 1); PG8_SCHED; PG8_LDA(At, 1, 0); PG8_STAGE(PG8_SA(0, 1), a2 + hstep, voffA);
            PG8_WAIT_V(8); PG8_WAIT_L(0); PG8_BAR; PG8_MMA(0, 0, At, B0); PG8_MMA(0, 1, At, B1); PG8_BAR; PG8_SCHED;
            PG8_LDA(At, 1, 1); PG8_STAGE(PG8_SB(1, 0), b3, voffB); PG8_STAGE(PG8_SB(1, 1), b3 + hstep, voffB); PG8_STAGE(PG8_SA(1, 0), a3, voffA);
            PG8_WAIT_V(8); PG8_WAIT_L(0); PG8_BAR; PG8_MMA(1, 0, At, B0); PG8_MMA(1, 1, At, B1); PG8_BAR; PG8_SCHED;
            } else {
            PG8_LDB(B0, 0, 0); PG8_SCHED; PG8_LDA(At, 0, 0); PG8_STAGE(PG8_SA(1, 1), a1 + hstep, voffA);
            PG8_WAIT_L(8); PG8_BAR; PG8_WAIT_L(0); PG8_MMA(0, 0, At, B0); PG8_BAR; PG8_SCHED;
            PG8_LDB(B1, 0, 1); PG8_STAGE(PG8_SB(0, 0), b2, voffB);
            PG8_BAR; PG8_WAIT_L(0); PG8_MMA(0, 1, At, B1); PG8_BAR;
            PG8_LDA(At, 0, 1); PG8_STAGE(PG8_SA(0, 0), a2, voffA);
            PG8_BAR; PG8_WAIT_L(0); PG8_MMA(1, 0, At, B0); PG8_BAR; PG8_SCHED;
            PG8_STAGE(PG8_SB(0, 1), b2 + hstep, voffB);
            PG8_WAIT_V(6); PG8_BAR; PG8_MMA(1, 1, At, B1); PG8_BAR;
            PG8_LDB(B0, 1, 0); PG8_SCHED; PG8_LDA(At, 1, 0); PG8_STAGE(PG8_SA(0, 1), a2 + hstep, voffA);
            PG8_WAIT_L(8); PG8_BAR; PG8_WAIT_L(0); PG8_MMA(0, 0, At, B0); PG8_BAR; PG8_SCHED;
            PG8_LDB(B1, 1, 1); PG8_STAGE(PG8_SB(1, 0), b3, voffB);
            PG8_BAR; PG8_WAIT_L(0); PG8_MMA(0, 1, At, B1); PG8_BAR;
            PG8_LDA(At, 1, 1); PG8_STAGE(PG8_SA(1, 0), a3, voffA);
            PG8_BAR; PG8_WAIT_L(0); PG8_MMA(1, 0, At, B0); PG8_BAR; PG8_SCHED;
            PG8_STAGE(PG8_SB(1, 1), b3 + hstep, voffB);
            PG8_WAIT_V(6); PG8_BAR; PG8_MMA(1, 1, At, B1); PG8_BAR;
            }
        }
        if constexpr (ALIGN_EPI) { if (wr == 0) PG8_BAR; }
        if constexpr (!Epi::AFTER_DRAIN) { E(acc, cur, wr, wc, fr, fq); S.done(cur); }
        if (!has_next) break;
#pragma unroll
        for (int a = 0; a < 2; ++a)
#pragma unroll
            for (int b = 0; b < 2; ++b)
#pragma unroll
                for (int m = 0; m < 4; ++m)
#pragma unroll
                    for (int n = 0; n < 2; ++n) acc[a][b][m][n] = (f32x4){0.f, 0.f, 0.f, 0.f};
        cur = nxt; cA = nA; cB = nB; ++ui;
        if constexpr (ALIGN_EPI) { if (wr == 1) PG8_BAR; }
    }
    PG8_WAIT_V(0);
    if constexpr (!ALIGN_EPI) { if (wr == 0) PG8_BAR; }
    PG8_BAR;
    if constexpr (Epi::AFTER_DRAIN) { E.fused(acc, cur, wr, wc, fr, fq, lds, wid, lane); S.done(cur); }
#undef PG8_SA
#undef PG8_SB
#undef PG8_STAGE
#undef PG8_LDA
#undef PG8_LDB
#undef PG8_MMA
#undef PG8_WAIT_V
#undef PG8_WAIT_L
#undef PG8_BAR
#undef PG8_SCHED
}
}
#define GAS __attribute__((address_space(1)))
#define LAS __attribute__((address_space(3)))
typedef unsigned short bf16;
typedef unsigned v4u __attribute__((ext_vector_type(4)));
typedef float f32x4 __attribute__((ext_vector_type(4)));
typedef short bf16x8 __attribute__((ext_vector_type(8)));
typedef GAS unsigned gu32;
typedef GAS unsigned long long gu64;
#define RLX_AGENT __ATOMIC_RELAXED, __HIP_MEMORY_SCOPE_AGENT
#define LDS_WAIT() asm volatile("s_waitcnt lgkmcnt(0)" ::: "memory")
#define VM_WAIT() asm volatile("s_waitcnt vmcnt(0)" ::: "memory")
__device__ __forceinline__ unsigned long long rt() { return __builtin_amdgcn_s_memrealtime(); }
__device__ __forceinline__ unsigned f2bf(float f) { unsigned u = __builtin_bit_cast(unsigned, f); return (u + 0x7fffu + ((u >> 16) & 1u)) >> 16; }
__device__ __forceinline__ unsigned pk2(float lo, float hi) { return f2bf(lo) | (f2bf(hi) << 16); }

#define XB_TMO      128
#define XB_XCNT(j)  (256  + 64 * (j))
#define XB_XSUB(j)  (1280 + 64 * (j))
#define XB_XGEN(j)  (2304 + 64 * (j))
#define XB_TOP      3328
#define XB_TOPGEN   3392
#define XCD_BAR_WORDS 3456
#define XB_SPIN_CAP (1u << 18)

__device__ __forceinline__ unsigned xb_ld(unsigned* p)              { return __hip_atomic_load(p, __ATOMIC_RELAXED, __HIP_MEMORY_SCOPE_AGENT); }
__device__ __forceinline__ unsigned xb_add(unsigned* p, unsigned v) { return __hip_atomic_fetch_add(p, v, __ATOMIC_RELAXED, __HIP_MEMORY_SCOPE_AGENT); }
__device__ __forceinline__ unsigned xb_xcc_id() { return (unsigned)__builtin_amdgcn_s_getreg((3 << 11) | 20) & 0xFu; }
#define XB_SPIN(cond, bar) do { unsigned _sp = 0; while (cond) { __builtin_amdgcn_s_sleep(1); \
    if ((++_sp & 255u) == 0u) { if (xb_ld(&(bar)[XB_TMO])) break; if (_sp > XB_SPIN_CAP) { atomicAdd(&(bar)[XB_TMO], 1u); break; } } } } while (0)

struct XcdBarrier {
    unsigned* bar; unsigned x;
    volatile LAS unsigned* st;
};

__device__ __forceinline__ XcdBarrier xcd_barrier_post(unsigned* bar, volatile LAS unsigned* st) {
    XcdBarrier b; b.bar = bar; b.x = xb_xcc_id(); b.st = st;
    if (threadIdx.x == 0) (void)xb_add(&bar[XB_XCNT(b.x)], 1u);
    return b;
}
__device__ __forceinline__ void xcd_barrier_complete(unsigned* bar, unsigned x, unsigned& nloc, unsigned& nx) {
    const unsigned G = gridDim.x * gridDim.y * gridDim.z;
    unsigned sum, cnt, mine, sp = 0u;
    for (;;) {
        sum = 0u; cnt = 0u; mine = 0u;
#pragma unroll
        for (unsigned j = 0; j < 16; ++j) { const unsigned c = xb_ld(&bar[XB_XCNT(j)]); sum += c; cnt += (c > 0u) ? 1u : 0u; mine = (j == x) ? c : mine; }
        if (sum == G) break;
        __builtin_amdgcn_s_sleep(1);
        if ((++sp & 255u) == 0u) { if (xb_ld(&bar[XB_TMO])) break; if (sp > XB_SPIN_CAP) { atomicAdd(&bar[XB_TMO], 1u); break; } }
    }
    nloc = mine > 0u ? mine : 1u; nx = cnt > 0u ? cnt : 1u;
}

__device__ __forceinline__ void xcd_barrier(const XcdBarrier& b) {
    asm volatile("s_waitcnt vmcnt(0)" ::: "memory");
    __syncthreads();
    if (threadIdx.x == 0) {
        unsigned* bar = b.bar;
        __builtin_amdgcn_s_waitcnt(0);
        unsigned nloc = b.st[0], nx = b.st[1];
        if (nloc == 0u) { xcd_barrier_complete(bar, b.x, nloc, nx); b.st[0] = nloc; b.st[1] = nx; }
        const unsigned old = xb_add(&bar[XB_XSUB(b.x)], 1u);
        const unsigned gen = old / nloc;
        if (old + 1u == (gen + 1u) * nloc) {
            __builtin_amdgcn_fence(__ATOMIC_RELEASE, "agent");
            asm volatile("s_waitcnt vmcnt(0)" ::: "memory");
            const unsigned og = xb_add(&bar[XB_TOP], 1u);
            const unsigned tg = og / nx;
            if (og + 1u == (tg + 1u) * nx) xb_add(&bar[XB_TOPGEN], 1u);
            else XB_SPIN(xb_ld(&bar[XB_TOPGEN]) == tg, bar);
            __builtin_amdgcn_fence(__ATOMIC_ACQUIRE, "agent");
            xb_add(&bar[XB_XGEN(b.x)], 1u);
            asm volatile("s_waitcnt vmcnt(0)" ::: "memory");
        } else {
            XB_SPIN(xb_ld(&bar[XB_XGEN(b.x)]) == gen, bar);
            __builtin_amdgcn_fence(__ATOMIC_ACQUIRE, "agent");
            asm volatile("s_waitcnt vmcnt(0)" ::: "memory");
        }
    }
    __syncthreads();
}

constexpr int NWAVES = 8;
constexpr int DM = 1024, NB = 8, TL = 2048, LC = 256, DFF = 4096;
constexpr int ML = NB * TL;
constexpr int MC = NB * LC;
constexpr int MT = ML + MC;
constexpr int NU = 4096;
constexpr int UQ = 0, UK = 512, UV = 1024, UO = 1536, UZ = 2048, UX = 2560, UB = 3072, UC = 3200, UAQ = 3328, UAK = 3840, UAV = 3968;
constexpr int INW = 4128;
constexpr int NY = 1536;
constexpr float EPS = 1e-6f;
constexpr int NPH = 19;

constexpr size_t MiB = 1u << 20;
constexpr size_t WS_CTL = 0, CTL_ZERO_BYTES = 1 * MiB;
constexpr size_t WS_MOD = 1 * MiB;
constexpr size_t WS_GATES = 2 * MiB;
constexpr size_t WS_GW = 5 * MiB;
constexpr size_t WS_W1 = 6 * MiB;
constexpr size_t WS_A = 14 * MiB;
constexpr size_t WS_B = 68 * MiB;
constexpr size_t WS_W0 = 212 * MiB;
constexpr size_t WS_CTXF = 220 * MiB;
constexpr size_t WS_P = 212 * MiB;
constexpr size_t WS_END = 256 * MiB;
static_assert(WS_GATES + (size_t)MT * 32 * 4 <= WS_GW && WS_GW + 2 * 32 * 1024 * 4 <= WS_W1 && WS_W1 + 8 * MiB <= WS_A && WS_A + (size_t)MT * NY * 2 <= WS_B && WS_B + (size_t)MT * NU * 2 <= WS_W0 && WS_W0 + 8 * MiB <= WS_CTXF
              && WS_CTXF + (size_t)MC * DM * 4 <= WS_END && WS_P + (size_t)MT * 1024 * 2 <= WS_END, "d_ws map");
constexpr int CW_BAR = 4096;

constexpr int RING_OFF = 0, RING_BYTES = 131072;
constexpr int LDSCTL_OFF = RING_BYTES, MISC_OFF = LDSCTL_OFF + 320;
constexpr int LDS_BYTES = 147456;

__device__ __forceinline__ float bf2f(unsigned short h) { return __uint_as_float((unsigned)h << 16); }
__device__ __forceinline__ unsigned short f2bf_s(float f) { return (unsigned short)f2bf(f); }
__device__ __forceinline__ float wave_sum(float v) {
#pragma unroll
    for (int o = 1; o < 64; o <<= 1) v += __shfl_xor(v, o);
    return v;
}

struct Frame {
    LAS unsigned char* lds;
    volatile LAS unsigned* MISC;
    gu32* ctl;
    int tid, lane, wave, G;
    float* out;
    unsigned char* ws;
};
__device__ __forceinline__ const float* kin(int i) {
    const __attribute__((address_space(4))) char* ka = (const __attribute__((address_space(4))) char*)__builtin_amdgcn_kernarg_segment_ptr();
    asm volatile("" : "+s"(ka));
    return ((const float* const __attribute__((address_space(4)))*)ka)[i];
}
enum { I_X = 0, I_C, I_CTX, I_CCTX, I_WMOD, I_BMOD, I_N1G, I_WIN, I_MLBI, I_MLBF, I_MLNG, I_CONVW, I_CONVB, I_ALOG, I_DTB, I_SSDD, I_SSDNG, I_QNG, I_KNG, I_SINK, I_WOUT, I_N2G, I_WUP, I_WDOWN };

__device__ __forceinline__ void transpose_item(const float* W, int ldw, int src_col0, bf16* WT, int K, int dst_row0, int k0, LAS float* scr, int lane) {
#pragma unroll
    for (int i = 0; i < 32; ++i) { const int kk = 2 * i + (lane >> 5); scr[kk * 33 + (lane & 31)] = W[(size_t)(k0 + kk) * ldw + src_col0 + (lane & 31)]; }
    LDS_WAIT(); asm volatile("" ::: "memory");
    const int c = lane & 7;
#pragma unroll
    for (int j = 0; j < 4; ++j) { const int n = (lane >> 3) + 8 * j; const LAS float* s = scr + (8 * c) * 33 + n;
        v4u o; o.x = pk2(s[0 * 33], s[1 * 33]); o.y = pk2(s[2 * 33], s[3 * 33]); o.z = pk2(s[4 * 33], s[5 * 33]); o.w = pk2(s[6 * 33], s[7 * 33]);
        *(GAS v4u*)(WT + (size_t)(dst_row0 + n) * K + k0 + 8 * c) = o; }
    LDS_WAIT(); asm volatile("" ::: "memory");
}
__device__ __forceinline__ void convert_weight(Frame& F, const float* W, int K, int N, bf16* WT) {
    LAS float* scr = (LAS float*)(F.lds + RING_OFF + F.wave * 16384);
    const int gw = blockIdx.x * NWAVES + F.wave, NGW = F.G * NWAVES, nblk = N / 32, nitems = (K / 64) * nblk;
    for (int it = gw; it < nitems; it += NGW) { const int kb = it / nblk, nb = it % nblk; transpose_item(W, N, 32 * nb, WT, K, 32 * nb, 64 * kb, scr, F.lane); }
}
__device__ __forceinline__ void convert_win(Frame& F, const float* W, bf16* WT) {
    LAS float* scr = (LAS float*)(F.lds + RING_OFF + F.wave * 16384);
    const int gw = blockIdx.x * NWAVES + F.wave, NGW = F.G * NWAVES, nblk = NU / 32, nitems = (DM / 64) * nblk;
    for (int it = gw; it < nitems; it += NGW) { const int kb = it / nblk, nb = it % nblk, d0 = 32 * nb, s0 = d0 + (d0 < 2048 ? 0 : (d0 < 3328 ? 16 : 32));
        transpose_item(W, INW, s0, WT, DM, d0, 64 * kb, scr, F.lane); }
}

__device__ __forceinline__ void phase_mod(Frame& F) {
    LAS float* s = (LAS float*)(F.lds + RING_OFF);
    LAS float* red = (LAS float*)(F.lds + RING_OFF + 36864);
    float* MOD = (float*)(F.ws + WS_MOD);
    for (int i = F.tid; i < 9 * 1024; i += NWAVES * 64) { const int r = i >> 10, k = i & 1023; const float v = r < 8 ? kin(I_C)[r * 1024 + k] : kin(I_CCTX)[k]; s[i] = v / (1.f + expf(-v)); }
    __syncthreads();
    for (int u = blockIdx.x; u < 192; u += F.G) {
        const int L = u / 96, cg = u % 96, col = cg * 64 + F.lane, kq = F.wave;
        const float* w = kin(I_WMOD) + (size_t)L * 1024 * 6144 + col;
        float acc[9];
#pragma unroll
        for (int r = 0; r < 9; ++r) acc[r] = 0.f;
#pragma unroll 16
        for (int k = kq * 128; k < kq * 128 + 128; ++k) { const float wv = w[(size_t)k * 6144];
#pragma unroll
            for (int r = 0; r < 9; ++r) acc[r] += s[r * 1024 + k] * wv; }
#pragma unroll
        for (int r = 0; r < 9; ++r) red[(kq * 9 + r) * 64 + F.lane] = acc[r];
        __syncthreads();
        for (int i = F.tid; i < 576; i += NWAVES * 64) { const int r = i >> 6, c = i & 63; float a = kin(I_BMOD)[L * 6144 + cg * 64 + c];
#pragma unroll
            for (int q = 0; q < 8; ++q) a += red[(q * 9 + r) * 64 + c];
            MOD[(size_t)(L * 9 + r) * 6144 + cg * 64 + c] = a; }
        __syncthreads();
    }
    { float* GW = (float*)(F.ws + WS_GW); const int nb = F.G > 192 ? F.G - 192 : F.G, b0 = F.G > 192 ? (int)blockIdx.x - 192 : (int)blockIdx.x;
      if (b0 >= 0) for (int i = b0 * (NWAVES * 64) + F.tid; i < 2 * 32 * 1024; i += nb * NWAVES * 64) { const int L = i >> 15, k = (i >> 5) & 1023, j = i & 31;
          GW[(size_t)L * 32768 + j * 1024 + k] = kin(I_WIN)[(size_t)L * DM * INW + (size_t)k * INW + (j < 16 ? 2048 + j : 3344 + (j - 16))]; } }
}

template <bool WITH_GATES>
__device__ __forceinline__ void norm_rows(Frame& F, int L, int nrows, const float* xl, const float* xc, const float* g, int chunk0, bf16* XN, LAS float* gwl) {
    const float* MODL = (const float*)(F.ws + WS_MOD) + (size_t)L * 9 * 6144;
    float* GATES = (float*)(F.ws + WS_GATES);
    const int gw = blockIdx.x * NWAVES + F.wave, NGW = F.G * NWAVES, lane = F.lane;
    for (int r = gw; r < nrows; r += NGW) {
        const bool lat = r < ML;
        const float* xr = lat ? xl + (size_t)r * DM : xc + (size_t)(r - ML) * DM;
        const float* md = MODL + (size_t)(lat ? (r >> 11) : 8) * 6144 + chunk0 * 1024;
        f32x4 v[4]; float ss = 0.f;
#pragma unroll
        for (int j = 0; j < 4; ++j) { v[j] = *(const f32x4*)(xr + 256 * j + 4 * lane); ss += (v[j].x * v[j].x + v[j].y * v[j].y) + (v[j].z * v[j].z + v[j].w * v[j].w); }
        const float rstd = 1.0f / sqrtf(wave_sum(ss) * (1.f / DM) + EPS);
#pragma unroll
        for (int j = 0; j < 4; ++j) { const int e = 256 * j + 4 * lane; const f32x4 gg = *(const f32x4*)(g + e), sh = *(const f32x4*)(md + e), sc = *(const f32x4*)(md + 1024 + e);
            v[j] = (v[j] * rstd) * gg * (sc + 1.0f) + sh;
            unsigned long long o = (unsigned long long)pk2(v[j].x, v[j].y) | ((unsigned long long)pk2(v[j].z, v[j].w) << 32);
            *(unsigned long long*)(XN + (size_t)r * DM + e) = o; }
        if (WITH_GATES) {
            float p[32];
#pragma unroll
            for (int jj = 0; jj < 32; ++jj) { float a = 0.f;
#pragma unroll
                for (int j = 0; j < 4; ++j) { const f32x4 w = *(const LAS f32x4*)(gwl + jj * 1024 + 256 * j + 4 * lane); a += (v[j].x * w.x + v[j].y * w.y) + (v[j].z * w.z + v[j].w * w.w); }
                p[jj] = a; }
#pragma unroll
            for (int n = 16, o = 32; n >= 1; n >>= 1, o >>= 1) { const bool hi = (lane & o) != 0;
#pragma unroll
                for (int j = 0; j < n; ++j) { const float keep = hi ? p[j + n] : p[j], send = hi ? p[j] : p[j + n]; p[j] = keep + __shfl_xor(send, o); } }
            const float mine = p[0] + __shfl_xor(p[0], 1);
            if ((lane & 1) == 0) { const int gj = lane >> 1; float o;
                if (gj < 8) o = mine + kin(I_MLBI)[L * 8 + gj];
                else if (gj < 16) { const float z = mine + kin(I_MLBF)[L * 8 + gj - 8]; o = fminf(z, 0.f) - log1pf(expf(-fabsf(z))); }
                else { const float z = mine + kin(I_DTB)[L * 16 + gj - 16]; o = fmaxf(z, 0.f) + log1pf(expf(-fabsf(z))); }
                GATES[(size_t)r * 32 + gj] = o; }
        }
    }
}

__device__ __forceinline__ void phase_qkn(Frame& F, int L) {
    bf16* U = (bf16*)(F.ws + WS_B);
    const int gw = blockIdx.x * NWAVES + F.wave, NGW = F.G * NWAVES, lane = F.lane;
    const int gh = lane >> 5, p = lane & 31, fi = p & 15, d1 = (p < 16) ? p : 32 + (p - 16), d2 = d1 + 16;
    const float gq1 = kin(I_QNG)[L * 64 + d1], gq2 = kin(I_QNG)[L * 64 + d2], gk1 = kin(I_KNG)[L * 64 + d1], gk2 = kin(I_KNG)[L * 64 + d2];
    const float inv = exp2f(-(float)fi * (13.287712379549449f / 16.0f));
    const int nrows = (L == 0) ? MT : MT;
    for (int r = gw; r < nrows; r += NGW) {
        float cs = 1.f, sn = 0.f;
        if (r < ML) { const int t = r & 2047; const float pos = (float)((p < 16) ? (t >> 6) : (t & 63)); const float ang = pos * inv; cs = __cosf(ang); sn = __sinf(ang); }
#pragma unroll
        for (int j = 0; j < 5; ++j) {
            const int c = 2 * j + gh;
            bf16* kr = U + (size_t)r * NU + UAQ + c * 64;
            float x1 = bf2f(kr[d1]), x2 = bf2f(kr[d2]);
            float ss = x1 * x1 + x2 * x2;
#pragma unroll
            for (int o = 1; o < 32; o <<= 1) ss += __shfl_xor(ss, o);
            const float rs = 1.0f / sqrtf(ss * (1.f / 64.f) + EPS);
            const bool isq = c < 8; const float sc = isq ? 0.125f * 1.4426950408889634f : 1.0f;
            x1 = x1 * rs * (isq ? gq1 : gk1) * sc; x2 = x2 * rs * (isq ? gq2 : gk2) * sc;
            kr[d1] = f2bf_s(x1 * cs - x2 * sn); kr[d2] = f2bf_s(x2 * cs + x1 * sn);
        }
    }
}

__device__ __forceinline__ int scan_row(int s, int d, int b) {
    if (s < LC) { const int t = d ? (LC - 1 - s) : s; return ML + b * LC + t; }
    int t = s - LC; if (d) t = TL - 1 - t; return b * TL + t;
}

__device__ __forceinline__ void mlstm_unit(Frame& F, int L, int d, int unit) {
    const int vq = unit & 3, h = (unit >> 2) & 3, b = unit >> 4, lane = F.lane, kh = lane >> 5, vv = lane & 31, gi = d * 4 + h;
    const bf16* U = (const bf16*)(F.ws + WS_B); const float* GATES = (const float*)(F.ws + WS_GATES); bf16* Y = (bf16*)(F.ws + WS_A);
    LAS float* buf = (LAS float*)(F.lds + RING_OFF + F.wave * 16384);
    constexpr int ST = 320;
    constexpr float KSC = 0.08838834764831845f;
    float C[64];
#pragma unroll
    for (int i = 0; i < 64; ++i) C[i] = 0.f;
    float n0 = 0.f, n1 = 0.f, m = 0.f;
    unsigned qd[8], kd[8]; unsigned short vd[8]; float pli[8], plf[8];
#define ML_LOAD(nb_) do { _Pragma("unroll") for (int i = 0; i < 8; ++i) { const int r_ = scan_row((nb_) * 8 + i, d, b); const bf16* ur_ = U + (size_t)r_ * NU + h * 128; \
        qd[i] = *(const unsigned*)(ur_ + UQ + 2 * lane); kd[i] = *(const unsigned*)(ur_ + UK + 2 * lane); vd[i] = ur_[UV + vq * 32 + vv]; \
        pli[i] = GATES[(size_t)r_ * 32 + gi]; plf[i] = GATES[(size_t)r_ * 32 + 8 + gi]; } } while (0)
    ML_LOAD(0);
    for (int nb = 0; nb < (LC + TL) / 8; ++nb) {
#pragma unroll
        for (int i = 0; i < 8; ++i) { LAS float* sl = buf + i * ST;
            sl[2 * lane] = __uint_as_float(qd[i] << 16); sl[2 * lane + 1] = __uint_as_float(qd[i] & 0xffff0000u);
            sl[128 + 2 * lane] = __uint_as_float(kd[i] << 16) * KSC; sl[128 + 2 * lane + 1] = __uint_as_float(kd[i] & 0xffff0000u) * KSC;
            if (lane < 32) sl[256 + lane] = bf2f(vd[i]);
            if (lane == 0) { sl[288] = pli[i]; sl[289] = plf[i]; } }
        if (nb + 1 < (LC + TL) / 8) ML_LOAD(nb + 1);
#pragma unroll 1
        for (int i = 0; i < 8; ++i) { const LAS float* sl = buf + i * ST;
            const float li = sl[288], lf = sl[289], vval = sl[256 + vv];
            const float mn = fmaxf(lf + m, li), dec = __expf(lf + m - mn), iw = __expf(li - mn); m = mn;
            const float ivk = iw * vval; float num = 0.f;
#pragma unroll
            for (int j = 0; j < 16; ++j) { const f32x4 kv = *(const LAS f32x4*)(sl + 128 + kh * 64 + 4 * j), qv = *(const LAS f32x4*)(sl + kh * 64 + 4 * j);
                C[4 * j + 0] = dec * C[4 * j + 0] + ivk * kv.x; num += qv.x * C[4 * j + 0];
                C[4 * j + 1] = dec * C[4 * j + 1] + ivk * kv.y; num += qv.y * C[4 * j + 1];
                C[4 * j + 2] = dec * C[4 * j + 2] + ivk * kv.z; num += qv.z * C[4 * j + 2];
                C[4 * j + 3] = dec * C[4 * j + 3] + ivk * kv.w; num += qv.w * C[4 * j + 3]; }
            num += __shfl_xor(num, 32);
            n0 = dec * n0 + iw * sl[128 + lane]; n1 = dec * n1 + iw * sl[192 + lane];
            const float den = wave_sum(sl[lane] * n0 + sl[64 + lane] * n1);
            const float hv = num / fmaxf(fabsf(den), __expf(-mn));
            const int s = nb * 8 + i;
            if ((s >= LC || L == 0) && lane < 32) { const int r = scan_row(s, d, b); bf16* yp = Y + (size_t)r * NY + h * 128 + vq * 32 + vv;
                if (d == 0) *yp = f2bf_s(hv); else *yp = f2bf_s(bf2f(*yp) + hv); }
        }
    }
#undef ML_LOAD
}

constexpr int MP_Q = 272, MP_S = 144;
constexpr int MO_QS = 0, MO_KS = 17408, MO_KW = 34816, MO_VT = 53248, MO_SP = 71680, MO_CT = 80896, MO_SC = 115712;
static_assert(MO_SC + 2064 <= RING_BYTES, "mLSTM LDS map");
__device__ __forceinline__ void mlstm_block_unit(Frame& F, int L, int d, int unit) {
    const int h = unit & 3, b = unit >> 2, tid = F.tid, lane = F.lane, w = F.wave, fr = lane & 15, fq = lane >> 4, gi = d * 4 + h;
    const bf16* U = (const bf16*)(F.ws + WS_B); const float* GATES = (const float*)(F.ws + WS_GATES); bf16* Y = (bf16*)(F.ws + WS_A);
    LAS unsigned char* lds = F.lds + RING_OFF;
    LAS float* sc_a = (LAS float*)(lds + MO_SC); LAS float* sc_mx = sc_a + 64; LAS float* sc_g = sc_a + 128; LAS float* sc_w = sc_a + 192; LAS float* sc_emt = sc_a + 256; LAS float* sc_rd = sc_a + 320;
    LAS float* sc_n = sc_a + 384; LAS float* sc_s = sc_a + 512;
    constexpr float KSC = 0.08838834764831845f;
    typedef unsigned u32x2 __attribute__((ext_vector_type(2)));
    __syncthreads();
    for (int i = tid; i < 128 * MP_Q / 16; i += NWAVES * 64) *(LAS v4u*)(lds + MO_CT + i * 16) = (v4u){0u, 0u, 0u, 0u};
    if (tid < 128) sc_n[tid] = 0.f;
    if (tid == 0) { sc_s[0] = 0.f; sc_s[1] = 0.f; }
    f32x4 C[8];
#pragma unroll
    for (int j = 0; j < 8; ++j) C[j] = (f32x4){0.f, 0.f, 0.f, 0.f};
    const int srow = tid >> 3, part = tid & 7;
    v4u pq0, pq1, pk0, pk1, pv0, pv1; float gli = 0.f, glf = 0.f;
#define MB_LOAD(c_) do { const int r_ = scan_row((c_) * 64 + srow, d, b); const bf16* ur_ = U + (size_t)r_ * NU + h * 128 + 16 * part; \
        pq0 = *(const v4u*)(ur_ + UQ); pq1 = *(const v4u*)(ur_ + UQ + 8); pk0 = *(const v4u*)(ur_ + UK); pk1 = *(const v4u*)(ur_ + UK + 8); pv0 = *(const v4u*)(ur_ + UV); pv1 = *(const v4u*)(ur_ + UV + 8); \
        if (w == 0) { const int r2_ = scan_row((c_) * 64 + lane, d, b); gli = GATES[(size_t)r2_ * 32 + gi]; glf = GATES[(size_t)r2_ * 32 + 8 + gi]; } } while (0)
    MB_LOAD(0);
    __syncthreads();
    for (int c = 0; c < (LC + TL) / 64; ++c) {
        if (w == 0) {
            float bc = glf;
#pragma unroll
            for (int o = 1; o < 64; o <<= 1) { const float t_ = __shfl_up(bc, o); if (lane >= o) bc += t_; }
            const float a = gli - bc; float am = a;
#pragma unroll
            for (int o = 1; o < 64; o <<= 1) { const float t_ = __shfl_up(am, o); if (lane >= o) am = fmaxf(am, t_); }
            const float m_in = sc_s[0], mx = fmaxf(m_in, am), g = __expf(m_in - mx), mx63 = __shfl(mx, 63), wv = __expf(a - mx63), mt = bc + mx;
            sc_a[lane] = a; sc_mx[lane] = mx; sc_g[lane] = g; sc_w[lane] = wv; sc_emt[lane] = __expf(-mt);
            if (lane == 63) { sc_s[0] = mt; sc_s[1] = g; }
        }
        __syncthreads();
        {
            *(LAS v4u*)(lds + MO_QS + srow * MP_Q + part * 32) = pq0; *(LAS v4u*)(lds + MO_QS + srow * MP_Q + part * 32 + 16) = pq1;
            *(LAS v4u*)(lds + MO_KS + srow * MP_Q + part * 32) = pk0; *(LAS v4u*)(lds + MO_KS + srow * MP_Q + part * 32 + 16) = pk1;
            const float wk = sc_w[srow] * KSC;
            LAS unsigned short* kw = (LAS unsigned short*)(lds + MO_KW + (16 * part) * MP_S + srow * 2);
            LAS unsigned short* vt = (LAS unsigned short*)(lds + MO_VT + (16 * part) * MP_S + srow * 2);
            const unsigned kk[8] = {pk0.x, pk0.y, pk0.z, pk0.w, pk1.x, pk1.y, pk1.z, pk1.w};
            const unsigned vv[8] = {pv0.x, pv0.y, pv0.z, pv0.w, pv1.x, pv1.y, pv1.z, pv1.w};
#pragma unroll
            for (int e = 0; e < 8; ++e) {
                kw[(2 * e) * (MP_S / 2)] = f2bf_s(__uint_as_float(kk[e] << 16) * wk); kw[(2 * e + 1) * (MP_S / 2)] = f2bf_s(__uint_as_float(kk[e] & 0xffff0000u) * wk);
                vt[(2 * e) * (MP_S / 2)] = (unsigned short)(vv[e] & 0xffffu); vt[(2 * e + 1) * (MP_S / 2)] = (unsigned short)(vv[e] >> 16); }
        }
        if (c + 1 < (LC + TL) / 64) MB_LOAD(c + 1);
        __syncthreads();
        {
            const int ms = w >> 1, nt0 = 2 * (w & 1);
            f32x4 acc[2] = {(f32x4){0.f, 0.f, 0.f, 0.f}, (f32x4){0.f, 0.f, 0.f, 0.f}};
#pragma unroll
            for (int kk2 = 0; kk2 < 4; ++kk2) {
                const bf16x8 af = *(const LAS bf16x8*)(lds + MO_KS + (16 * ms + fr) * MP_Q + (32 * kk2 + 8 * fq) * 2);
#pragma unroll
                for (int j = 0; j < 2; ++j) { const bf16x8 bfv = *(const LAS bf16x8*)(lds + MO_QS + (16 * (nt0 + j) + fr) * MP_Q + (32 * kk2 + 8 * fq) * 2);
                    acc[j] = __builtin_amdgcn_mfma_f32_16x16x32_bf16(af, bfv, acc[j], 0, 0, 0); }
            }
            const int s0 = 16 * ms + 4 * fq;
            const f32x4 av = *(const LAS f32x4*)(sc_a + s0);
#pragma unroll
            for (int j = 0; j < 2; ++j) { const int t = 16 * (nt0 + j) + fr; const float mxt = sc_mx[t];
                float v0 = (s0 + 0 <= t) ? acc[j][0] * KSC * __expf(av[0] - mxt) : 0.f, v1 = (s0 + 1 <= t) ? acc[j][1] * KSC * __expf(av[1] - mxt) : 0.f;
                float v2 = (s0 + 2 <= t) ? acc[j][2] * KSC * __expf(av[2] - mxt) : 0.f, v3 = (s0 + 3 <= t) ? acc[j][3] * KSC * __expf(av[3] - mxt) : 0.f;
                u32x2 o; o.x = pk2(v0, v1); o.y = pk2(v2, v3);
                *(LAS u32x2*)(lds + MO_SP + t * MP_S + s0 * 2) = o; }
        }
        __syncthreads();
        {
            const int t = srow;
            const v4u sp = *(const LAS v4u*)(lds + MO_SP + t * MP_S + part * 16);
            float ssum = (__uint_as_float(sp.x << 16) + __uint_as_float(sp.x & 0xffff0000u)) + (__uint_as_float(sp.y << 16) + __uint_as_float(sp.y & 0xffff0000u))
                       + (__uint_as_float(sp.z << 16) + __uint_as_float(sp.z & 0xffff0000u)) + (__uint_as_float(sp.w << 16) + __uint_as_float(sp.w & 0xffff0000u));
            const v4u q0 = *(const LAS v4u*)(lds + MO_QS + t * MP_Q + part * 32), q1 = *(const LAS v4u*)(lds + MO_QS + t * MP_Q + part * 32 + 16);
            const unsigned qq[8] = {q0.x, q0.y, q0.z, q0.w, q1.x, q1.y, q1.z, q1.w};
            float qn = 0.f;
#pragma unroll
            for (int e = 0; e < 8; ++e) qn += __uint_as_float(qq[e] << 16) * sc_n[16 * part + 2 * e] + __uint_as_float(qq[e] & 0xffff0000u) * sc_n[16 * part + 2 * e + 1];
            ssum += __shfl_xor(ssum, 1); ssum += __shfl_xor(ssum, 2); ssum += __shfl_xor(ssum, 4);
            qn += __shfl_xor(qn, 1); qn += __shfl_xor(qn, 2); qn += __shfl_xor(qn, 4);
            if (part == 0) { const float den = ssum + sc_g[t] * qn; sc_rd[t] = 1.0f / fmaxf(fabsf(den), sc_emt[t]); }
        }
        __syncthreads();
        if (c >= LC / 64 || L == 0) {
            const int mv = w;
            f32x4 a1[4], a2[4];
#pragma unroll
            for (int j = 0; j < 4; ++j) { a1[j] = (f32x4){0.f, 0.f, 0.f, 0.f}; a2[j] = (f32x4){0.f, 0.f, 0.f, 0.f}; }
#pragma unroll
            for (int kk2 = 0; kk2 < 2; ++kk2) {
                const bf16x8 af = *(const LAS bf16x8*)(lds + MO_VT + (16 * mv + fr) * MP_S + (32 * kk2 + 8 * fq) * 2);
#pragma unroll
                for (int j = 0; j < 4; ++j) { const bf16x8 bfv = *(const LAS bf16x8*)(lds + MO_SP + (16 * j + fr) * MP_S + (32 * kk2 + 8 * fq) * 2);
                    a1[j] = __builtin_amdgcn_mfma_f32_16x16x32_bf16(af, bfv, a1[j], 0, 0, 0); }
            }
#pragma unroll
            for (int kk2 = 0; kk2 < 4; ++kk2) {
                const bf16x8 af = *(const LAS bf16x8*)(lds + MO_CT + (16 * mv + fr) * MP_Q + (32 * kk2 + 8 * fq) * 2);
#pragma unroll
                for (int j = 0; j < 4; ++j) { const bf16x8 bfv = *(const LAS bf16x8*)(lds + MO_QS + (16 * j + fr) * MP_Q + (32 * kk2 + 8 * fq) * 2);
                    a2[j] = __builtin_amdgcn_mfma_f32_16x16x32_bf16(af, bfv, a2[j], 0, 0, 0); }
            }
#pragma unroll
            for (int j = 0; j < 4; ++j) { const int t = 16 * j + fr; const float g = sc_g[t], rd = sc_rd[t];
                const int row = scan_row(c * 64 + t, d, b);
                bf16* yp = (d == 0 ? Y + (size_t)row * NY : (bf16*)(F.ws + WS_P) + (size_t)row * 1024) + h * 128 + 16 * mv + 4 * fq;
                const float h0 = (a1[j][0] + g * a2[j][0]) * rd, h1 = (a1[j][1] + g * a2[j][1]) * rd, h2 = (a1[j][2] + g * a2[j][2]) * rd, h3 = (a1[j][3] + g * a2[j][3]) * rd;
                u32x2 o; o.x = pk2(h0, h1); o.y = pk2(h2, h3); *(u32x2*)yp = o; }
        }
        __syncthreads();
        {
            const float decay = sc_s[1]; const int mk = w;
#pragma unroll
            for (int j = 0; j < 8; ++j) C[j] = C[j] * decay;
#pragma unroll
            for (int kk2 = 0; kk2 < 2; ++kk2) {
                const bf16x8 af = *(const LAS bf16x8*)(lds + MO_KW + (16 * mk + fr) * MP_S + (32 * kk2 + 8 * fq) * 2);
#pragma unroll
                for (int j = 0; j < 8; ++j) { const bf16x8 bfv = *(const LAS bf16x8*)(lds + MO_VT + (16 * j + fr) * MP_S + (32 * kk2 + 8 * fq) * 2);
                    C[j] = __builtin_amdgcn_mfma_f32_16x16x32_bf16(af, bfv, C[j], 0, 0, 0); }
            }
#pragma unroll
            for (int j = 0; j < 8; ++j) { u32x2 o; o.x = pk2(C[j][0], C[j][1]); o.y = pk2(C[j][2], C[j][3]);
                *(LAS u32x2*)(lds + MO_CT + (16 * j + fr) * MP_Q + (16 * mk + 4 * fq) * 2) = o; }
            if (tid < 128) { float sm = 0.f;
#pragma unroll
                for (int e = 0; e < 8; ++e) { const v4u x = *(const LAS v4u*)(lds + MO_KW + tid * MP_S + e * 16);
                    sm += (__uint_as_float(x.x << 16) + __uint_as_float(x.x & 0xffff0000u)) + (__uint_as_float(x.y << 16) + __uint_as_float(x.y & 0xffff0000u))
                        + (__uint_as_float(x.z << 16) + __uint_as_float(x.z & 0xffff0000u)) + (__uint_as_float(x.w << 16) + __uint_as_float(x.w & 0xffff0000u)); }
                sc_n[tid] = decay * sc_n[tid] + sm; }
        }
        __syncthreads();
    }
#undef MB_LOAD
}

constexpr int SP_P = 144;
constexpr int SO_BS = 0, SO_CS = 9216, SO_BT = 18432, SO_HD = 27648, SO_HSTRIDE = 36864, SO_SP = 0, SO_XT = 9216, SO_XW = 18432, SO_HB = 27648, SO_SC = 101376, SO_CW = 103488;
static_assert(SO_CW + 4096 <= RING_BYTES, "SSD LDS map");
__device__ __forceinline__ void ssd_block_unit(Frame& F, int L, int d, int unit) {
    const int hp = unit & 3, b = unit >> 2, g = hp >> 1, tid = F.tid, lane = F.lane, w = F.wave, fr = lane & 15, fq = lane >> 4;
    const bf16* U = (const bf16*)(F.ws + WS_B); const float* GATES = (const float*)(F.ws + WS_GATES); bf16* Y = (bf16*)(F.ws + WS_A);
    LAS unsigned char* lds = F.lds + RING_OFF;
    LAS float* scb = (LAS float*)(lds + SO_SC);
    LAS float* cwt = (LAS float*)(lds + SO_CW);
    typedef unsigned u32x2 __attribute__((ext_vector_type(2)));
    __syncthreads();
    if (tid < 256) { const int ch = tid < 128 ? (2 * hp) * 64 + tid : (tid < 192 ? 512 + g * 64 + (tid - 128) : 640 + g * 64 + (tid - 192));
        const float* cw = kin(I_CONVW) + (size_t)L * 3 * 768;
        cwt[tid * 4 + 0] = cw[ch]; cwt[tid * 4 + 1] = cw[768 + ch]; cwt[tid * 4 + 2] = cw[1536 + ch]; cwt[tid * 4 + 3] = kin(I_CONVB)[L * 768 + ch]; }
    for (int i = tid; i < 2 * 9216 / 16; i += NWAVES * 64) { const int hl = i / 576, o = i % 576; *(LAS v4u*)(lds + SO_HD + hl * SO_HSTRIDE + SO_HB + o * 16) = (v4u){0u, 0u, 0u, 0u}; }
    const int hl = w >> 2, wq = w & 3, head = 2 * hp + hl;
    const float a_neg = -expf(kin(I_ALOG)[L * 16 + d * 8 + head]);
    const float dsk = kin(I_SSDD)[L * 8 + head];
    f32x4 Hs[4];
#pragma unroll
    for (int j = 0; j < 4; ++j) Hs[j] = (f32x4){0.f, 0.f, 0.f, 0.f};
    const int tokq = tid >> 5, c8 = tid & 31;
    const int ucol = c8 < 16 ? UX + (2 * hp) * 64 + 8 * c8 : (c8 < 24 ? UB + g * 64 + 8 * (c8 - 16) : UC + g * 64 + 8 * (c8 - 24));
    v4u raw[6]; float gdt = 0.f;
#define SB_LOAD(c_) do { const int s0_ = (c_) * 64; const bool cx_ = s0_ < LC; const int seglen_ = cx_ ? LC : TL; const int tf_ = cx_ ? s0_ : s0_ - LC; const int tlo_ = d ? seglen_ - 64 - tf_ : tf_; \
        const size_t rb0_ = cx_ ? (size_t)(ML + b * LC) : (size_t)(b * TL); \
        _Pragma("unroll") for (int r_ = 0; r_ < 6; ++r_) { const int t_ = tlo_ + 4 * tokq - 1 + r_; const bool ok_ = t_ >= 0 && t_ < seglen_; \
            raw[r_] = ok_ ? *(const v4u*)(U + (rb0_ + t_) * NU + ucol) : (v4u){0u, 0u, 0u, 0u}; } \
        if (w < 2) { const int r2_ = scan_row(s0_ + lane, d, b); gdt = GATES[(size_t)r2_ * 32 + 16 + d * 8 + 2 * hp + w]; } } while (0)
    SB_LOAD(0);
    __syncthreads();
    for (int c = 0; c < (LC + TL) / 64; ++c) {
        const bool need_out = (c >= LC / 64) || (L == 0);
        if (w < 2) {
            const float a_w = -expf(kin(I_ALOG)[L * 16 + d * 8 + 2 * hp + w]);
            float ac = gdt * a_w;
#pragma unroll
            for (int o = 1; o < 64; o <<= 1) { const float t_ = __shfl_up(ac, o); if (lane >= o) ac += t_; }
            const float aend = __shfl(ac, 63);
            LAS float* sb = scb + w * 256;
            sb[lane] = ac; sb[64 + lane] = gdt; sb[128 + lane] = __expf(aend - ac) * gdt; sb[192 + lane] = __expf(ac);
            if (lane == 0) scb[512 + w] = __expf(aend);
        }
        __syncthreads();
        {
            float val[4][8];
#pragma unroll
            for (int e = 0; e < 8; ++e) { const f32x4 cw = *(const LAS f32x4*)(cwt + (8 * c8 + e) * 4);
                float rv[6];
#pragma unroll
                for (int r_ = 0; r_ < 6; ++r_) { const unsigned x = (e < 2) ? raw[r_].x : (e < 4 ? raw[r_].y : (e < 6 ? raw[r_].z : raw[r_].w)); rv[r_] = (e & 1) ? __uint_as_float(x & 0xffff0000u) : __uint_as_float(x << 16); }
#pragma unroll
                for (int jj = 0; jj < 4; ++jj) { float v = cw[0] * rv[jj] + cw[1] * rv[jj + 1] + cw[2] * rv[jj + 2] + cw[3]; val[jj][e] = v / (1.f + __expf(-v)); } }
            const int i0 = d ? 60 - 4 * tokq : 4 * tokq;
            if (c8 < 16) {
                const int hx = c8 >> 3, p0 = 8 * (c8 & 7);
                LAS unsigned char* hb = lds + SO_HD + hx * SO_HSTRIDE; const LAS float* wv = scb + hx * 256 + 128;
                const float w0 = wv[i0], w1 = wv[i0 + 1], w2 = wv[i0 + 2], w3 = wv[i0 + 3];
#pragma unroll
                for (int e = 0; e < 8; ++e) { const float x0 = val[d ? 3 : 0][e], x1 = val[d ? 2 : 1][e], x2 = val[d ? 1 : 2][e], x3 = val[d ? 0 : 3][e];
                    u32x2 o; o.x = pk2(x0, x1); o.y = pk2(x2, x3); *(LAS u32x2*)(hb + SO_XT + (p0 + e) * SP_P + i0 * 2) = o;
                    u32x2 q; q.x = pk2(x0 * w0, x1 * w1); q.y = pk2(x2 * w2, x3 * w3); *(LAS u32x2*)(hb + SO_XW + (p0 + e) * SP_P + i0 * 2) = q; }
            } else if (c8 < 24) {
                const int n0 = 8 * (c8 - 16);
#pragma unroll
                for (int q = 0; q < 4; ++q) { const int jj = d ? 3 - q : q; v4u o; o.x = pk2(val[jj][0], val[jj][1]); o.y = pk2(val[jj][2], val[jj][3]); o.z = pk2(val[jj][4], val[jj][5]); o.w = pk2(val[jj][6], val[jj][7]);
                    *(LAS v4u*)(lds + SO_BS + (i0 + q) * SP_P + n0 * 2) = o; }
#pragma unroll
                for (int e = 0; e < 8; ++e) { u32x2 o; o.x = pk2(val[d ? 3 : 0][e], val[d ? 2 : 1][e]); o.y = pk2(val[d ? 1 : 2][e], val[d ? 0 : 3][e]);
                    *(LAS u32x2*)(lds + SO_BT + (n0 + e) * SP_P + i0 * 2) = o; }
            } else {
                const int n0 = 8 * (c8 - 24);
#pragma unroll
                for (int q = 0; q < 4; ++q) { const int jj = d ? 3 - q : q; v4u o; o.x = pk2(val[jj][0], val[jj][1]); o.y = pk2(val[jj][2], val[jj][3]); o.z = pk2(val[jj][4], val[jj][5]); o.w = pk2(val[jj][6], val[jj][7]);
                    *(LAS v4u*)(lds + SO_CS + (i0 + q) * SP_P + n0 * 2) = o; }
            }
        }
        if (c + 1 < (LC + TL) / 64) SB_LOAD(c + 1);
        __syncthreads();
        if (need_out) {
            const int ms = w >> 1, nt0 = 2 * (w & 1);
            f32x4 acc[2] = {(f32x4){0.f, 0.f, 0.f, 0.f}, (f32x4){0.f, 0.f, 0.f, 0.f}};
#pragma unroll
            for (int kk2 = 0; kk2 < 2; ++kk2) {
                const bf16x8 af = *(const LAS bf16x8*)(lds + SO_BS + (16 * ms + fr) * SP_P + (32 * kk2 + 8 * fq) * 2);
#pragma unroll
                for (int j = 0; j < 2; ++j) { const bf16x8 bfv = *(const LAS bf16x8*)(lds + SO_CS + (16 * (nt0 + j) + fr) * SP_P + (32 * kk2 + 8 * fq) * 2);
                    acc[j] = __builtin_amdgcn_mfma_f32_16x16x32_bf16(af, bfv, acc[j], 0, 0, 0); }
            }
            const int s0 = 16 * ms + 4 * fq;
#pragma unroll
            for (int hx = 0; hx < 2; ++hx) { const LAS float* sb = scb + hx * 256;
                const f32x4 as = *(const LAS f32x4*)(sb + s0), ds = *(const LAS f32x4*)(sb + 64 + s0);
#pragma unroll
                for (int j = 0; j < 2; ++j) { const int t = 16 * (nt0 + j) + fr; const float at = sb[t];
                    float v0 = (s0 + 0 <= t) ? acc[j][0] * __expf(at - as[0]) * ds[0] : 0.f, v1 = (s0 + 1 <= t) ? acc[j][1] * __expf(at - as[1]) * ds[1] : 0.f;
                    float v2 = (s0 + 2 <= t) ? acc[j][2] * __expf(at - as[2]) * ds[2] : 0.f, v3 = (s0 + 3 <= t) ? acc[j][3] * __expf(at - as[3]) * ds[3] : 0.f;
                    u32x2 o; o.x = pk2(v0, v1); o.y = pk2(v2, v3);
                    *(LAS u32x2*)(lds + SO_HD + hx * SO_HSTRIDE + SO_SP + t * SP_P + s0 * 2) = o; } }
        }
        __syncthreads();
        if (need_out) {
            LAS unsigned char* hb = lds + SO_HD + hl * SO_HSTRIDE; const LAS float* sb = scb + hl * 256;
            f32x4 a1[4], a2[4];
#pragma unroll
            for (int j = 0; j < 4; ++j) { a1[j] = (f32x4){0.f, 0.f, 0.f, 0.f}; a2[j] = (f32x4){0.f, 0.f, 0.f, 0.f}; }
#pragma unroll
            for (int kk2 = 0; kk2 < 2; ++kk2) {
                const bf16x8 ax = *(const LAS bf16x8*)(hb + SO_XT + (16 * wq + fr) * SP_P + (32 * kk2 + 8 * fq) * 2);
                const bf16x8 ah = *(const LAS bf16x8*)(hb + SO_HB + (16 * wq + fr) * SP_P + (32 * kk2 + 8 * fq) * 2);
#pragma unroll
                for (int j = 0; j < 4; ++j) { const bf16x8 bs = *(const LAS bf16x8*)(hb + SO_SP + (16 * j + fr) * SP_P + (32 * kk2 + 8 * fq) * 2);
                    const bf16x8 bc = *(const LAS bf16x8*)(lds + SO_CS + (16 * j + fr) * SP_P + (32 * kk2 + 8 * fq) * 2);
                    a1[j] = __builtin_amdgcn_mfma_f32_16x16x32_bf16(ax, bs, a1[j], 0, 0, 0);
                    a2[j] = __builtin_amdgcn_mfma_f32_16x16x32_bf16(ah, bc, a2[j], 0, 0, 0); }
            }
#pragma unroll
            for (int j = 0; j < 4; ++j) { const int t = 16 * j + fr; const float et = sb[192 + t];
                const int row = scan_row(c * 64 + t, d, b); const int p0 = 16 * wq + 4 * fq;
                bf16* yp = (d == 0 ? Y + (size_t)row * NY : (bf16*)(F.ws + WS_P) + (size_t)row * 1024) + 512 + head * 64 + p0;
                float y0 = a1[j][0] + et * a2[j][0], y1 = a1[j][1] + et * a2[j][1], y2 = a1[j][2] + et * a2[j][2], y3 = a1[j][3] + et * a2[j][3];
                if (d == 1) { const LAS unsigned short* xp = (const LAS unsigned short*)(hb + SO_XT + p0 * SP_P + t * 2);
                    y0 += dsk * bf2f(xp[0]); y1 += dsk * bf2f(xp[SP_P / 2]); y2 += dsk * bf2f(xp[2 * (SP_P / 2)]); y3 += dsk * bf2f(xp[3 * (SP_P / 2)]); }
                u32x2 o; o.x = pk2(y0, y1); o.y = pk2(y2, y3); *(u32x2*)yp = o; }
        }
        __syncthreads();
        {
            LAS unsigned char* hb = lds + SO_HD + hl * SO_HSTRIDE; const float dA = scb[512 + hl];
#pragma unroll
            for (int j = 0; j < 4; ++j) Hs[j] = Hs[j] * dA;
#pragma unroll
            for (int kk2 = 0; kk2 < 2; ++kk2) {
                const bf16x8 af = *(const LAS bf16x8*)(lds + SO_BT + (16 * wq + fr) * SP_P + (32 * kk2 + 8 * fq) * 2);
#pragma unroll
                for (int j = 0; j < 4; ++j) { const bf16x8 bfv = *(const LAS bf16x8*)(hb + SO_XW + (16 * j + fr) * SP_P + (32 * kk2 + 8 * fq) * 2);
                    Hs[j] = __builtin_amdgcn_mfma_f32_16x16x32_bf16(af, bfv, Hs[j], 0, 0, 0); }
            }
#pragma unroll
            for (int j = 0; j < 4; ++j) { u32x2 o; o.x = pk2(Hs[j][0], Hs[j][1]); o.y = pk2(Hs[j][2], Hs[j][3]);
                *(LAS u32x2*)(hb + SO_HB + (16 * j + fr) * SP_P + (16 * wq + 4 * fq) * 2) = o; }
        }
        __syncthreads();
    }
#undef SB_LOAD
    (void)a_neg;
}

__device__ __forceinline__ void ssd_unit(Frame& F, int L, int d, int unit) {
    const int h = unit & 7, b = unit >> 3, g = h >> 2, lane = F.lane;
    const bf16* U = (const bf16*)(F.ws + WS_B); const float* GATES = (const float*)(F.ws + WS_GATES); bf16* Y = (bf16*)(F.ws + WS_A);
    LAS float* buf = (LAS float*)(F.lds + RING_OFF + F.wave * 16384);
    constexpr int ST = 200;
    const int cx = h * 64 + lane, cb = 512 + g * 64 + lane, cc = 640 + g * 64 + lane;
    const float* cw = kin(I_CONVW) + (size_t)L * 3 * 768; const float* cbias = kin(I_CONVB) + (size_t)L * 768;
    const float wx0 = cw[cx], wx1 = cw[768 + cx], wx2 = cw[1536 + cx], bx = cbias[cx];
    const float wb0 = cw[cb], wb1 = cw[768 + cb], wb2 = cw[1536 + cb], bb = cbias[cb];
    const float wc0 = cw[cc], wc1 = cw[768 + cc], wc2 = cw[1536 + cc], bc = cbias[cc];
    const float a_neg = -expf(kin(I_ALOG)[L * 16 + d * 8 + h]);
    const float dsk = kin(I_SSDD)[L * 8 + h];
    float hs[64];
#pragma unroll
    for (int i = 0; i < 64; ++i) hs[i] = 0.f;
    unsigned short rx[10], rb[10], rc[10]; float pdt[8];
#define SSD_LOAD(nb_) do { const int s0_ = (nb_) * 8; const bool cx_ = s0_ < LC; const int seglen_ = cx_ ? LC : TL; int tf_ = cx_ ? s0_ : s0_ - LC; const int tlo_ = d ? seglen_ - 8 - tf_ : tf_; \
        const size_t rb0_ = cx_ ? (size_t)(ML + b * LC) : (size_t)(b * TL); \
        _Pragma("unroll") for (int i = 0; i < 10; ++i) { const int t_ = tlo_ - 1 + i; const bool ok_ = t_ >= 0 && t_ < seglen_; const bf16* ur_ = U + (rb0_ + (ok_ ? t_ : 0)) * NU + UX; \
            rx[i] = ok_ ? ur_[cx] : (unsigned short)0; rb[i] = ok_ ? ur_[cb] : (unsigned short)0; rc[i] = ok_ ? ur_[cc] : (unsigned short)0; } \
        _Pragma("unroll") for (int i = 0; i < 8; ++i) { const int r_ = scan_row(s0_ + i, d, b); pdt[i] = GATES[(size_t)r_ * 32 + 16 + d * 8 + h]; } } while (0)
    SSD_LOAD(0);
    for (int nb = 0; nb < (LC + TL) / 8; ++nb) {
#pragma unroll
        for (int i = 0; i < 8; ++i) { const int j = d ? 7 - i : i;
            LAS float* sl = buf + i * ST;
            float xv = wx0 * bf2f(rx[j]) + wx1 * bf2f(rx[j + 1]) + wx2 * bf2f(rx[j + 2]) + bx; xv = xv / (1.f + __expf(-xv));
            float bv = wb0 * bf2f(rb[j]) + wb1 * bf2f(rb[j + 1]) + wb2 * bf2f(rb[j + 2]) + bb; bv = bv / (1.f + __expf(-bv));
            float cv = wc0 * bf2f(rc[j]) + wc1 * bf2f(rc[j + 1]) + wc2 * bf2f(rc[j + 2]) + bc; cv = cv / (1.f + __expf(-cv));
            sl[lane] = bv; sl[64 + lane] = cv; sl[128 + lane] = xv; if (lane == 0) sl[192] = pdt[i]; }
        if (nb + 1 < (LC + TL) / 8) SSD_LOAD(nb + 1);
#pragma unroll 1
        for (int i = 0; i < 8; ++i) { const LAS float* sl = buf + i * ST;
            const float dt = sl[192], xv = sl[128 + lane], dA = __expf(dt * a_neg), dbx = dt * xv; float y = 0.f;
#pragma unroll
            for (int j = 0; j < 16; ++j) { const f32x4 Bv = *(const LAS f32x4*)(sl + 4 * j), Cv = *(const LAS f32x4*)(sl + 64 + 4 * j);
                hs[4 * j + 0] = dA * hs[4 * j + 0] + dbx * Bv.x; y += Cv.x * hs[4 * j + 0];
                hs[4 * j + 1] = dA * hs[4 * j + 1] + dbx * Bv.y; y += Cv.y * hs[4 * j + 1];
                hs[4 * j + 2] = dA * hs[4 * j + 2] + dbx * Bv.z; y += Cv.z * hs[4 * j + 2];
                hs[4 * j + 3] = dA * hs[4 * j + 3] + dbx * Bv.w; y += Cv.w * hs[4 * j + 3]; }
            const int s = nb * 8 + i;
            if (s >= LC || L == 0) { const int r = scan_row(s, d, b); bf16* yp = Y + (size_t)r * NY + 512 + h * 64 + lane;
                if (d == 0) *yp = f2bf_s(y); else *yp = f2bf_s(bf2f(*yp) + y + dsk * xv); }
        }
    }
#undef SSD_LOAD
}

typedef float f32x16 __attribute__((ext_vector_type(16)));
constexpr int AT_KP = 144, AT_VP = 136;
constexpr int AT_KB = 64 * AT_KP, AT_VB = 64 * AT_VP;
__device__ __forceinline__ void attn_block_unit(Frame& F, int L, int unit) {
    const bf16* U = (const bf16*)(F.ws + WS_B); bf16* Y = (bf16*)(F.ws + WS_A);
    const int tid = F.tid, lane = F.lane, w = F.wave, r = lane & 31, hf = lane >> 5;
    const bool lat = unit < 512;
    int b, g, qt;
    if (lat) { b = unit >> 6; g = (unit >> 5) & 1; qt = unit & 31; } else { const int u2 = unit - 512; b = u2 >> 3; g = (u2 >> 2) & 1; qt = u2 & 3; }
    const int t0 = qt * 64, hh = w >> 1, qh = w & 1, head = g * 4 + hh, t = t0 + 32 * qh + r;
    const size_t qrow = lat ? (size_t)(b * TL + t) : (size_t)(ML + b * LC + t);
    LAS unsigned char* Kt = F.lds + RING_OFF;
    LAS unsigned char* Vt = F.lds + RING_OFF + 2 * AT_KB;
    bf16x8 qf[4];
#pragma unroll
    for (int ks = 0; ks < 4; ++ks) qf[ks] = *(const bf16x8*)(U + qrow * NU + UAQ + head * 64 + 16 * ks + 8 * hf);
    const int rel_lo = lat ? (qt < 2 ? -qt : -2) : 0, rel_hi = lat ? (31 - qt < 2 ? 31 - qt : 2) : -1;
    const int ntiles = 4 + (rel_hi - rel_lo + 1);
    f32x16 o0, o1;
#pragma unroll
    for (int i = 0; i < 16; ++i) { o0[i] = 0.f; o1[i] = 0.f; }
    float mrun = kin(I_SINK)[L * 8 + head] * 1.4426950408889634f, lrun = (hf == 0) ? 1.f : 0.f;
    const int skk = tid >> 3, sc8 = tid & 7;
    v4u pk, pv;
#define AT_LOAD(i_) do { const int i__ = (i_); const size_t base_ = (i__ < 4) ? (size_t)(ML + b * LC + 64 * i__) : (size_t)(b * TL + t0 + 64 * (rel_lo + i__ - 4)); \
        const bf16* kp_ = U + (base_ + skk) * NU + g * 64 + 8 * sc8; pk = *(const v4u*)(kp_ + UAK); pv = *(const v4u*)(kp_ + UAV); } while (0)
#define AT_STORE(buf_) do { *(LAS v4u*)(Kt + (buf_) * AT_KB + skk * AT_KP + sc8 * 16) = pk; LAS unsigned short* vb_ = (LAS unsigned short*)(Vt + (buf_) * AT_VB + (8 * sc8) * AT_VP + skk * 2); \
        vb_[0 * (AT_VP / 2)] = (unsigned short)(pv.x & 0xffffu); vb_[1 * (AT_VP / 2)] = (unsigned short)(pv.x >> 16); vb_[2 * (AT_VP / 2)] = (unsigned short)(pv.y & 0xffffu); vb_[3 * (AT_VP / 2)] = (unsigned short)(pv.y >> 16); \
        vb_[4 * (AT_VP / 2)] = (unsigned short)(pv.z & 0xffffu); vb_[5 * (AT_VP / 2)] = (unsigned short)(pv.z >> 16); vb_[6 * (AT_VP / 2)] = (unsigned short)(pv.w & 0xffffu); vb_[7 * (AT_VP / 2)] = (unsigned short)(pv.w >> 16); } while (0)
    __syncthreads();
    AT_LOAD(0); AT_STORE(0);
    __syncthreads();
    for (int i = 0; i < ntiles; ++i) {
        const int buf = i & 1;
        if (i + 1 < ntiles) AT_LOAD(i + 1);
        const LAS unsigned char* kb = Kt + buf * AT_KB; const LAS unsigned char* vb = Vt + buf * AT_VB;
        f32x16 s0, s1;
#pragma unroll
        for (int e = 0; e < 16; ++e) { s0[e] = 0.f; s1[e] = 0.f; }
#pragma unroll
        for (int ks = 0; ks < 4; ++ks) {
            const bf16x8 k0 = *(const LAS bf16x8*)(kb + r * AT_KP + (16 * ks + 8 * hf) * 2), k1 = *(const LAS bf16x8*)(kb + (32 + r) * AT_KP + (16 * ks + 8 * hf) * 2);
            s0 = __builtin_amdgcn_mfma_f32_32x32x16_bf16(k0, qf[ks], s0, 0, 0, 0);
            s1 = __builtin_amdgcn_mfma_f32_32x32x16_bf16(k1, qf[ks], s1, 0, 0, 0);
        }
        if (i >= 4) { const int rel = rel_lo + i - 4;
            if (rel == 2 || rel == -2) { const int dbase = 64 * rel - 32 * qh - r + 4 * hf;
#pragma unroll
                for (int e = 0; e < 16; ++e) { const int d0 = dbase + (e & 3) + 8 * (e >> 2), d1 = d0 + 32;
                    if (d0 > 128 || d0 < -128) s0[e] = -INFINITY; if (d1 > 128 || d1 < -128) s1[e] = -INFINITY; } } }
        float tm = s0[0];
#pragma unroll
        for (int e = 1; e < 16; ++e) tm = fmaxf(tm, s0[e]);
#pragma unroll
        for (int e = 0; e < 16; ++e) tm = fmaxf(tm, s1[e]);
        tm = fmaxf(tm, __shfl_xor(tm, 32));
        const float mn = fmaxf(mrun, tm), al = __builtin_amdgcn_exp2f(mrun - mn); mrun = mn;
        float ps = 0.f;
#pragma unroll
        for (int e = 0; e < 16; ++e) { s0[e] = __builtin_amdgcn_exp2f(s0[e] - mn); s1[e] = __builtin_amdgcn_exp2f(s1[e] - mn); ps += s0[e] + s1[e]; }
        lrun = lrun * al + ps;
#pragma unroll
        for (int e = 0; e < 16; ++e) { o0[e] *= al; o1[e] *= al; }
        bf16x8 pf[4];
#pragma unroll
        for (int s2 = 0; s2 < 2; ++s2) {
            unsigned a0 = pk2(s0[8 * s2 + 0], s0[8 * s2 + 1]), a1 = pk2(s0[8 * s2 + 2], s0[8 * s2 + 3]), a2 = pk2(s0[8 * s2 + 4], s0[8 * s2 + 5]), a3 = pk2(s0[8 * s2 + 6], s0[8 * s2 + 7]);
            unsigned c0 = pk2(s1[8 * s2 + 0], s1[8 * s2 + 1]), c1 = pk2(s1[8 * s2 + 2], s1[8 * s2 + 3]), c2 = pk2(s1[8 * s2 + 4], s1[8 * s2 + 5]), c3 = pk2(s1[8 * s2 + 6], s1[8 * s2 + 7]);
            v4u x; x.x = a0; x.y = a1; x.z = a2; x.w = a3; pf[s2] = __builtin_bit_cast(bf16x8, x);
            v4u y; y.x = c0; y.y = c1; y.z = c2; y.w = c3; pf[2 + s2] = __builtin_bit_cast(bf16x8, y);
        }
#pragma unroll
        for (int ks = 0; ks < 4; ++ks) {
            const int kofs = (16 * ks + 4 * hf) * 2;
            typedef unsigned u32x2 __attribute__((ext_vector_type(2)));
            const u32x2 a_lo0 = *(const LAS u32x2*)(vb + r * AT_VP + kofs), a_hi0 = *(const LAS u32x2*)(vb + r * AT_VP + kofs + 16);
            const u32x2 a_lo1 = *(const LAS u32x2*)(vb + (32 + r) * AT_VP + kofs), a_hi1 = *(const LAS u32x2*)(vb + (32 + r) * AT_VP + kofs + 16);
            v4u va; va.x = a_lo0.x; va.y = a_lo0.y; va.z = a_hi0.x; va.w = a_hi0.y;
            v4u vc; vc.x = a_lo1.x; vc.y = a_lo1.y; vc.z = a_hi1.x; vc.w = a_hi1.y;
            o0 = __builtin_amdgcn_mfma_f32_32x32x16_bf16(__builtin_bit_cast(bf16x8, va), pf[ks], o0, 0, 0, 0);
            o1 = __builtin_amdgcn_mfma_f32_32x32x16_bf16(__builtin_bit_cast(bf16x8, vc), pf[ks], o1, 0, 0, 0);
        }
        if (i + 1 < ntiles) AT_STORE(buf ^ 1);
        __syncthreads();
    }
#undef AT_LOAD
#undef AT_STORE
    const float il = 1.f / (lrun + __shfl_xor(lrun, 32));
    bf16* yp = Y + qrow * NY + 1024 + head * 64 + 4 * hf;
    typedef unsigned u32x2s __attribute__((ext_vector_type(2)));
#pragma unroll
    for (int gq = 0; gq < 4; ++gq) {
        u32x2s w0; w0.x = pk2(o0[4 * gq] * il, o0[4 * gq + 1] * il); w0.y = pk2(o0[4 * gq + 2] * il, o0[4 * gq + 3] * il);
        u32x2s w1; w1.x = pk2(o1[4 * gq] * il, o1[4 * gq + 1] * il); w1.y = pk2(o1[4 * gq + 2] * il, o1[4 * gq + 3] * il);
        *(u32x2s*)(yp + 8 * gq) = w0; *(u32x2s*)(yp + 32 + 8 * gq) = w1;
    }
}

__device__ __forceinline__ void phase_finish(Frame& F, int L) {
    const bf16* U = (const bf16*)(F.ws + WS_B); bf16* Y = (bf16*)(F.ws + WS_A);
    const int gw = blockIdx.x * NWAVES + F.wave, NGW = F.G * NWAVES, lane = F.lane, nrows = (L == 0) ? MT : ML;
    float g1[8], g2[8];
#pragma unroll
    for (int j = 0; j < 8; ++j) { g1[j] = kin(I_MLNG)[L * 512 + 8 * lane + j]; g2[j] = kin(I_SSDNG)[L * 512 + 8 * lane + j]; }
    for (int r = gw; r < nrows; r += NGW) {
        bf16* yr = Y + (size_t)r * NY; const bf16* ur = U + (size_t)r * NU;
        const bf16* pr = (const bf16*)(F.ws + WS_P) + (size_t)r * 1024;
        { const v4u hw = *(const v4u*)(yr + 8 * lane), ow = *(const v4u*)(ur + UO + 8 * lane), pw = *(const v4u*)(pr + 8 * lane);
          float hv[8], ov[8];
          hv[0] = __uint_as_float(hw.x << 16); hv[1] = __uint_as_float(hw.x & 0xffff0000u); hv[2] = __uint_as_float(hw.y << 16); hv[3] = __uint_as_float(hw.y & 0xffff0000u);
          hv[4] = __uint_as_float(hw.z << 16); hv[5] = __uint_as_float(hw.z & 0xffff0000u); hv[6] = __uint_as_float(hw.w << 16); hv[7] = __uint_as_float(hw.w & 0xffff0000u);
          ov[0] = __uint_as_float(ow.x << 16); ov[1] = __uint_as_float(ow.x & 0xffff0000u); ov[2] = __uint_as_float(ow.y << 16); ov[3] = __uint_as_float(ow.y & 0xffff0000u);
          ov[4] = __uint_as_float(ow.z << 16); ov[5] = __uint_as_float(ow.z & 0xffff0000u); ov[6] = __uint_as_float(ow.w << 16); ov[7] = __uint_as_float(ow.w & 0xffff0000u);
          hv[0] += __uint_as_float(pw.x << 16); hv[1] += __uint_as_float(pw.x & 0xffff0000u); hv[2] += __uint_as_float(pw.y << 16); hv[3] += __uint_as_float(pw.y & 0xffff0000u);
          hv[4] += __uint_as_float(pw.z << 16); hv[5] += __uint_as_float(pw.z & 0xffff0000u); hv[6] += __uint_as_float(pw.w << 16); hv[7] += __uint_as_float(pw.w & 0xffff0000u);
          float ss = 0.f;
#pragma unroll
          for (int j = 0; j < 8; ++j) ss += hv[j] * hv[j];
#pragma unroll
          for (int o = 1; o < 16; o <<= 1) ss += __shfl_xor(ss, o);
          const float rs = 1.0f / sqrtf(ss * (1.f / 128.f) + EPS);
          float rv[8];
#pragma unroll
          for (int j = 0; j < 8; ++j) rv[j] = hv[j] * rs * g1[j] / (1.f + __expf(-ov[j]));
          v4u w; w.x = pk2(rv[0], rv[1]); w.y = pk2(rv[2], rv[3]); w.z = pk2(rv[4], rv[5]); w.w = pk2(rv[6], rv[7]);
          *(v4u*)(yr + 8 * lane) = w; }
        { const v4u hw = *(const v4u*)(yr + 512 + 8 * lane), zw = *(const v4u*)(ur + UZ + 8 * lane), pw = *(const v4u*)(pr + 512 + 8 * lane);
          float hv[8], zv[8];
          hv[0] = __uint_as_float(hw.x << 16); hv[1] = __uint_as_float(hw.x & 0xffff0000u); hv[2] = __uint_as_float(hw.y << 16); hv[3] = __uint_as_float(hw.y & 0xffff0000u);
          hv[4] = __uint_as_float(hw.z << 16); hv[5] = __uint_as_float(hw.z & 0xffff0000u); hv[6] = __uint_as_float(hw.w << 16); hv[7] = __uint_as_float(hw.w & 0xffff0000u);
          zv[0] = __uint_as_float(zw.x << 16); zv[1] = __uint_as_float(zw.x & 0xffff0000u); zv[2] = __uint_as_float(zw.y << 16); zv[3] = __uint_as_float(zw.y & 0xffff0000u);
          zv[4] = __uint_as_float(zw.z << 16); zv[5] = __uint_as_float(zw.z & 0xffff0000u); zv[6] = __uint_as_float(zw.w << 16); zv[7] = __uint_as_float(zw.w & 0xffff0000u);
          hv[0] += __uint_as_float(pw.x << 16); hv[1] += __uint_as_float(pw.x & 0xffff0000u); hv[2] += __uint_as_float(pw.y << 16); hv[3] += __uint_as_float(pw.y & 0xffff0000u);
          hv[4] += __uint_as_float(pw.z << 16); hv[5] += __uint_as_float(pw.z & 0xffff0000u); hv[6] += __uint_as_float(pw.w << 16); hv[7] += __uint_as_float(pw.w & 0xffff0000u);
          float ss = 0.f;
#pragma unroll
          for (int j = 0; j < 8; ++j) { hv[j] = hv[j] * zv[j] / (1.f + __expf(-zv[j])); ss += hv[j] * hv[j]; }
          ss = wave_sum(ss);
          const float rs = 1.0f / sqrtf(ss * (1.f / 512.f) + EPS);
          v4u w; w.x = pk2(hv[0] * rs * g2[0], hv[1] * rs * g2[1]); w.y = pk2(hv[2] * rs * g2[2], hv[3] * rs * g2[3]); w.z = pk2(hv[4] * rs * g2[4], hv[5] * rs * g2[5]); w.w = pk2(hv[6] * rs * g2[6], hv[7] * rs * g2[7]);
          *(v4u*)(yr + 512 + 8 * lane) = w; }
    }
}

#ifdef NO_MLSTM
#define MLSTM_CALL(d)
#else
#define MLSTM_CALL(d) if (u < 128) mlstm_unit(F, L, d, u);
#endif
#ifdef NO_MLSTMB
#define MLSTMB_CALL(d, u)
#else
#define MLSTMB_CALL(d, u) mlstm_block_unit(F, L, d, u);
#endif
#ifdef NO_SSDB
#define SSDB_CALL(d, u)
#else
#define SSDB_CALL(d, u) ssd_block_unit(F, L, d, u);
#endif
#ifdef NO_SSD
#define SSD_CALL(d)
#else
#define SSD_CALL(d) if (u >= 128) ssd_unit(F, L, d, u - 128);
#endif
#ifdef NO_ATTN
#define ATTN_CALL ;
#else
#define ATTN_CALL attn_block_unit(F, L, u);
#endif
#ifndef DUP_MASK
#define DUP_MASK 0
#endif
#define TWICE(p, ...) do { { __VA_ARGS__ } if (((DUP_MASK) >> (p)) & 1) { __syncthreads(); asm volatile("" : "+v"(F.lane), "+v"(F.tid)); F.wave = __builtin_amdgcn_readfirstlane(F.tid >> 6); { __VA_ARGS__ } } } while (0)
struct Args { const float* in[24]; float* out; unsigned char* ws; int ph_lo, ph_hi; };
__global__ void __launch_bounds__(NWAVES * 64, 2) mk_fwd(Args args) {
    extern __shared__ __attribute__((aligned(16))) unsigned char lds[];
    Frame F;
    F.lds = (LAS unsigned char*)lds;
    F.MISC = (volatile LAS unsigned*)(F.lds + MISC_OFF);
    F.tid = threadIdx.x; F.lane = F.tid & 63; F.wave = __builtin_amdgcn_readfirstlane(F.tid >> 6);
    F.G = gridDim.x;
    F.ws = args.ws; F.out = args.out; F.ctl = (gu32*)(args.ws + WS_CTL);
    for (int u = F.tid; u < (LDS_BYTES - LDSCTL_OFF) / 4; u += NWAVES * 64) ((LAS unsigned*)(F.lds + LDSCTL_OFF))[u] = 0u;
    __syncthreads();
    const int lo = args.ph_lo, hi = args.ph_hi;
    const bool use_bar = (hi - lo) > 1;
    XcdBarrier bar; bar.bar = (unsigned*)(F.ctl + CW_BAR); bar.x = 0; bar.st = nullptr;
    if (use_bar) bar = xcd_barrier_post((unsigned*)(F.ctl + CW_BAR), F.MISC + 8);
#define IN(k) (lo <= (k) && (k) < hi)
#define XL ((L == 0) ? kin(I_X) : (const float*)F.out)
#define XC ((L == 0) ? kin(I_CTX) : (const float*)(F.ws + WS_CTXF))
#define SEAM(k) do { if (IN(k) && IN((k) + 1)) xcd_barrier(bar); asm volatile("" : "+v"(F.lane), "+v"(F.tid)); F.wave = __builtin_amdgcn_readfirstlane(F.tid >> 6); } while (0)

    bf16* W0 = (bf16*)(F.ws + WS_W0); bf16* W1 = (bf16*)(F.ws + WS_W1);
    bf16* RA = (bf16*)(F.ws + WS_A); bf16* RB = (bf16*)(F.ws + WS_B);
    float* CTXF = (float*)(F.ws + WS_CTXF);
    const float* MOD = (const float*)(F.ws + WS_MOD);

        if (IN(0)) { phase_mod(F); }
    SEAM(0);

    for (int L = 0; L < 2; ++L) {
        const int p0 = 1 + 9 * L;
        const int Mout = (L == 0) ? MT : ML;
        if (IN(p0 + 0)) TWICE(0,
            convert_win(F, kin(I_WIN) + (size_t)L * DM * INW, W0);
            convert_weight(F, kin(I_WOUT) + (size_t)L * NY * DM, NY, DM, W1);
            __syncthreads();
            LAS float* gwl = (LAS float*)(F.lds + RING_OFF);
            { const v4u* gsrc = (const v4u*)((const float*)(F.ws + WS_GW) + (size_t)L * 32768);
              _Pragma("unroll") for (int i = 0; i < 16; ++i) *(LAS v4u*)((LAS unsigned char*)gwl + (size_t)(i * 512 + F.tid) * 16) = gsrc[i * 512 + F.tid]; }
            __syncthreads();
            norm_rows<true>(F, L, MT, XL, XC, kin(I_N1G) + L * DM, 0, RA, gwl);
            __syncthreads();
        );
        SEAM(p0 + 0);
        if (IN(p0 + 1)) TWICE(1,
            pg8::Gemm g{RA, W0, MT, NU, DM}; pg8::StaticOrder S; S.init(MT, NU, F.G, (int)blockIdx.x);
            pg8::EpiBf16<0> E{RB, NU};
            pg8::gemm_phase<pg8::EpiBf16<0>, pg8::StaticOrder, true, true>(F.lds + RING_OFF, g, S, E);
        );
        SEAM(p0 + 1);
        if (IN(p0 + 2)) { phase_qkn(F, L); }
        SEAM(p0 + 2);
        if (IN(p0 + 3)) {
            if (blockIdx.x < 64) { MLSTMB_CALL((int)blockIdx.x >> 5, (int)blockIdx.x & 31) }
            else if (blockIdx.x < 128) { SSDB_CALL(((int)blockIdx.x - 64) >> 5, ((int)blockIdx.x - 64) & 31) }
            else { const int nun = (L == 0) ? 576 : 512; for (int u = blockIdx.x - 128; u < nun; u += F.G - 128) { ATTN_CALL } }
            __syncthreads();
        }
        SEAM(p0 + 3);
        if (IN(p0 + 4)) { phase_finish(F, L); }
        SEAM(p0 + 4);
        if (IN(p0 + 5)) {
            pg8::Gemm g{RA, W1, Mout, DM, NY}; pg8::StaticOrder S; S.init(Mout, DM, F.G, (int)blockIdx.x);
            pg8::EpiRes E{XL, F.out, XC, CTXF, MOD + (size_t)L * 9 * 6144 + 2 * 1024};
            pg8::gemm_phase<pg8::EpiRes, pg8::StaticOrder, true, true>(F.lds + RING_OFF, g, S, E);
        }
        SEAM(p0 + 5);
        if (IN(p0 + 6)) TWICE(6,
            convert_weight(F, kin(I_WUP) + (size_t)L * DM * DFF, DM, DFF, W0);
            convert_weight(F, kin(I_WDOWN) + (size_t)L * DFF * DM, DFF, DM, W1);
            norm_rows<false>(F, L, Mout, (const float*)F.out, (const float*)CTXF, kin(I_N2G) + L * DM, 3, RA, nullptr);
        );
        SEAM(p0 + 6);
        if (IN(p0 + 7)) TWICE(7,
            pg8::Gemm g{RA, W0, Mout, DFF, DM}; pg8::StaticOrder S; S.init(Mout, DFF, F.G, (int)blockIdx.x);
            pg8::EpiBf16<2> E{RB, DFF};
            pg8::gemm_phase<pg8::EpiBf16<2>, pg8::StaticOrder, true, true>(F.lds + RING_OFF, g, S, E);
        );
        SEAM(p0 + 7);
        if (IN(p0 + 8)) {
            pg8::Gemm g{RB, W1, Mout, DM, DFF}; pg8::StaticOrder S; S.init(Mout, DM, F.G, (int)blockIdx.x);
            pg8::EpiRes E{(const float*)F.out, F.out, (const float*)CTXF, CTXF, MOD + (size_t)L * 9 * 6144 + 5 * 1024};
            pg8::gemm_phase<pg8::EpiRes, pg8::StaticOrder, true, true>(F.lds + RING_OFF, g, S, E);
        }
        SEAM(p0 + 8);
    }
#undef IN
#undef SEAM
}

#ifndef MK_N_LAUNCHES
#define MK_N_LAUNCHES 1
#endif
extern "C" void kernel_launch(void* const* d_in, const int* in_sizes, int n_in, void* d_out, int out_size, void* d_ws, size_t ws_size, hipStream_t stream) {
    static int grid = 0;
    if (grid == 0) {
        if (n_in != 24 || out_size != ML * DM || ws_size < WS_END) { fprintf(stderr, "kernel_launch: unexpected shapes (n_in %d out %d ws %zu)\n", n_in, out_size, ws_size); grid = -1; return; }
        int dev = 0, cus = 0, per_cu = 0;
        if (hipGetDevice(&dev) != hipSuccess || hipDeviceGetAttribute(&cus, hipDeviceAttributeMultiprocessorCount, dev) != hipSuccess) { grid = -1; return; }
        if (hipFuncSetAttribute((const void*)mk_fwd, hipFuncAttributeMaxDynamicSharedMemorySize, LDS_BYTES) != hipSuccess) { fprintf(stderr, "kernel_launch: hipFuncSetAttribute failed\n"); grid = -1; return; }
        if (hipOccupancyMaxActiveBlocksPerMultiprocessor(&per_cu, (const void*)mk_fwd, NWAVES * 64, LDS_BYTES) != hipSuccess || per_cu < 1) fprintf(stderr, "kernel_launch: occupancy query reports %d\n", per_cu);
        (void)hipGetLastError();
        grid = cus;
    }
    if (grid < 0) return;
    if (hipMemsetAsync((char*)d_ws + WS_CTL, 0, CTL_ZERO_BYTES, stream) != hipSuccess) return;
    Args a{};
    for (int i = 0; i < 24; ++i) a.in[i] = (const float*)d_in[i];
    a.out = (float*)d_out; a.ws = (unsigned char*)d_ws;
    if (MK_N_LAUNCHES == 1) { a.ph_lo = 0; a.ph_hi = NPH; hipLaunchKernelGGL(mk_fwd, dim3(grid), dim3(NWAVES * 64), LDS_BYTES, stream, a); }
    else { for (int p = 0; p < NPH; ++p) { a.ph_lo = p; a.ph_hi = p + 1; hipLaunchKernelGGL(mk_fwd, dim3(grid), dim3(NWAVES * 64), LDS_BYTES, stream, a); } }
}
```

```cpp
#include <hip/hip_runtime.h>
#include <cstdio>
#include <cstdint>
#include <cmath>
namespace pg8 {
#define PG8_LAS __attribute__((address_space(3)))
typedef unsigned short bf16_t;
typedef short bf16x8 __attribute__((ext_vector_type(8)));
typedef float f32x4 __attribute__((ext_vector_type(4)));
typedef unsigned u32x4 __attribute__((ext_vector_type(4)));
constexpr int BM = 256, BK = 64, HALF = 128, HTB = HALF * BK * 2  , STAGE_BYTES = 8 * HTB, NXCD = 8, WGM = 8;

__host__ __device__ __forceinline__ int lds_byte(int r, int c) { const int st = (r >> 4) * 2 + (c >> 5), rr = r & 15, cc = c & 31, ob = rr * 64 + cc * 2; return st * 1024 + (ob ^ (((ob >> 9) & 1) << 5)); }
__host__ __device__ __forceinline__ void stage_rc(int b, int& R, int& C) { const int st = b / 1024, sb = b % 1024, swz = sb ^ (((sb >> 9) & 1) << 5); R = (st >> 1) * 16 + swz / 64; C = (st & 1) * 32 + (swz % 64) / 2; }
__host__ __device__ __forceinline__ int perm32(int rho) { const int n = rho >> 4, i = rho & 15; return 8 * (i >> 2) + 4 * n + (i & 3); }

struct Unit { int pm, pn; };
struct Gemm { const bf16_t* A; const bf16_t* Bt; int M, N, K; };

struct StaticOrder {
    int nM, nN, nwg, G, c;
    __host__ __device__ void init(int M, int N, int G_, int c_) { nM = M / BM; nN = N / BM; nwg = nM * nN; G = G_; c = c_; }
    __host__ __device__ bool next(int i, Unit& u) const {
        const long L = (long)i * G + c; if (L >= nwg) return false;
        int wgid = (int)L; { const int q = nwg / NXCD, r = nwg % NXCD, xcd = wgid % NXCD, off = wgid / NXCD; wgid = (xcd < r ? xcd * (q + 1) : r * (q + 1) + (xcd - r) * q) + off; }
        const int nig = WGM * nN, gid = wgid / nig, fm = gid * WGM, gsz = (nM - fm) < WGM ? (nM - fm) : WGM;
        u.pm = fm + ((wgid % nig) % gsz); u.pn = (wgid % nig) / gsz; return true;
    }
    __device__ __forceinline__ void a_ready(const Unit&) const {}
    __device__ __forceinline__ void done(const Unit&) const {}
};

__device__ __forceinline__ unsigned cvt_pk_bf16(float lo, float hi) { unsigned r; asm volatile("v_cvt_pk_bf16_f32 %0, %1, %2" : "=v"(r) : "v"(lo), "v"(hi)); return r; }
typedef float f32x2 __attribute__((ext_vector_type(2)));
__device__ __forceinline__ f32x2 gelu_pk(f32x2 v) {
    const f32x2 av = __builtin_elementwise_abs(v), d = av * 0.2316418882f + 1.0f;
    f32x2 t; t.x = __builtin_amdgcn_rcpf(d.x); t.y = __builtin_amdgcn_rcpf(d.y);
    f32x2 q = t * 0.5307027145f + (-0.7265760135f); q = q * t + 0.7107068705f; q = q * t + (-0.142248368f); q = q * t + 0.127414796f; q = q * t;
    const f32x2 s = (v * v) * (-0.72134752044f);
    f32x2 e; e.x = __builtin_amdgcn_exp2f(s.x); e.y = __builtin_amdgcn_exp2f(s.y);
    const f32x2 m = v * (q * e), r = v - m;
    f32x2 o; o.x = v.x < 0.f ? m.x : r.x; o.y = v.y < 0.f ? m.y : r.y; return o;
}

template <int ACT  > struct EpiBf16 {
    static constexpr bool PERM = true, AFTER_DRAIN = false;
    bf16_t* O; int ldc;
    __device__ __forceinline__ void operator()(const f32x4 (&acc)[2][2][4][2], const Unit& u, int wr, int wc, int fr, int fq) const {
        const int row0 = u.pm * BM + wr * 64 + fr; const int col0 = u.pn * BM + wc * 32 + 8 * fq;
#pragma unroll
        for (int ai = 0; ai < 2; ++ai)
#pragma unroll
            for (int m = 0; m < 4; ++m) { bf16_t* rowp = O + (size_t)(row0 + ai * HALF + m * 16) * ldc + col0;
#pragma unroll
                for (int bj = 0; bj < 2; ++bj) { f32x4 v0 = acc[ai][bj][m][0], v1 = acc[ai][bj][m][1];
                    if (ACT == 2) {
#pragma unroll
                        for (int e = 0; e < 4; ++e) { float a = v0[e] > 0.f ? v0[e] : 0.f; v0[e] = a * a; float b = v1[e] > 0.f ? v1[e] : 0.f; v1[e] = b * b; } }
                    u32x4 w; w.x = cvt_pk_bf16(v0[0], v0[1]); w.y = cvt_pk_bf16(v0[2], v0[3]); w.z = cvt_pk_bf16(v1[0], v1[1]); w.w = cvt_pk_bf16(v1[2], v1[3]);
                    *(u32x4*)(rowp + bj * HALF) = w; } }
    }
};
struct EpiRes {
    static constexpr bool PERM = false, AFTER_DRAIN = false;
    const float* base_l; float* out_l; const float* base_c; float* out_c; const float* gate;
    __device__ __forceinline__ void operator()(const f32x4 (&acc)[2][2][4][2], const Unit& u, int wr, int wc, int fr, int fq) const {
        const bool lat = u.pm < 64;
        const float* bs = lat ? base_l + (size_t)u.pm * BM * 1024 : base_c + (size_t)(u.pm - 64) * BM * 1024;
        float* ot = lat ? out_l + (size_t)u.pm * BM * 1024 : out_c + (size_t)(u.pm - 64) * BM * 1024;
        const float* gt = gate + (size_t)(lat ? (u.pm >> 3) : 8) * 6144;
        const int col0 = u.pn * BM + wc * 32 + 4 * fq;
        f32x4 gv[2][2];
#pragma unroll
        for (int bj = 0; bj < 2; ++bj)
#pragma unroll
            for (int n = 0; n < 2; ++n) gv[bj][n] = *(const f32x4*)(gt + col0 + bj * HALF + n * 16);
#pragma unroll
        for (int ai = 0; ai < 2; ++ai)
#pragma unroll
            for (int m = 0; m < 4; ++m) { const size_t off = (size_t)(ai * HALF + wr * 64 + m * 16 + fr) * 1024 + col0;
#pragma unroll
                for (int bj = 0; bj < 2; ++bj)
#pragma unroll
                    for (int n = 0; n < 2; ++n) { const f32x4 b = *(const f32x4*)(bs + off + bj * HALF + n * 16);
                        *(f32x4*)(ot + off + bj * HALF + n * 16) = b + gv[bj][n] * acc[ai][bj][m][n]; }
                if (m & 1) asm volatile("" ::: "memory"); }
    }
};

struct EpiU {
    static constexpr bool PERM = true, AFTER_DRAIN = false;
    bf16_t* O; float* G; const float* gb;
    __device__ __forceinline__ void operator()(const f32x4 (&acc)[2][2][4][2], const Unit& u, int wr, int wc, int fr, int fq) const {
        const int row0 = u.pm * BM + wr * 64 + fr;
        if (u.pn < 16) {
            const int col0 = u.pn * BM + wc * 32 + 8 * fq;
#pragma unroll
            for (int ai = 0; ai < 2; ++ai)
#pragma unroll
                for (int m = 0; m < 4; ++m) { bf16_t* rowp = O + (size_t)(row0 + ai * HALF + m * 16) * 4096 + col0;
#pragma unroll
                    for (int bj = 0; bj < 2; ++bj) { const f32x4 v0 = acc[ai][bj][m][0], v1 = acc[ai][bj][m][1];
                        u32x4 w; w.x = cvt_pk_bf16(v0[0], v0[1]); w.y = cvt_pk_bf16(v0[2], v0[3]); w.z = cvt_pk_bf16(v1[0], v1[1]); w.w = cvt_pk_bf16(v1[2], v1[3]);
                        *(u32x4*)(rowp + bj * HALF) = w; } }
        } else if (wc == 0) {
            const int gj0 = 8 * fq; const f32x4 b0 = *(const f32x4*)(gb + gj0), b1 = *(const f32x4*)(gb + gj0 + 4);
#pragma unroll
            for (int ai = 0; ai < 2; ++ai)
#pragma unroll
                for (int m = 0; m < 4; ++m) { f32x4 v0 = acc[ai][0][m][0] + b0, v1 = acc[ai][0][m][1] + b1;
                    if (fq != 0) { const float sg = (fq == 1) ? -1.f : 1.f;
#pragma unroll
                        for (int e2 = 0; e2 < 4; ++e2) { const float z0 = v0[e2], z1 = v1[e2];
                            const float l0 = __logf(1.f + __expf(-fabsf(z0))), l1 = __logf(1.f + __expf(-fabsf(z1)));
                            v0[e2] = (fq == 1 ? fminf(z0, 0.f) : fmaxf(z0, 0.f)) + sg * l0; v1[e2] = (fq == 1 ? fminf(z1, 0.f) : fmaxf(z1, 0.f)) + sg * l1; } }
                    float* gp = G + (size_t)(row0 + ai * HALF + m * 16) * 32 + gj0;
                    *(f32x4*)gp = v0; *(f32x4*)(gp + 4) = v1; }
        }
    }
};

template <class Epi, class Sched, bool ALIGN_EPI = false, bool SP2 = false>
__device__ __forceinline__ void gemm_phase(PG8_LAS unsigned char* lds, const Gemm g, const Sched& S, const Epi& E) {
    int tid_l = threadIdx.x; asm volatile("" : "+v"(tid_l));
    const int tid = tid_l, wid = __builtin_amdgcn_readfirstlane(tid >> 6), lane = tid & 63, wr = wid >> 2, wc = wid & 3, fr = lane & 15, fq = lane >> 4;
    const int K = g.K, nt = K / BK;
    unsigned voffA[2], voffB[2];
#pragma unroll
    for (int i = 0; i < 2; ++i) { int R, C; stage_rc(tid * 16 + i * 8192, R, C); const int Rb = Epi::PERM ? ((R & ~31) + perm32(R & 31)) : R;
        voffA[i] = (unsigned)(R * K + C) * 2u; voffB[i] = (unsigned)(Rb * K + C) * 2u; }
    const size_t kstep = (size_t)(BK * 2);
    const size_t hstep = (size_t)HALF * K * 2;
    const size_t tstep = 2 * hstep;
    const unsigned ldsw = (unsigned)wid * 1024u;
    const int aoff = lds_byte(wr * 64 + fr, fq * 8), boff = lds_byte(wc * 32 + fr, fq * 8);
#define PG8_SA(b, h) (((b) * 2 + (h)) * HTB)
#define PG8_SB(b, h) ((4 + (b) * 2 + (h)) * HTB)
#define PG8_STAGE(bufoff, gbase, voff) do { _Pragma("unroll") for (int _i = 0; _i < 2; ++_i) \
        __builtin_amdgcn_global_load_lds((const unsigned*)((const char*)(gbase) + (voff)[_i]), (PG8_LAS unsigned*)(lds + (bufoff) + ldsw + _i * 8192), 16, 0, 0); } while (0)
#define PG8_LDA(dst, b, h) do { _Pragma("unroll") for (int m = 0; m < 4; ++m) _Pragma("unroll") for (int k = 0; k < 2; ++k) dst[m][k] = *(const PG8_LAS bf16x8*)(lds + PG8_SA(b, h) + aoff + m * 2048 + k * 1024); } while (0)
#define PG8_LDB(dst, b, h) do { _Pragma("unroll") for (int n = 0; n < 2; ++n) _Pragma("unroll") for (int k = 0; k < 2; ++k) dst[n][k] = *(const PG8_LAS bf16x8*)(lds + PG8_SB(b, h) + boff + n * 2048 + k * 1024); } while (0)
#define PG8_MMA(ai, bj, At, Bt) do { __builtin_amdgcn_s_setprio(1); _Pragma("unroll") for (int m = 0; m < 4; ++m) _Pragma("unroll") for (int n = 0; n < 2; ++n) _Pragma("unroll") for (int k = 0; k < 2; ++k) \
        acc[ai][bj][m][n] = __builtin_amdgcn_mfma_f32_16x16x32_bf16(Bt[n][k], At[m][k], acc[ai][bj][m][n], 0, 0, 0); __builtin_amdgcn_s_setprio(0); } while (0)
#define PG8_WAIT_V(n) asm volatile("s_waitcnt vmcnt(" #n ")" ::: "memory")
#define PG8_WAIT_L(n) asm volatile("s_waitcnt lgkmcnt(" #n ")" ::: "memory")
#define PG8_BAR __builtin_amdgcn_s_barrier()
#define PG8_SCHED __builtin_amdgcn_sched_barrier(0)
    Unit cur, nxt; int ui = 0;
    if (!S.next(0, cur)) return;
    f32x4 acc[2][2][4][2];
#pragma unroll
    for (int a = 0; a < 2; ++a)
#pragma unroll
        for (int b = 0; b < 2; ++b)
#pragma unroll
            for (int m = 0; m < 4; ++m)
#pragma unroll
                for (int n = 0; n < 2; ++n) acc[a][b][m][n] = (f32x4){0.f, 0.f, 0.f, 0.f};
    bf16x8 At[4][2], B0[2][2], B1[2][2];
    const char* cA = (const char*)g.A + (size_t)cur.pm * tstep; const char* cB = (const char*)g.Bt + (size_t)cur.pn * tstep;
    S.a_ready(cur);
    if constexpr (SP2) {
        PG8_STAGE(PG8_SB(0, 0), cB, voffB); PG8_STAGE(PG8_SB(0, 1), cB + hstep, voffB); PG8_STAGE(PG8_SA(0, 0), cA, voffA); PG8_STAGE(PG8_SA(0, 1), cA + hstep, voffA);
        if (wr == 1) PG8_BAR;
        PG8_WAIT_V(2); PG8_BAR;
        PG8_STAGE(PG8_SB(1, 0), cB + kstep, voffB); PG8_STAGE(PG8_SA(1, 0), cA + kstep, voffA); PG8_STAGE(PG8_SB(1, 1), cB + hstep + kstep, voffB);
        PG8_WAIT_V(6); PG8_BAR;
    } else {
        PG8_STAGE(PG8_SB(0, 0), cB, voffB); PG8_STAGE(PG8_SA(0, 0), cA, voffA); PG8_STAGE(PG8_SB(0, 1), cB + hstep, voffB); PG8_STAGE(PG8_SA(0, 1), cA + hstep, voffA);
        if (wr == 1) PG8_BAR;
        PG8_WAIT_V(4); PG8_BAR;
        PG8_STAGE(PG8_SB(1, 0), cB + kstep, voffB); PG8_STAGE(PG8_SA(1, 0), cA + kstep, voffA); PG8_STAGE(PG8_SB(1, 1), cB + hstep + kstep, voffB);
        PG8_WAIT_V(6); PG8_BAR;
    }
    for (;;) {
        const bool has_next = S.next(ui + 1, nxt);
        const char* nA = has_next ? (const char*)g.A + (size_t)nxt.pm * tstep : cA; const char* nB = has_next ? (const char*)g.Bt + (size_t)nxt.pn * tstep : cB;
        for (int t = 0; t < nt; t += 2) {
            const bool last = (t == nt - 2);
            const char* a1 = cA + (size_t)(t + 1) * kstep;
            const char* a2 = last ? nA : cA + (size_t)(t + 2) * kstep; const char* b2 = last ? nB : cB + (size_t)(t + 2) * kstep;
            const char* a3 = a2 + kstep; const char* b3 = b2 + kstep;
            if (last && has_next) S.a_ready(nxt);
            if constexpr (SP2) {
            PG8_LDB(B0, 0, 0); PG8_LDB(B1, 0, 1); PG8_SCHED; PG8_LDA(At, 0, 0); PG8_STAGE(PG8_SA(1, 1), a1 + hstep, voffA);
            PG8_WAIT_V(8); PG8_WAIT_L(0); PG8_BAR; PG8_MMA(0, 0, At, B0); PG8_MMA(0, 1, At, B1); PG8_BAR; PG8_SCHED;
            PG8_LDA(At, 0, 1); PG8_STAGE(PG8_SB(0, 0), b2, voffB); PG8_STAGE(PG8_SB(0, 1), b2 + hstep, voffB); PG8_STAGE(PG8_SA(0, 0), a2, voffA);
            PG8_WAIT_V(8); PG8_WAIT_L(0); PG8_BAR; PG8_MMA(1, 0, At, B0); PG8_MMA(1, 1, At, B1); PG8_BAR; PG8_SCHED;
            PG8_LDB(B0, 1, 0); PG8_LDB(B1, 1, 1); PG8_SCHED; PG8_LDA(At, 1, 0); PG8_STAGE(PG8_SA(0, 1), a2 + hstep, voffA);
            PG8_WAIT_V(8); PG8_WAIT_L(0); PG8_BAR; PG8_MMA(0, 0, At, B0); PG8_MMA(0, 1, At, B1); PG8_BAR; PG8_SCHED;
            PG8_LDA(At, 1, 1); PG8_STAGE(PG8_SB(1, 0), b3, voffB); PG8_STAGE(PG8_SB(1, 1), b3 + hstep, voffB); PG8_STAGE(PG8_SA(1, 0), a3, voffA);
            PG8_WAIT_V(8); PG8_WAIT_L(0); PG8_BAR; PG8_MMA(1, 0, At, B0); PG8_MMA(1, 1, At, B1); PG8_BAR; PG8_SCHED;
            } else {
            PG8_LDB(B0, 0, 0); PG8_SCHED; PG8_LDA(At, 0, 0); PG8_STAGE(PG8_SA(1, 1), a1 + hstep, voffA);
            PG8_WAIT_L(8); PG8_BAR; PG8_WAIT_L(0); PG8_MMA(0, 0, At, B0); PG8_BAR; PG8_SCHED;
            PG8_LDB(B1, 0, 1); PG8_STAGE(PG8_SB(0, 0), b2, voffB);
            PG8_BAR; PG8_WAIT_L(0); PG8_MMA(0, 1, At, B1); PG8_BAR;
            PG8_LDA(At, 0, 1); PG8_STAGE(PG8_SA(0, 0), a2, voffA);
            PG8_BAR; PG8_WAIT_L(0); PG8_MMA(1, 0, At, B0); PG8_BAR; PG8_SCHED;
            PG8_STAGE(PG8_SB(0, 1), b2 + hstep, voffB);
            PG8_WAIT_V(6); PG8_BAR; PG8_MMA(1, 1, At, B1); PG8_BAR;
            PG8_LDB(B0, 1, 0); PG8_SCHED; PG8_LDA(At, 1, 0); PG8_STAGE(PG8_SA(0, 1), a2 + hstep, voffA);
            PG8_WAIT_L(8); PG8_BAR; PG8_WAIT_L(0); PG8_MMA(0, 0, At, B0); PG8_BAR; PG8_SCHED;
            PG8_LDB(B1, 1, 1); PG8_STAGE(PG8_SB(1, 0), b3, voffB);
            PG8_BAR; PG8_WAIT_L(0); PG8_MMA(0, 1, At, B1); PG8_BAR;
            PG8_LDA(At, 1, 1); PG8_STAGE(PG8_SA(1, 0), a3, voffA);
            PG8_BAR; PG8_WAIT_L(0); PG8_MMA(1, 0, At, B0); PG8_BAR; PG8_SCHED;
            PG8_STAGE(PG8_SB(1, 1), b3 + hstep, voffB);
            PG8_WAIT_V(6); PG8_BAR; PG8_MMA(1, 1, At, B1); PG8_BAR;
            }
        }
        if constexpr (ALIGN_EPI) { if (wr == 0) PG8_BAR; }
        if constexpr (!Epi::AFTER_DRAIN) { E(acc, cur, wr, wc, fr, fq); S.done(cur); }
        if (!has_next) break;
#pragma unroll
        for (int a = 0; a < 2; ++a)
#pragma unroll
            for (int b = 0; b < 2; ++b)
#pragma unroll
                for (int m = 0; m < 4; ++m)
#pragma unroll
                    for (int n = 0; n < 2; ++n) acc[a][b][m][n] = (f32x4){0.f, 0.f, 0.f, 0.f};
        cur = nxt; cA = nA; cB = nB; ++ui;
        if constexpr (ALIGN_EPI) { if (wr == 1) PG8_BAR; }
    }
    PG8_WAIT_V(0);
    if constexpr (!ALIGN_EPI) { if (wr == 0) PG8_BAR; }
    PG8_BAR;
    if constexpr (Epi::AFTER_DRAIN) { E.fused(acc, cur, wr, wc, fr, fq, lds, wid, lane); S.done(cur); }
#undef PG8_SA
#undef PG8_SB
#undef PG8_STAGE
#undef PG8_LDA
#undef PG8_LDB
#undef PG8_MMA
#undef PG8_WAIT_V
#undef PG8_WAIT_L
#undef PG8_BAR
#undef PG8_SCHED
}
}
#define GAS __attribute__((address_space(1)))
#define LAS __attribute__((address_space(3)))
typedef unsigned short bf16;
typedef unsigned v4u __attribute__((ext_vector_type(4)));
typedef float f32x4 __attribute__((ext_vector_type(4)));
typedef short bf16x8 __attribute__((ext_vector_type(8)));
typedef GAS unsigned gu32;
typedef GAS unsigned long long gu64;
#define RLX_AGENT __ATOMIC_RELAXED, __HIP_MEMORY_SCOPE_AGENT
#define LDS_WAIT() asm volatile("s_waitcnt lgkmcnt(0)" ::: "memory")
#define VM_WAIT() asm volatile("s_waitcnt vmcnt(0)" ::: "memory")
__device__ __forceinline__ unsigned long long rt() { return __builtin_amdgcn_s_memrealtime(); }
__device__ __forceinline__ unsigned f2bf(float f) { unsigned u = __builtin_bit_cast(unsigned, f); return (u + 0x7fffu + ((u >> 16) & 1u)) >> 16; }
typedef float f32x2_cv __attribute__((ext_vector_type(2))); typedef __bf16 bf16x2_cv __attribute__((ext_vector_type(2)));
__device__ __forceinline__ unsigned pk2(float lo, float hi) { const f32x2_cv v = {lo, hi}; const bf16x2_cv r = __builtin_convertvector(v, bf16x2_cv); return __builtin_bit_cast(unsigned, r); }

#define XB_TMO      128
#define XB_XCNT(j)  (256  + 64 * (j))
#define XB_XSUB(j)  (1280 + 64 * (j))
#define XB_XGEN(j)  (2304 + 64 * (j))
#define XB_TOP      3328
#define XB_TOPGEN   3392
#define XCD_BAR_WORDS 3456
#define XB_SPIN_CAP (1u << 18)

__device__ __forceinline__ unsigned xb_ld(unsigned* p)              { return __hip_atomic_load(p, __ATOMIC_RELAXED, __HIP_MEMORY_SCOPE_AGENT); }
__device__ __forceinline__ unsigned xb_add(unsigned* p, unsigned v) { return __hip_atomic_fetch_add(p, v, __ATOMIC_RELAXED, __HIP_MEMORY_SCOPE_AGENT); }
__device__ __forceinline__ unsigned xb_xcc_id() { return (unsigned)__builtin_amdgcn_s_getreg((3 << 11) | 20) & 0xFu; }
#define XB_SPIN(cond, bar) do { unsigned _sp = 0; while (cond) { __builtin_amdgcn_s_sleep(1); \
    if ((++_sp & 255u) == 0u) { if (xb_ld(&(bar)[XB_TMO])) break; if (_sp > XB_SPIN_CAP) { atomicAdd(&(bar)[XB_TMO], 1u); break; } } } } while (0)

struct XcdBarrier {
    unsigned* bar; unsigned x;
    volatile LAS unsigned* st;
};

__device__ __forceinline__ XcdBarrier xcd_barrier_post(unsigned* bar, volatile LAS unsigned* st) {
    XcdBarrier b; b.bar = bar; b.x = xb_xcc_id(); b.st = st;
    if (threadIdx.x == 0) (void)xb_add(&bar[XB_XCNT(b.x)], 1u);
    return b;
}
__device__ __forceinline__ void xcd_barrier_complete(unsigned* bar, unsigned x, unsigned& nloc, unsigned& nx) {
    const unsigned G = gridDim.x * gridDim.y * gridDim.z;
    unsigned sum, cnt, mine, sp = 0u;
    for (;;) {
        sum = 0u; cnt = 0u; mine = 0u;
#pragma unroll
        for (unsigned j = 0; j < 16; ++j) { const unsigned c = xb_ld(&bar[XB_XCNT(j)]); sum += c; cnt += (c > 0u) ? 1u : 0u; mine = (j == x) ? c : mine; }
        if (sum == G) break;
        __builtin_amdgcn_s_sleep(1);
        if ((++sp & 255u) == 0u) { if (xb_ld(&bar[XB_TMO])) break; if (sp > XB_SPIN_CAP) { atomicAdd(&bar[XB_TMO], 1u); break; } }
    }
    nloc = mine > 0u ? mine : 1u; nx = cnt > 0u ? cnt : 1u;
}

__device__ __forceinline__ void xcd_barrier(const XcdBarrier& b) {
    asm volatile("s_waitcnt vmcnt(0)" ::: "memory");
    __syncthreads();
    if (threadIdx.x == 0) {
        unsigned* bar = b.bar;
        __builtin_amdgcn_s_waitcnt(0);
        unsigned nloc = b.st[0], nx = b.st[1];
        if (nloc == 0u) { xcd_barrier_complete(bar, b.x, nloc, nx); b.st[0] = nloc; b.st[1] = nx; }
        const unsigned old = xb_add(&bar[XB_XSUB(b.x)], 1u);
        const unsigned gen = old / nloc;
        if (old + 1u == (gen + 1u) * nloc) {
            __builtin_amdgcn_fence(__ATOMIC_RELEASE, "agent");
            asm volatile("s_waitcnt vmcnt(0)" ::: "memory");
            const unsigned og = xb_add(&bar[XB_TOP], 1u);
            const unsigned tg = og / nx;
            if (og + 1u == (tg + 1u) * nx) xb_add(&bar[XB_TOPGEN], 1u);
            else XB_SPIN(xb_ld(&bar[XB_TOPGEN]) == tg, bar);
            __builtin_amdgcn_fence(__ATOMIC_ACQUIRE, "agent");
            xb_add(&bar[XB_XGEN(b.x)], 1u);
            asm volatile("s_waitcnt vmcnt(0)" ::: "memory");
        } else {
            XB_SPIN(xb_ld(&bar[XB_XGEN(b.x)]) == gen, bar);
            __builtin_amdgcn_fence(__ATOMIC_ACQUIRE, "agent");
            asm volatile("s_waitcnt vmcnt(0)" ::: "memory");
        }
    }
    __syncthreads();
}

constexpr int NWAVES = 8;
constexpr int DM = 1024, NB = 8, TL = 2048, LC = 256, DFF = 4096;
constexpr int ML = NB * TL;
constexpr int MC = NB * LC;
constexpr int MT = ML + MC;
constexpr int NUP = 4352;
constexpr int NU = 4096;
constexpr int UQ = 0, UK = 512, UV = 1024, UO = 1536, UZ = 2048, UX = 2560, UB = 3072, UC = 3200, UAQ = 3328, UAK = 3840, UAV = 3968;
constexpr int INW = 4128;
constexpr int NY = 1536;
constexpr float EPS = 1e-6f;
constexpr int NPH = 19;

constexpr size_t MiB = 1u << 20;
constexpr size_t WS_CTL = 0, CTL_ZERO_BYTES = 1 * MiB;
constexpr size_t WS_MOD = 1 * MiB;
constexpr size_t WS_GATES = 2 * MiB;
constexpr size_t WS_GB = 5 * MiB;
constexpr size_t WS_W1 = 6 * MiB;
constexpr size_t WS_A = 14 * MiB;
constexpr size_t WS_B = 68 * MiB;
constexpr size_t WS_W0 = 212 * MiB;
constexpr size_t WS_CTXF = 221 * MiB;
constexpr size_t WS_P = 212 * MiB;
constexpr size_t WS_END = 256 * MiB;
static_assert(WS_GATES + (size_t)MT * 32 * 4 <= WS_GB && WS_GB + 256 <= WS_W1 && WS_W1 + 8 * MiB <= WS_A && WS_A + (size_t)MT * NY * 2 <= WS_B && WS_B + (size_t)MT * NU * 2 <= WS_W0 && WS_W0 + (size_t)NUP * DM * 2 <= WS_CTXF
              && WS_CTXF + (size_t)MC * DM * 4 <= WS_END && WS_P + (size_t)MT * 1024 * 2 <= WS_END, "d_ws map");
constexpr int CW_BAR = 4096;

constexpr int RING_OFF = 0, RING_BYTES = 131072;
constexpr int LDSCTL_OFF = RING_BYTES, MISC_OFF = LDSCTL_OFF + 320;
constexpr int LDS_BYTES = 147456;

__device__ __forceinline__ float bf2f(unsigned short h) { return __uint_as_float((unsigned)h << 16); }
__device__ __forceinline__ unsigned short f2bf_s(float f) { return (unsigned short)f2bf(f); }
__device__ __forceinline__ float wave_sum(float v) {
#pragma unroll
    for (int o = 1; o < 64; o <<= 1) v += __shfl_xor(v, o);
    return v;
}

struct Frame {
    LAS unsigned char* lds;
    volatile LAS unsigned* MISC;
    gu32* ctl;
    int tid, lane, wave, G;
    float* out;
    unsigned char* ws;
};
__device__ __forceinline__ const float* kin(int i) {
    const __attribute__((address_space(4))) char* ka = (const __attribute__((address_space(4))) char*)__builtin_amdgcn_kernarg_segment_ptr();
    asm volatile("" : "+s"(ka));
    return ((const float* const __attribute__((address_space(4)))*)ka)[i];
}
enum { I_X = 0, I_C, I_CTX, I_CCTX, I_WMOD, I_BMOD, I_N1G, I_WIN, I_MLBI, I_MLBF, I_MLNG, I_CONVW, I_CONVB, I_ALOG, I_DTB, I_SSDD, I_SSDNG, I_QNG, I_KNG, I_SINK, I_WOUT, I_N2G, I_WUP, I_WDOWN };

__device__ __forceinline__ void transpose_item(const float* W, int ldw, int src_col0, bf16* WT, int K, int dst_row0, int k0, LAS float* scr, int lane) {
#pragma unroll
    for (int i = 0; i < 32; ++i) { const int kk = 2 * i + (lane >> 5); scr[kk * 33 + (lane & 31)] = W[(size_t)(k0 + kk) * ldw + src_col0 + (lane & 31)]; }
    LDS_WAIT(); asm volatile("" ::: "memory");
    const int c = lane & 7;
#pragma unroll
    for (int j = 0; j < 4; ++j) { const int n = (lane >> 3) + 8 * j; const LAS float* s = scr + (8 * c) * 33 + n;
        v4u o; o.x = pk2(s[0 * 33], s[1 * 33]); o.y = pk2(s[2 * 33], s[3 * 33]); o.z = pk2(s[4 * 33], s[5 * 33]); o.w = pk2(s[6 * 33], s[7 * 33]);
        *(GAS v4u*)(WT + (size_t)(dst_row0 + n) * K + k0 + 8 * c) = o; }
    LDS_WAIT(); asm volatile("" ::: "memory");
}
__device__ __forceinline__ void convert_weight(Frame& F, const float* W, int K, int N, bf16* WT) {
    LAS float* scr = (LAS float*)(F.lds + RING_OFF + F.wave * 16384);
    const int gw = blockIdx.x * NWAVES + F.wave, NGW = F.G * NWAVES, nblk = N / 32, nitems = (K / 64) * nblk;
    for (int it = gw; it < nitems; it += NGW) { const int kb = it / nblk, nb = it % nblk; transpose_item(W, N, 32 * nb, WT, K, 32 * nb, 64 * kb, scr, F.lane); }
}
__device__ __forceinline__ void convert_win(Frame& F, const float* W, bf16* WT) {
    LAS float* scr = (LAS float*)(F.lds + RING_OFF + F.wave * 16384);
    const int gw = blockIdx.x * NWAVES + F.wave, NGW = F.G * NWAVES, nblk = NU / 32, nitems = (DM / 64) * nblk;
    for (int it = gw; it < nitems; it += NGW) { const int kb = it / nblk, nb = it % nblk, d0 = 32 * nb, s0 = d0 + (d0 < 2048 ? 0 : (d0 < 3328 ? 16 : 32));
        transpose_item(W, INW, s0, WT, DM, d0, 64 * kb, scr, F.lane); }
    const int gt = blockIdx.x * (NWAVES * 64) + F.tid, NGT = F.G * NWAVES * 64;
    for (int i = gt; i < 32 * 1024; i += NGT) { const int j = i & 31, k = i >> 5; WT[(size_t)(NU + j) * DM + k] = f2bf_s(W[(size_t)k * INW + (j < 16 ? 2048 + j : 3344 + (j - 16))]); }
    for (int i = gt; i < (NUP - NU - 32) * DM / 8; i += NGT) *(GAS v4u*)(WT + (size_t)(NU + 32) * DM + (size_t)i * 8) = (v4u){0u, 0u, 0u, 0u};
}

__device__ __forceinline__ void phase_mod(Frame& F) {
    LAS float* s = (LAS float*)(F.lds + RING_OFF);
    LAS float* red = (LAS float*)(F.lds + RING_OFF + 36864);
    float* MOD = (float*)(F.ws + WS_MOD);
    for (int i = F.tid; i < 9 * 1024; i += NWAVES * 64) { const int r = i >> 10, k = i & 1023; const float v = r < 8 ? kin(I_C)[r * 1024 + k] : kin(I_CCTX)[k]; s[i] = v / (1.f + expf(-v)); }
    __syncthreads();
    for (int u = blockIdx.x; u < 192; u += F.G) {
        const int L = u / 96, cg = u % 96, col = cg * 64 + F.lane, kq = F.wave;
        const float* w = kin(I_WMOD) + (size_t)L * 1024 * 6144 + col;
        float acc[9];
#pragma unroll
        for (int r = 0; r < 9; ++r) acc[r] = 0.f;
#pragma unroll 16
        for (int k = kq * 128; k < kq * 128 + 128; ++k) { const float wv = w[(size_t)k * 6144];
#pragma unroll
            for (int r = 0; r < 9; ++r) acc[r] += s[r * 1024 + k] * wv; }
#pragma unroll
        for (int r = 0; r < 9; ++r) red[(kq * 9 + r) * 64 + F.lane] = acc[r];
        __syncthreads();
        for (int i = F.tid; i < 576; i += NWAVES * 64) { const int r = i >> 6, c = i & 63; float a = kin(I_BMOD)[L * 6144 + cg * 64 + c];
#pragma unroll
            for (int q = 0; q < 8; ++q) a += red[(q * 9 + r) * 64 + c];
            MOD[(size_t)(L * 9 + r) * 6144 + cg * 64 + c] = a; }
        __syncthreads();
    }
    if (blockIdx.x == F.G - 1 && F.tid < 64) { float* GB = (float*)(F.ws + WS_GB); const int L = F.tid >> 5, j = F.tid & 31;
        GB[F.tid] = j < 8 ? kin(I_MLBI)[L * 8 + j] : (j < 16 ? kin(I_MLBF)[L * 8 + j - 8] : kin(I_DTB)[L * 16 + j - 16]); }

}

__device__ __forceinline__ void norm_rows(Frame& F, int L, int nrows, const float* xl, const float* xc, const float* g, int chunk0, bf16* XN) {
    const float* MODL = (const float*)(F.ws + WS_MOD) + (size_t)L * 9 * 6144;
    const int gw = blockIdx.x * NWAVES + F.wave, NGW = F.G * NWAVES, lane = F.lane;
    for (int r = gw; r < nrows; r += NGW) {
        const bool lat = r < ML;
        const float* xr = lat ? xl + (size_t)r * DM : xc + (size_t)(r - ML) * DM;
        const float* md = MODL + (size_t)(lat ? (r >> 11) : 8) * 6144 + chunk0 * 1024;
        f32x4 v[4]; float ss = 0.f;
#pragma unroll
        for (int j = 0; j < 4; ++j) { v[j] = *(const f32x4*)(xr + 256 * j + 4 * lane); ss += (v[j].x * v[j].x + v[j].y * v[j].y) + (v[j].z * v[j].z + v[j].w * v[j].w); }
        const float rstd = 1.0f / sqrtf(wave_sum(ss) * (1.f / DM) + EPS);
#pragma unroll
        for (int j = 0; j < 4; ++j) { const int e = 256 * j + 4 * lane; const f32x4 gg = *(const f32x4*)(g + e), sh = *(const f32x4*)(md + e), sc = *(const f32x4*)(md + 1024 + e);
            v[j] = (v[j] * rstd) * gg * (sc + 1.0f) + sh;
            unsigned long long o = (unsigned long long)pk2(v[j].x, v[j].y) | ((unsigned long long)pk2(v[j].z, v[j].w) << 32);
            *(unsigned long long*)(XN + (size_t)r * DM + e) = o; }
    }
}

__device__ __forceinline__ void phase_qkn(Frame& F, int L) {
    bf16* U = (bf16*)(F.ws + WS_B);
    const int gw = blockIdx.x * NWAVES + F.wave, NGW = F.G * NWAVES, lane = F.lane;
    const int gh = lane >> 5, p = lane & 31, fi = p & 15, d1 = (p < 16) ? p : 32 + (p - 16), d2 = d1 + 16;
    const float gq1 = kin(I_QNG)[L * 64 + d1], gq2 = kin(I_QNG)[L * 64 + d2], gk1 = kin(I_KNG)[L * 64 + d1], gk2 = kin(I_KNG)[L * 64 + d2];
    const float inv = exp2f(-(float)fi * (13.287712379549449f / 16.0f));
    const int nrows = (L == 0) ? MT : MT;
    for (int r = gw; r < nrows; r += NGW) {
        float cs = 1.f, sn = 0.f;
        if (r < ML) { const int t = r & 2047; const float pos = (float)((p < 16) ? (t >> 6) : (t & 63)); const float ang = pos * inv; cs = __cosf(ang); sn = __sinf(ang); }
#pragma unroll
        for (int j = 0; j < 5; ++j) {
            const int c = 2 * j + gh;
            bf16* kr = U + (size_t)r * NU + UAQ + c * 64;
            float x1 = bf2f(kr[d1]), x2 = bf2f(kr[d2]);
            float ss = x1 * x1 + x2 * x2;
#pragma unroll
            for (int o = 1; o < 32; o <<= 1) ss += __shfl_xor(ss, o);
            const float rs = 1.0f / sqrtf(ss * (1.f / 64.f) + EPS);
            const bool isq = c < 8; const float sc = isq ? 0.125f * 1.4426950408889634f : 1.0f;
            x1 = x1 * rs * (isq ? gq1 : gk1) * sc; x2 = x2 * rs * (isq ? gq2 : gk2) * sc;
            kr[d1] = f2bf_s(x1 * cs - x2 * sn); kr[d2] = f2bf_s(x2 * cs + x1 * sn);
        }
    }
}

__device__ __forceinline__ int scan_row(int s, int d, int b) {
    if (s < LC) { const int t = d ? (LC - 1 - s) : s; return ML + b * LC + t; }
    int t = s - LC; if (d) t = TL - 1 - t; return b * TL + t;
}

constexpr size_t WS_PREP = 248 * MiB;
constexpr size_t PO_B = 0, PO_A = 64 * 2304 * 4, PO_M = 2 * PO_A, PO_C = 3 * PO_A, PO_D = PO_C + 128 * 2304 * 4, PO_END = PO_D + 128 * 2304 * 4;
static_assert(WS_PREP + PO_END <= WS_END && WS_P + (size_t)MT * 1024 * 2 <= WS_PREP, "prep map");
__device__ __forceinline__ void phase_scan_prep(Frame& F, int L) {
    const float* GATES = (const float*)(F.ws + WS_GATES); unsigned char* pp = F.ws + WS_PREP;
    const int gw = blockIdx.x * NWAVES + F.wave, NGW = F.G * NWAVES, lane = F.lane;
    for (int task = gw; task < 64 * 36 + 128 * 36; task += NGW) {
        if (task < 64 * 36) { const int sq = task / 36, c = task % 36, d = sq >> 5, b = (sq >> 2) & 7, h = sq & 3;
            const int r = scan_row(c * 64 + lane, d, b); const float li = GATES[(size_t)r * 32 + d * 4 + h], lf = GATES[(size_t)r * 32 + 8 + d * 4 + h];
            float bc = lf;
#pragma unroll
            for (int o = 1; o < 64; o <<= 1) { const float t_ = __shfl_up(bc, o); if (lane >= o) bc += t_; }
            const float a = li - bc; float am = a;
#pragma unroll
            for (int o = 1; o < 64; o <<= 1) { const float t_ = __shfl_up(am, o); if (lane >= o) am = fmaxf(am, t_); }
            const size_t o_ = ((size_t)sq * 2304 + c * 64 + lane) * 4;
            *(float*)(pp + PO_B + o_) = bc; *(float*)(pp + PO_A + o_) = a; *(float*)(pp + PO_M + o_) = am;
        } else { const int t2 = task - 64 * 36, sq = t2 / 36, c = t2 % 36, d = sq >> 6, b = (sq >> 3) & 7, hd = sq & 7;
            const int r = scan_row(c * 64 + lane, d, b); const float dt = GATES[(size_t)r * 32 + 16 + d * 8 + hd];
            float ac = dt * -expf(kin(I_ALOG)[L * 16 + d * 8 + hd]);
#pragma unroll
            for (int o = 1; o < 64; o <<= 1) { const float t_ = __shfl_up(ac, o); if (lane >= o) ac += t_; }
            const size_t o_ = ((size_t)sq * 2304 + c * 64 + lane) * 4;
            *(float*)(pp + PO_C + o_) = ac; *(float*)(pp + PO_D + o_) = dt;
        }
    }
}

constexpr int MP_Q = 272, MP_S = 144;
constexpr int MO_QS = 0, MO_KS = 17408, MO_KW = 34816, MO_VT = 53248, MO_SP = 71680, MO_CT = 80896, MO_SC = 115712;
static_assert(MO_SC + 4096 <= RING_BYTES, "mLSTM LDS map");
__device__ __forceinline__ void mlstm_block_unit(Frame& F, int L, int d, int unit) {
    const int h = unit & 3, b = unit >> 2, tid = F.tid, lane = F.lane, w = F.wave, fr = lane & 15, fq = lane >> 4, sq = d * 32 + unit;
    const bf16* U = (const bf16*)(F.ws + WS_B); bf16* Y = (bf16*)(F.ws + WS_A);
    const float* PB = (const float*)(F.ws + WS_PREP + PO_B) + (size_t)sq * 2304; const float* PA = (const float*)(F.ws + WS_PREP + PO_A) + (size_t)sq * 2304; const float* PM = (const float*)(F.ws + WS_PREP + PO_M) + (size_t)sq * 2304;
    LAS unsigned char* lds = F.lds + RING_OFF;
    LAS float* sc_a = (LAS float*)(lds + MO_SC); LAS float* sc_mx = sc_a + 64; LAS float* sc_g = sc_a + 128; LAS float* sc_emt = sc_a + 192; LAS float* sc_den = sc_a + 256; LAS float* sc_qn = sc_a + 320;
    LAS float* sc_n = sc_a + 384; LAS float* sc_min = sc_a + 512; LAS float* sc_am63 = sc_a + 576; LAS float* sc_b63 = sc_a + 640;
    constexpr float KSC = 0.08838834764831845f;
    constexpr int NCH = (LC + TL) / 64;
    typedef unsigned u32x2 __attribute__((ext_vector_type(2)));
#ifndef SCAN_REPS
#define SCAN_REPS 1
#endif
#ifndef SSD_REPS
#define SSD_REPS 1
#endif
    for (int rep_ = 0; rep_ < SCAN_REPS; ++rep_) {
    __syncthreads();
    for (int i = tid; i < 128 * MP_Q / 16; i += NWAVES * 64) *(LAS v4u*)(lds + MO_CT + i * 16) = (v4u){0u, 0u, 0u, 0u};
    if (tid < 128) sc_n[tid] = 0.f;
    if (tid < NCH) { sc_b63[tid] = PB[tid * 64 + 63]; sc_am63[tid] = PM[tid * 64 + 63]; }
    __syncthreads();
    if (tid == 0) { float m = 0.f; for (int c = 0; c < NCH; ++c) { sc_min[c] = m; m = sc_b63[c] + fmaxf(m, sc_am63[c]); } }
    f32x4 C[8];
#pragma unroll
    for (int j = 0; j < 8; ++j) C[j] = (f32x4){0.f, 0.f, 0.f, 0.f};
    const int tq = tid >> 5, kc = tid & 31;
    u32x2 pq[4], pk[4], pv[4]; f32x4 pa4; float pb1 = 0.f, pa1 = 0.f, pm1 = 0.f;
#define MB_LOAD(c_) do { _Pragma("unroll") for (int j_ = 0; j_ < 4; ++j_) { const int r_ = scan_row((c_) * 64 + 4 * tq + j_, d, b); const bf16* ur_ = U + (size_t)r_ * NU + h * 128 + 4 * kc; \
            pq[j_] = *(const u32x2*)(ur_ + UQ); pk[j_] = *(const u32x2*)(ur_ + UK); pv[j_] = *(const u32x2*)(ur_ + UV); } \
        pa4 = *(const f32x4*)(PA + (c_) * 64 + 4 * tq); \
        if (tid < 64) { pb1 = PB[(c_) * 64 + tid]; pa1 = PA[(c_) * 64 + tid]; pm1 = PM[(c_) * 64 + tid]; } } while (0)
    MB_LOAD(0);
    __syncthreads();

    for (int c = 0; c < NCH; ++c) {
        const float m_in = sc_min[c], mx63 = fmaxf(m_in, sc_am63[c]), decay = __expf(m_in - mx63);
        if (tid < 64) { const float mx = fmaxf(m_in, pm1); sc_a[tid] = pa1; sc_mx[tid] = mx; sc_g[tid] = __expf(m_in - mx); sc_emt[tid] = __expf(-(pb1 + mx)); sc_den[tid] = 0.f; }
        {
            const float w0 = __expf(pa4[0] - mx63) * KSC, w1 = __expf(pa4[1] - mx63) * KSC, w2 = __expf(pa4[2] - mx63) * KSC, w3 = __expf(pa4[3] - mx63) * KSC;
#pragma unroll
            for (int j = 0; j < 4; ++j) { *(LAS u32x2*)(lds + MO_QS + (4 * tq + j) * MP_Q + kc * 8) = pq[j]; *(LAS u32x2*)(lds + MO_KS + (4 * tq + j) * MP_Q + kc * 8) = pk[j]; }
#pragma unroll
            for (int e = 0; e < 4; ++e) {
                const unsigned k0 = (e < 2) ? pk[0].x : pk[0].y, k1 = (e < 2) ? pk[1].x : pk[1].y, k2 = (e < 2) ? pk[2].x : pk[2].y, k3 = (e < 2) ? pk[3].x : pk[3].y;
                const unsigned v0 = (e < 2) ? pv[0].x : pv[0].y, v1 = (e < 2) ? pv[1].x : pv[1].y, v2 = (e < 2) ? pv[2].x : pv[2].y, v3 = (e < 2) ? pv[3].x : pv[3].y;
                const float f0 = (e & 1) ? __uint_as_float(k0 & 0xffff0000u) : __uint_as_float(k0 << 16), f1 = (e & 1) ? __uint_as_float(k1 & 0xffff0000u) : __uint_as_float(k1 << 16);
                const float f2 = (e & 1) ? __uint_as_float(k2 & 0xffff0000u) : __uint_as_float(k2 << 16), f3 = (e & 1) ? __uint_as_float(k3 & 0xffff0000u) : __uint_as_float(k3 << 16);
                u32x2 ow; ow.x = pk2(f0 * w0, f1 * w1); ow.y = pk2(f2 * w2, f3 * w3);
                *(LAS u32x2*)(lds + MO_KW + (4 * kc + e) * MP_S + tq * 8) = ow;
                const unsigned h0 = (e & 1) ? (v0 >> 16) : (v0 & 0xffffu), h1 = (e & 1) ? (v1 >> 16) : (v1 & 0xffffu), h2 = (e & 1) ? (v2 >> 16) : (v2 & 0xffffu), h3 = (e & 1) ? (v3 >> 16) : (v3 & 0xffffu);
                u32x2 ov; ov.x = h0 | (h1 << 16); ov.y = h2 | (h3 << 16);
                *(LAS u32x2*)(lds + MO_VT + (4 * kc + e) * MP_S + tq * 8) = ov; }
        }
        if (c > 0) {
#pragma unroll
            for (int j = 0; j < 8; ++j) { u32x2 o; o.x = pk2(C[j][0], C[j][1]); o.y = pk2(C[j][2], C[j][3]);
                *(LAS u32x2*)(lds + MO_CT + (16 * j + fr) * MP_Q + (16 * w + 4 * fq) * 2) = o; }
        }
        if (c + 1 < NCH) MB_LOAD(c + 1);
        __syncthreads();
        {
            const int t = tid >> 3, part = tid & 7;
            const v4u q0 = *(const LAS v4u*)(lds + MO_QS + t * MP_Q + part * 32), q1 = *(const LAS v4u*)(lds + MO_QS + t * MP_Q + part * 32 + 16);
            const unsigned qq[8] = {q0.x, q0.y, q0.z, q0.w, q1.x, q1.y, q1.z, q1.w};
            float qn = 0.f;
#pragma unroll
            for (int e = 0; e < 8; ++e) qn += __uint_as_float(qq[e] << 16) * sc_n[16 * part + 2 * e] + __uint_as_float(qq[e] & 0xffff0000u) * sc_n[16 * part + 2 * e + 1];
            qn += __shfl_xor(qn, 1); qn += __shfl_xor(qn, 2); qn += __shfl_xor(qn, 4);
            if (part == 0) sc_qn[t] = qn;
        }
        {
            const int ms = w >> 1, nt0 = 2 * (w & 1);
            f32x4 acc[2] = {(f32x4){0.f, 0.f, 0.f, 0.f}, (f32x4){0.f, 0.f, 0.f, 0.f}};
#pragma unroll
            for (int kk2 = 0; kk2 < 4; ++kk2) {
                const bf16x8 af = *(const LAS bf16x8*)(lds + MO_KS + (16 * ms + fr) * MP_Q + (32 * kk2 + 8 * fq) * 2);
#pragma unroll
                for (int j = 0; j < 2; ++j) { const bf16x8 bfv = *(const LAS bf16x8*)(lds + MO_QS + (16 * (nt0 + j) + fr) * MP_Q + (32 * kk2 + 8 * fq) * 2);
                    acc[j] = __builtin_amdgcn_mfma_f32_16x16x32_bf16(af, bfv, acc[j], 0, 0, 0); }
            }
            const int s0 = 16 * ms + 4 * fq;
            const f32x4 av = *(const LAS f32x4*)(sc_a + s0);
#pragma unroll
            for (int j = 0; j < 2; ++j) { const int t = 16 * (nt0 + j) + fr; const float mxt = sc_mx[t];
                const float v0 = (s0 + 0 <= t) ? acc[j][0] * KSC * __expf(av[0] - mxt) : 0.f, v1 = (s0 + 1 <= t) ? acc[j][1] * KSC * __expf(av[1] - mxt) : 0.f;
                const float v2 = (s0 + 2 <= t) ? acc[j][2] * KSC * __expf(av[2] - mxt) : 0.f, v3 = (s0 + 3 <= t) ? acc[j][3] * KSC * __expf(av[3] - mxt) : 0.f;
                u32x2 o; o.x = pk2(v0, v1); o.y = pk2(v2, v3);
                *(LAS u32x2*)(lds + MO_SP + t * MP_S + s0 * 2) = o;
                float rs = (v0 + v1) + (v2 + v3); rs += __shfl_xor(rs, 16); rs += __shfl_xor(rs, 32);
                if (fq == 0 && 16 * ms <= t) atomicAdd((float*)(sc_den + t), rs); }
        }
        __syncthreads();
        if (c >= LC / 64 || L == 0) {
            const int mv = w;
            f32x4 a1[4], a2[4];
#pragma unroll
            for (int j = 0; j < 4; ++j) { a1[j] = (f32x4){0.f, 0.f, 0.f, 0.f}; a2[j] = (f32x4){0.f, 0.f, 0.f, 0.f}; }
#pragma unroll
            for (int kk2 = 0; kk2 < 2; ++kk2) {
                const bf16x8 af = *(const LAS bf16x8*)(lds + MO_VT + (16 * mv + fr) * MP_S + (32 * kk2 + 8 * fq) * 2);
#pragma unroll
                for (int j = 0; j < 4; ++j) { const bf16x8 bfv = *(const LAS bf16x8*)(lds + MO_SP + (16 * j + fr) * MP_S + (32 * kk2 + 8 * fq) * 2);
                    a1[j] = __builtin_amdgcn_mfma_f32_16x16x32_bf16(af, bfv, a1[j], 0, 0, 0); }
            }
#pragma unroll
            for (int kk2 = 0; kk2 < 4; ++kk2) {
                const bf16x8 af = *(const LAS bf16x8*)(lds + MO_CT + (16 * mv + fr) * MP_Q + (32 * kk2 + 8 * fq) * 2);
#pragma unroll
                for (int j = 0; j < 4; ++j) { const bf16x8 bfv = *(const LAS bf16x8*)(lds + MO_QS + (16 * j + fr) * MP_Q + (32 * kk2 + 8 * fq) * 2);
                    a2[j] = __builtin_amdgcn_mfma_f32_16x16x32_bf16(af, bfv, a2[j], 0, 0, 0); }
            }
#pragma unroll
            for (int j = 0; j < 4; ++j) { const int t = 16 * j + fr; const float g = sc_g[t];
                const float den = sc_den[t] + g * sc_qn[t], rd = 1.0f / fmaxf(fabsf(den), sc_emt[t]);
                const int row = scan_row(c * 64 + t, d, b);
                bf16* yp = (d == 0 ? Y + (size_t)row * NY : (bf16*)(F.ws + WS_P) + (size_t)row * 1024) + h * 128 + 16 * mv + 4 * fq;
                const float h0 = (a1[j][0] + g * a2[j][0]) * rd, h1 = (a1[j][1] + g * a2[j][1]) * rd, h2 = (a1[j][2] + g * a2[j][2]) * rd, h3 = (a1[j][3] + g * a2[j][3]) * rd;
                u32x2 o; o.x = pk2(h0, h1); o.y = pk2(h2, h3); *(u32x2*)yp = o; }
        }
        {
            const int mk = w;
#pragma unroll
            for (int j = 0; j < 8; ++j) C[j] = C[j] * decay;
#pragma unroll
            for (int kk2 = 0; kk2 < 2; ++kk2) {
                const bf16x8 af = *(const LAS bf16x8*)(lds + MO_KW + (16 * mk + fr) * MP_S + (32 * kk2 + 8 * fq) * 2);
#pragma unroll
                for (int j = 0; j < 8; ++j) { const bf16x8 bfv = *(const LAS bf16x8*)(lds + MO_VT + (16 * j + fr) * MP_S + (32 * kk2 + 8 * fq) * 2);
                    C[j] = __builtin_amdgcn_mfma_f32_16x16x32_bf16(af, bfv, C[j], 0, 0, 0); }
            }
            if (tid < 128) { float sm = 0.f;
#pragma unroll
                for (int e = 0; e < 8; ++e) { const v4u x = *(const LAS v4u*)(lds + MO_KW + tid * MP_S + e * 16);
                    sm += (__uint_as_float(x.x << 16) + __uint_as_float(x.x & 0xffff0000u)) + (__uint_as_float(x.y << 16) + __uint_as_float(x.y & 0xffff0000u))
                        + (__uint_as_float(x.z << 16) + __uint_as_float(x.z & 0xffff0000u)) + (__uint_as_float(x.w << 16) + __uint_as_float(x.w & 0xffff0000u)); }
                sc_n[tid] = decay * sc_n[tid] + sm; }
        }
        __syncthreads();
    }
    }

#undef MB_LOAD
}

constexpr int SP_P = 144;
constexpr int SO_BS = 0, SO_CS = 9216, SO_BT = 18432, SO_HD = 27648, SO_HSTRIDE = 36864, SO_SP = 0, SO_XT = 9216, SO_XW = 18432, SO_HB = 27648, SO_SC = 101376, SO_CW = 103488;
static_assert(SO_CW + 4096 <= RING_BYTES, "SSD LDS map");
__device__ __forceinline__ void ssd_block_unit(Frame& F, int L, int d, int unit) {
    const int hp = unit & 3, b = unit >> 2, g = hp >> 1, tid = F.tid, lane = F.lane, w = F.wave, fr = lane & 15, fq = lane >> 4;
    const bf16* U = (const bf16*)(F.ws + WS_B); bf16* Y = (bf16*)(F.ws + WS_A);
    LAS unsigned char* lds = F.lds + RING_OFF;
    LAS float* scb = (LAS float*)(lds + SO_SC);
    LAS float* cwt = (LAS float*)(lds + SO_CW);
    constexpr int NCH = (LC + TL) / 64;
    typedef unsigned u32x2 __attribute__((ext_vector_type(2)));
    for (int rep_ = 0; rep_ < SSD_REPS; ++rep_) {
    __syncthreads();
    if (tid < 256) { const int ch = tid < 128 ? (2 * hp) * 64 + tid : (tid < 192 ? 512 + g * 64 + (tid - 128) : 640 + g * 64 + (tid - 192));
        const float* cw = kin(I_CONVW) + (size_t)L * 3 * 768;
        cwt[tid * 4 + 0] = cw[ch]; cwt[tid * 4 + 1] = cw[768 + ch]; cwt[tid * 4 + 2] = cw[1536 + ch]; cwt[tid * 4 + 3] = kin(I_CONVB)[L * 768 + ch]; }
    for (int i = tid; i < 2 * 9216 / 16; i += NWAVES * 64) { const int hl2 = i / 576, o = i % 576; *(LAS v4u*)(lds + SO_HD + hl2 * SO_HSTRIDE + SO_HB + o * 16) = (v4u){0u, 0u, 0u, 0u}; }
    const int hl = w >> 2, wq = w & 3, head = 2 * hp + hl;
    const float dsk = kin(I_SSDD)[L * 8 + head];
    f32x4 Hs[4];
#pragma unroll
    for (int j = 0; j < 4; ++j) Hs[j] = (f32x4){0.f, 0.f, 0.f, 0.f};
    const int tokq = tid & 15, c8 = tid >> 4;
    const int ucol = c8 < 16 ? UX + (2 * hp) * 64 + 8 * c8 : (c8 < 24 ? UB + g * 64 + 8 * (c8 - 16) : UC + g * 64 + 8 * (c8 - 24));
    const int i0 = d ? 60 - 4 * tokq : 4 * tokq;
    const int hxs = (c8 >> 3) & 1;
    const float* PCs = (const float*)(F.ws + WS_PREP + PO_C) + (size_t)(d * 64 + b * 8 + 2 * hp + hxs) * 2304;
    const float* PDs = (const float*)(F.ws + WS_PREP + PO_D) + (size_t)(d * 64 + b * 8 + 2 * hp + hxs) * 2304;
    const int sh = (tid >> 6) & 1, st = tid & 63;
    const float* PC1 = (const float*)(F.ws + WS_PREP + PO_C) + (size_t)(d * 64 + b * 8 + 2 * hp + sh) * 2304;
    const float* PD1 = (const float*)(F.ws + WS_PREP + PO_D) + (size_t)(d * 64 + b * 8 + 2 * hp + sh) * 2304;
    const float* PCc = (const float*)(F.ws + WS_PREP + PO_C) + (size_t)(d * 64 + b * 8 + head) * 2304;
    v4u raw[6]; f32x4 pac = (f32x4){0.f, 0.f, 0.f, 0.f}, pdt = pac; float paend = 0.f, pac1 = 0.f, pdt1 = 0.f, pend_c = 0.f;
#define SB_LOAD(c_) do { const int s0_ = (c_) * 64; const bool cx_ = s0_ < LC; const int seglen_ = cx_ ? LC : TL; const int tf_ = cx_ ? s0_ : s0_ - LC; const int tlo_ = d ? seglen_ - 64 - tf_ : tf_; \
        const size_t rb0_ = cx_ ? (size_t)(ML + b * LC) : (size_t)(b * TL); \
        _Pragma("unroll") for (int r_ = 0; r_ < 6; ++r_) { const int t_ = tlo_ + 4 * tokq - 1 + r_; const bool ok_ = t_ >= 0 && t_ < seglen_; \
            raw[r_] = ok_ ? *(const v4u*)(U + (rb0_ + t_) * NU + ucol) : (v4u){0u, 0u, 0u, 0u}; } \
        if (c8 < 16) { pac = *(const f32x4*)(PCs + s0_ + i0); pdt = *(const f32x4*)(PDs + s0_ + i0); paend = PCs[s0_ + 63]; } \
        if (tid < 128) { pac1 = PC1[s0_ + st]; pdt1 = PD1[s0_ + st]; } \
        pend_c = PCc[s0_ + 63]; } while (0)
    SB_LOAD(0);
    __syncthreads();
    for (int c = 0; c < NCH; ++c) {
        const bool need_out = (c >= LC / 64) || (L == 0);
        const float dA = __expf(pend_c);
        if (tid < 128) { LAS float* sb = scb + sh * 256; sb[st] = pac1; sb[64 + st] = pdt1; sb[192 + st] = __expf(pac1); }
        {
            float val[4][8];
#pragma unroll
            for (int e = 0; e < 8; ++e) { const f32x4 cw = *(const LAS f32x4*)(cwt + (8 * c8 + e) * 4);
                float rv[6];
#pragma unroll
                for (int r_ = 0; r_ < 6; ++r_) { const unsigned x = (e < 2) ? raw[r_].x : (e < 4 ? raw[r_].y : (e < 6 ? raw[r_].z : raw[r_].w)); rv[r_] = (e & 1) ? __uint_as_float(x & 0xffff0000u) : __uint_as_float(x << 16); }
#pragma unroll
                for (int jj = 0; jj < 4; ++jj) { float v = cw[0] * rv[jj] + cw[1] * rv[jj + 1] + cw[2] * rv[jj + 2] + cw[3]; val[jj][e] = v * __builtin_amdgcn_rcpf(1.f + __expf(-v)); } }
            if (c8 < 16) {
                const int p0 = 8 * (c8 & 7);
                LAS unsigned char* hb = lds + SO_HD + hxs * SO_HSTRIDE;
                const float w0 = __expf(paend - pac[0]) * pdt[0], w1 = __expf(paend - pac[1]) * pdt[1], w2 = __expf(paend - pac[2]) * pdt[2], w3 = __expf(paend - pac[3]) * pdt[3];
#pragma unroll
                for (int e = 0; e < 8; ++e) { const float x0 = val[d ? 3 : 0][e], x1 = val[d ? 2 : 1][e], x2 = val[d ? 1 : 2][e], x3 = val[d ? 0 : 3][e];
                    u32x2 o; o.x = pk2(x0, x1); o.y = pk2(x2, x3); *(LAS u32x2*)(hb + SO_XT + (p0 + e) * SP_P + i0 * 2) = o;
                    u32x2 q; q.x = pk2(x0 * w0, x1 * w1); q.y = pk2(x2 * w2, x3 * w3); *(LAS u32x2*)(hb + SO_XW + (p0 + e) * SP_P + i0 * 2) = q; }
            } else if (c8 < 24) {
                const int n0 = 8 * (c8 - 16);
#pragma unroll
                for (int q = 0; q < 4; ++q) { const int jj = d ? 3 - q : q; v4u o; o.x = pk2(val[jj][0], val[jj][1]); o.y = pk2(val[jj][2], val[jj][3]); o.z = pk2(val[jj][4], val[jj][5]); o.w = pk2(val[jj][6], val[jj][7]);
                    *(LAS v4u*)(lds + SO_BS + (i0 + q) * SP_P + n0 * 2) = o; }
#pragma unroll
                for (int e = 0; e < 8; ++e) { u32x2 o; o.x = pk2(val[d ? 3 : 0][e], val[d ? 2 : 1][e]); o.y = pk2(val[d ? 1 : 2][e], val[d ? 0 : 3][e]);
                    *(LAS u32x2*)(lds + SO_BT + (n0 + e) * SP_P + i0 * 2) = o; }
            } else {
                const int n0 = 8 * (c8 - 24);
#pragma unroll
                for (int q = 0; q < 4; ++q) { const int jj = d ? 3 - q : q; v4u o; o.x = pk2(val[jj][0], val[jj][1]); o.y = pk2(val[jj][2], val[jj][3]); o.z = pk2(val[jj][4], val[jj][5]); o.w = pk2(val[jj][6], val[jj][7]);
                    *(LAS v4u*)(lds + SO_CS + (i0 + q) * SP_P + n0 * 2) = o; }
            }
        }
        if (c > 0) { LAS unsigned char* hb = lds + SO_HD + hl * SO_HSTRIDE;
#pragma unroll
            for (int j = 0; j < 4; ++j) { u32x2 o; o.x = pk2(Hs[j][0], Hs[j][1]); o.y = pk2(Hs[j][2], Hs[j][3]);
                *(LAS u32x2*)(hb + SO_HB + (16 * j + fr) * SP_P + (16 * wq + 4 * fq) * 2) = o; } }
        if (c + 1 < NCH) SB_LOAD(c + 1);
        __syncthreads();
        if (need_out) {
            const int ms = w >> 1, nt0 = 2 * (w & 1);
            f32x4 acc[2] = {(f32x4){0.f, 0.f, 0.f, 0.f}, (f32x4){0.f, 0.f, 0.f, 0.f}};
#pragma unroll
            for (int kk2 = 0; kk2 < 2; ++kk2) {
                const bf16x8 af = *(const LAS bf16x8*)(lds + SO_BS + (16 * ms + fr) * SP_P + (32 * kk2 + 8 * fq) * 2);
#pragma unroll
                for (int j = 0; j < 2; ++j) { const bf16x8 bfv = *(const LAS bf16x8*)(lds + SO_CS + (16 * (nt0 + j) + fr) * SP_P + (32 * kk2 + 8 * fq) * 2);
                    acc[j] = __builtin_amdgcn_mfma_f32_16x16x32_bf16(af, bfv, acc[j], 0, 0, 0); }
            }
            const int s0 = 16 * ms + 4 * fq;
#pragma unroll
            for (int hx = 0; hx < 2; ++hx) { const LAS float* sb = scb + hx * 256;
                const f32x4 as = *(const LAS f32x4*)(sb + s0), ds = *(const LAS f32x4*)(sb + 64 + s0);
#pragma unroll
                for (int j = 0; j < 2; ++j) { const int t = 16 * (nt0 + j) + fr; const float at = sb[t];
                    const float v0 = (s0 + 0 <= t) ? acc[j][0] * __expf(at - as[0]) * ds[0] : 0.f, v1 = (s0 + 1 <= t) ? acc[j][1] * __expf(at - as[1]) * ds[1] : 0.f;
                    const float v2 = (s0 + 2 <= t) ? acc[j][2] * __expf(at - as[2]) * ds[2] : 0.f, v3 = (s0 + 3 <= t) ? acc[j][3] * __expf(at - as[3]) * ds[3] : 0.f;
                    u32x2 o; o.x = pk2(v0, v1); o.y = pk2(v2, v3);
                    *(LAS u32x2*)(lds + SO_HD + hx * SO_HSTRIDE + SO_SP + t * SP_P + s0 * 2) = o; } }
        }
        __syncthreads();
        {
            LAS unsigned char* hb = lds + SO_HD + hl * SO_HSTRIDE; const LAS float* sb = scb + hl * 256;
            if (need_out) {
                f32x4 a1[4], a2[4];
#pragma unroll
                for (int j = 0; j < 4; ++j) { a1[j] = (f32x4){0.f, 0.f, 0.f, 0.f}; a2[j] = (f32x4){0.f, 0.f, 0.f, 0.f}; }
#pragma unroll
                for (int kk2 = 0; kk2 < 2; ++kk2) {
                    const bf16x8 ax = *(const LAS bf16x8*)(hb + SO_XT + (16 * wq + fr) * SP_P + (32 * kk2 + 8 * fq) * 2);
                    const bf16x8 ah = *(const LAS bf16x8*)(hb + SO_HB + (16 * wq + fr) * SP_P + (32 * kk2 + 8 * fq) * 2);
#pragma unroll
                    for (int j = 0; j < 4; ++j) { const bf16x8 bs = *(const LAS bf16x8*)(hb + SO_SP + (16 * j + fr) * SP_P + (32 * kk2 + 8 * fq) * 2);
                        const bf16x8 bc = *(const LAS bf16x8*)(lds + SO_CS + (16 * j + fr) * SP_P + (32 * kk2 + 8 * fq) * 2);
                        a1[j] = __builtin_amdgcn_mfma_f32_16x16x32_bf16(ax, bs, a1[j], 0, 0, 0);
                        a2[j] = __builtin_amdgcn_mfma_f32_16x16x32_bf16(ah, bc, a2[j], 0, 0, 0); }
                }
#pragma unroll
                for (int j = 0; j < 4; ++j) { const int t = 16 * j + fr; const float et = sb[192 + t];
                    const int row = scan_row(c * 64 + t, d, b); const int p0 = 16 * wq + 4 * fq;
                    bf16* yp = (d == 0 ? Y + (size_t)row * NY : (bf16*)(F.ws + WS_P) + (size_t)row * 1024) + 512 + head * 64 + p0;
                    float y0 = a1[j][0] + et * a2[j][0], y1 = a1[j][1] + et * a2[j][1], y2 = a1[j][2] + et * a2[j][2], y3 = a1[j][3] + et * a2[j][3];
                    if (d == 1) { const LAS unsigned short* xp = (const LAS unsigned short*)(hb + SO_XT + p0 * SP_P + t * 2);
                        y0 += dsk * bf2f(xp[0]); y1 += dsk * bf2f(xp[SP_P / 2]); y2 += dsk * bf2f(xp[2 * (SP_P / 2)]); y3 += dsk * bf2f(xp[3 * (SP_P / 2)]); }
                    u32x2 o; o.x = pk2(y0, y1); o.y = pk2(y2, y3); *(u32x2*)yp = o; }
            }
#pragma unroll
            for (int j = 0; j < 4; ++j) Hs[j] = Hs[j] * dA;
#pragma unroll
            for (int kk2 = 0; kk2 < 2; ++kk2) {
                const bf16x8 af = *(const LAS bf16x8*)(lds + SO_BT + (16 * wq + fr) * SP_P + (32 * kk2 + 8 * fq) * 2);
#pragma unroll
                for (int j = 0; j < 4; ++j) { const bf16x8 bfv = *(const LAS bf16x8*)(hb + SO_XW + (16 * j + fr) * SP_P + (32 * kk2 + 8 * fq) * 2);
                    Hs[j] = __builtin_amdgcn_mfma_f32_16x16x32_bf16(af, bfv, Hs[j], 0, 0, 0); }
            }
        }
        __syncthreads();
    }
    }
#undef SB_LOAD
}

typedef float f32x16 __attribute__((ext_vector_type(16)));
constexpr int AT_KP = 144, AT_VP = 136;
constexpr int AT_KB = 64 * AT_KP, AT_VB = 64 * AT_VP;
__device__ __forceinline__ void attn_block_unit(Frame& F, int L, int unit) {
    const bf16* U = (const bf16*)(F.ws + WS_B); bf16* Y = (bf16*)(F.ws + WS_A);
    const int tid = F.tid, lane = F.lane, w = F.wave, r = lane & 31, hf = lane >> 5;
    const bool lat = unit < 512;
    int b, g, qt;
    if (lat) { b = unit >> 6; g = (unit >> 5) & 1; qt = unit & 31; } else { const int u2 = unit - 512; b = u2 >> 3; g = (u2 >> 2) & 1; qt = u2 & 3; }
    const int t0 = qt * 64, hh = w >> 1, qh = w & 1, head = g * 4 + hh, t = t0 + 32 * qh + r;
    const size_t qrow = lat ? (size_t)(b * TL + t) : (size_t)(ML + b * LC + t);
    LAS unsigned char* Kt = F.lds + RING_OFF;
    LAS unsigned char* Vt = F.lds + RING_OFF + 2 * AT_KB;
    bf16x8 qf[4];
#pragma unroll
    for (int ks = 0; ks < 4; ++ks) qf[ks] = *(const bf16x8*)(U + qrow * NU + UAQ + head * 64 + 16 * ks + 8 * hf);
    const int rel_lo = lat ? (qt < 2 ? -qt : -2) : 0, rel_hi = lat ? (31 - qt < 2 ? 31 - qt : 2) : -1;
    const int ntiles = 4 + (rel_hi - rel_lo + 1);
    f32x16 o0, o1;
#pragma unroll
    for (int i = 0; i < 16; ++i) { o0[i] = 0.f; o1[i] = 0.f; }
    float mrun = kin(I_SINK)[L * 8 + head] * 1.4426950408889634f, lrun = (hf == 0) ? 1.f : 0.f;
    const int skk = tid >> 3, sc8 = tid & 7;
    v4u pk, pv;
#define AT_LOAD(i_) do { const int i__ = (i_); const size_t base_ = (i__ < 4) ? (size_t)(ML + b * LC + 64 * i__) : (size_t)(b * TL + t0 + 64 * (rel_lo + i__ - 4)); \
        const bf16* kp_ = U + (base_ + skk) * NU + g * 64 + 8 * sc8; pk = *(const v4u*)(kp_ + UAK); pv = *(const v4u*)(kp_ + UAV); } while (0)
#define AT_STORE(buf_) do { *(LAS v4u*)(Kt + (buf_) * AT_KB + skk * AT_KP + sc8 * 16) = pk; LAS unsigned short* vb_ = (LAS unsigned short*)(Vt + (buf_) * AT_VB + (8 * sc8) * AT_VP + skk * 2); \
        vb_[0 * (AT_VP / 2)] = (unsigned short)(pv.x & 0xffffu); vb_[1 * (AT_VP / 2)] = (unsigned short)(pv.x >> 16); vb_[2 * (AT_VP / 2)] = (unsigned short)(pv.y & 0xffffu); vb_[3 * (AT_VP / 2)] = (unsigned short)(pv.y >> 16); \
        vb_[4 * (AT_VP / 2)] = (unsigned short)(pv.z & 0xffffu); vb_[5 * (AT_VP / 2)] = (unsigned short)(pv.z >> 16); vb_[6 * (AT_VP / 2)] = (unsigned short)(pv.w & 0xffffu); vb_[7 * (AT_VP / 2)] = (unsigned short)(pv.w >> 16); } while (0)
    __syncthreads();
    AT_LOAD(0); AT_STORE(0);
    __syncthreads();
    for (int i = 0; i < ntiles; ++i) {
        const int buf = i & 1;
        if (i + 1 < ntiles) AT_LOAD(i + 1);
        const LAS unsigned char* kb = Kt + buf * AT_KB; const LAS unsigned char* vb = Vt + buf * AT_VB;
        f32x16 s0, s1;
#pragma unroll
        for (int e = 0; e < 16; ++e) { s0[e] = 0.f; s1[e] = 0.f; }
#pragma unroll
        for (int ks = 0; ks < 4; ++ks) {
            const bf16x8 k0 = *(const LAS bf16x8*)(kb + r * AT_KP + (16 * ks + 8 * hf) * 2), k1 = *(const LAS bf16x8*)(kb + (32 + r) * AT_KP + (16 * ks + 8 * hf) * 2);
            s0 = __builtin_amdgcn_mfma_f32_32x32x16_bf16(k0, qf[ks], s0, 0, 0, 0);
            s1 = __builtin_amdgcn_mfma_f32_32x32x16_bf16(k1, qf[ks], s1, 0, 0, 0);
        }
        if (i >= 4) { const int rel = rel_lo + i - 4;
            if (rel == 2 || rel == -2) { const int dbase = 64 * rel - 32 * qh - r + 4 * hf;
#pragma unroll
                for (int e = 0; e < 16; ++e) { const int d0 = dbase + (e & 3) + 8 * (e >> 2), d1 = d0 + 32;
                    if (d0 > 128 || d0 < -128) s0[e] = -INFINITY; if (d1 > 128 || d1 < -128) s1[e] = -INFINITY; } } }
        float tm = s0[0];
#pragma unroll
        for (int e = 1; e < 16; ++e) tm = fmaxf(tm, s0[e]);
#pragma unroll
        for (int e = 0; e < 16; ++e) tm = fmaxf(tm, s1[e]);
        tm = fmaxf(tm, __shfl_xor(tm, 32));
        const float mn = fmaxf(mrun, tm), al = __builtin_amdgcn_exp2f(mrun - mn); mrun = mn;
        float ps = 0.f;
#pragma unroll
        for (int e = 0; e < 16; ++e) { s0[e] = __builtin_amdgcn_exp2f(s0[e] - mn); s1[e] = __builtin_amdgcn_exp2f(s1[e] - mn); ps += s0[e] + s1[e]; }
        lrun = lrun * al + ps;
#pragma unroll
        for (int e = 0; e < 16; ++e) { o0[e] *= al; o1[e] *= al; }
        bf16x8 pf[4];
#pragma unroll
        for (int s2 = 0; s2 < 2; ++s2) {
            unsigned a0 = pk2(s0[8 * s2 + 0], s0[8 * s2 + 1]), a1 = pk2(s0[8 * s2 + 2], s0[8 * s2 + 3]), a2 = pk2(s0[8 * s2 + 4], s0[8 * s2 + 5]), a3 = pk2(s0[8 * s2 + 6], s0[8 * s2 + 7]);
            unsigned c0 = pk2(s1[8 * s2 + 0], s1[8 * s2 + 1]), c1 = pk2(s1[8 * s2 + 2], s1[8 * s2 + 3]), c2 = pk2(s1[8 * s2 + 4], s1[8 * s2 + 5]), c3 = pk2(s1[8 * s2 + 6], s1[8 * s2 + 7]);
            v4u x; x.x = a0; x.y = a1; x.z = a2; x.w = a3; pf[s2] = __builtin_bit_cast(bf16x8, x);
            v4u y; y.x = c0; y.y = c1; y.z = c2; y.w = c3; pf[2 + s2] = __builtin_bit_cast(bf16x8, y);
        }
#pragma unroll
        for (int ks = 0; ks < 4; ++ks) {
            const int kofs = (16 * ks + 4 * hf) * 2;
            typedef unsigned u32x2 __attribute__((ext_vector_type(2)));
            const u32x2 a_lo0 = *(const LAS u32x2*)(vb + r * AT_VP + kofs), a_hi0 = *(const LAS u32x2*)(vb + r * AT_VP + kofs + 16);
            const u32x2 a_lo1 = *(const LAS u32x2*)(vb + (32 + r) * AT_VP + kofs), a_hi1 = *(const LAS u32x2*)(vb + (32 + r) * AT_VP + kofs + 16);
            v4u va; va.x = a_lo0.x; va.y = a_lo0.y; va.z = a_hi0.x; va.w = a_hi0.y;
            v4u vc; vc.x = a_lo1.x; vc.y = a_lo1.y; vc.z = a_hi1.x; vc.w = a_hi1.y;
            o0 = __builtin_amdgcn_mfma_f32_32x32x16_bf16(__builtin_bit_cast(bf16x8, va), pf[ks], o0, 0, 0, 0);
            o1 = __builtin_amdgcn_mfma_f32_32x32x16_bf16(__builtin_bit_cast(bf16x8, vc), pf[ks], o1, 0, 0, 0);
        }
        if (i + 1 < ntiles) AT_STORE(buf ^ 1);
        __syncthreads();
    }
#undef AT_LOAD
#undef AT_STORE
    const float il = 1.f / (lrun + __shfl_xor(lrun, 32));
    bf16* yp = Y + qrow * NY + 1024 + head * 64 + 4 * hf;
    typedef unsigned u32x2s __attribute__((ext_vector_type(2)));
#pragma unroll
    for (int gq = 0; gq < 4; ++gq) {
        u32x2s w0; w0.x = pk2(o0[4 * gq] * il, o0[4 * gq + 1] * il); w0.y = pk2(o0[4 * gq + 2] * il, o0[4 * gq + 3] * il);
        u32x2s w1; w1.x = pk2(o1[4 * gq] * il, o1[4 * gq + 1] * il); w1.y = pk2(o1[4 * gq + 2] * il, o1[4 * gq + 3] * il);
        *(u32x2s*)(yp + 8 * gq) = w0; *(u32x2s*)(yp + 32 + 8 * gq) = w1;
    }
}

__device__ __forceinline__ void phase_finish(Frame& F, int L) {
    const bf16* U = (const bf16*)(F.ws + WS_B); bf16* Y = (bf16*)(F.ws + WS_A);
    const int gw = blockIdx.x * NWAVES + F.wave, NGW = F.G * NWAVES, lane = F.lane, nrows = (L == 0) ? MT : ML;
    float g1[8], g2[8];
#pragma unroll
    for (int j = 0; j < 8; ++j) { g1[j] = kin(I_MLNG)[L * 512 + 8 * lane + j]; g2[j] = kin(I_SSDNG)[L * 512 + 8 * lane + j]; }
    for (int r = gw; r < nrows; r += NGW) {
        bf16* yr = Y + (size_t)r * NY; const bf16* ur = U + (size_t)r * NU;
        const bf16* pr = (const bf16*)(F.ws + WS_P) + (size_t)r * 1024;
        { const v4u hw = *(const v4u*)(yr + 8 * lane), ow = *(const v4u*)(ur + UO + 8 * lane), pw = *(const v4u*)(pr + 8 * lane);
          float hv[8], ov[8];
          hv[0] = __uint_as_float(hw.x << 16); hv[1] = __uint_as_float(hw.x & 0xffff0000u); hv[2] = __uint_as_float(hw.y << 16); hv[3] = __uint_as_float(hw.y & 0xffff0000u);
          hv[4] = __uint_as_float(hw.z << 16); hv[5] = __uint_as_float(hw.z & 0xffff0000u); hv[6] = __uint_as_float(hw.w << 16); hv[7] = __uint_as_float(hw.w & 0xffff0000u);
          ov[0] = __uint_as_float(ow.x << 16); ov[1] = __uint_as_float(ow.x & 0xffff0000u); ov[2] = __uint_as_float(ow.y << 16); ov[3] = __uint_as_float(ow.y & 0xffff0000u);
          ov[4] = __uint_as_float(ow.z << 16); ov[5] = __uint_as_float(ow.z & 0xffff0000u); ov[6] = __uint_as_float(ow.w << 16); ov[7] = __uint_as_float(ow.w & 0xffff0000u);
          hv[0] += __uint_as_float(pw.x << 16); hv[1] += __uint_as_float(pw.x & 0xffff0000u); hv[2] += __uint_as_float(pw.y << 16); hv[3] += __uint_as_float(pw.y & 0xffff0000u);
          hv[4] += __uint_as_float(pw.z << 16); hv[5] += __uint_as_float(pw.z & 0xffff0000u); hv[6] += __uint_as_float(pw.w << 16); hv[7] += __uint_as_float(pw.w & 0xffff0000u);
          float ss = 0.f;
#pragma unroll
          for (int j = 0; j < 8; ++j) ss += hv[j] * hv[j];
#pragma unroll
          for (int o = 1; o < 16; o <<= 1) ss += __shfl_xor(ss, o);
          const float rs = 1.0f / sqrtf(ss * (1.f / 128.f) + EPS);
          float rv[8];
#pragma unroll
          for (int j = 0; j < 8; ++j) rv[j] = hv[j] * rs * g1[j] * __builtin_amdgcn_rcpf(1.f + __expf(-ov[j]));
          v4u w; w.x = pk2(rv[0], rv[1]); w.y = pk2(rv[2], rv[3]); w.z = pk2(rv[4], rv[5]); w.w = pk2(rv[6], rv[7]);
          *(v4u*)(yr + 8 * lane) = w; }
        { const v4u hw = *(const v4u*)(yr + 512 + 8 * lane), zw = *(const v4u*)(ur + UZ + 8 * lane), pw = *(const v4u*)(pr + 512 + 8 * lane);
          float hv[8], zv[8];
          hv[0] = __uint_as_float(hw.x << 16); hv[1] = __uint_as_float(hw.x & 0xffff0000u); hv[2] = __uint_as_float(hw.y << 16); hv[3] = __uint_as_float(hw.y & 0xffff0000u);
          hv[4] = __uint_as_float(hw.z << 16); hv[5] = __uint_as_float(hw.z & 0xffff0000u); hv[6] = __uint_as_float(hw.w << 16); hv[7] = __uint_as_float(hw.w & 0xffff0000u);
          zv[0] = __uint_as_float(zw.x << 16); zv[1] = __uint_as_float(zw.x & 0xffff0000u); zv[2] = __uint_as_float(zw.y << 16); zv[3] = __uint_as_float(zw.y & 0xffff0000u);
          zv[4] = __uint_as_float(zw.z << 16); zv[5] = __uint_as_float(zw.z & 0xffff0000u); zv[6] = __uint_as_float(zw.w << 16); zv[7] = __uint_as_float(zw.w & 0xffff0000u);
          hv[0] += __uint_as_float(pw.x << 16); hv[1] += __uint_as_float(pw.x & 0xffff0000u); hv[2] += __uint_as_float(pw.y << 16); hv[3] += __uint_as_float(pw.y & 0xffff0000u);
          hv[4] += __uint_as_float(pw.z << 16); hv[5] += __uint_as_float(pw.z & 0xffff0000u); hv[6] += __uint_as_float(pw.w << 16); hv[7] += __uint_as_float(pw.w & 0xffff0000u);
          float ss = 0.f;
#pragma unroll
          for (int j = 0; j < 8; ++j) { hv[j] = hv[j] * zv[j] * __builtin_amdgcn_rcpf(1.f + __expf(-zv[j])); ss += hv[j] * hv[j]; }
          ss = wave_sum(ss);
          const float rs = 1.0f / sqrtf(ss * (1.f / 512.f) + EPS);
          v4u w; w.x = pk2(hv[0] * rs * g2[0], hv[1] * rs * g2[1]); w.y = pk2(hv[2] * rs * g2[2], hv[3] * rs * g2[3]); w.z = pk2(hv[4] * rs * g2[4], hv[5] * rs * g2[5]); w.w = pk2(hv[6] * rs * g2[6], hv[7] * rs * g2[7]);
          *(v4u*)(yr + 512 + 8 * lane) = w; }
    }
}

#ifdef NO_MLSTM
#define MLSTM_CALL(d)
#else
#define MLSTM_CALL(d)
#endif
#ifdef NO_MLSTMB
#define MLSTMB_CALL(d, u)
#else
#define MLSTMB_CALL(d, u) mlstm_block_unit(F, L, d, u);
#endif
#ifdef NO_SSDB
#define SSDB_CALL(d, u)
#else
#define SSDB_CALL(d, u) ssd_block_unit(F, L, d, u);
#endif
#ifdef NO_SSD
#define SSD_CALL(d)
#else
#define SSD_CALL(d)
#endif
#ifdef NO_ATTN
#define ATTN_CALL ;
#else
#define ATTN_CALL attn_block_unit(F, L, u);
#endif
#ifndef DUP_MASK
#define DUP_MASK 0
#endif
#define TWICE(p, ...) do { int qrep = 0; (void)qrep; { __VA_ARGS__ } if (((DUP_MASK) >> (p)) & 1) { qrep = 1; __syncthreads(); asm volatile("" : "+v"(F.lane), "+v"(F.tid)); F.wave = __builtin_amdgcn_readfirstlane(F.tid >> 6); { __VA_ARGS__ } } } while (0)
struct Args { const float* in[24]; float* out; unsigned char* ws; int ph_lo, ph_hi; };
__global__ void __launch_bounds__(NWAVES * 64, 2) mk_fwd(Args args) {
    extern __shared__ __attribute__((aligned(16))) unsigned char lds[];
    Frame F;
    F.lds = (LAS unsigned char*)lds;
    F.MISC = (volatile LAS unsigned*)(F.lds + MISC_OFF);
    F.tid = threadIdx.x; F.lane = F.tid & 63; F.wave = __builtin_amdgcn_readfirstlane(F.tid >> 6);
    F.G = gridDim.x;
    F.ws = args.ws; F.out = args.out; F.ctl = (gu32*)(args.ws + WS_CTL);
    for (int u = F.tid; u < (LDS_BYTES - LDSCTL_OFF) / 4; u += NWAVES * 64) ((LAS unsigned*)(F.lds + LDSCTL_OFF))[u] = 0u;
    __syncthreads();
    const int lo = args.ph_lo, hi = args.ph_hi;
    const bool use_bar = (hi - lo) > 1;
    XcdBarrier bar; bar.bar = (unsigned*)(F.ctl + CW_BAR); bar.x = 0; bar.st = nullptr;
    if (use_bar) bar = xcd_barrier_post((unsigned*)(F.ctl + CW_BAR), F.MISC + 8);
#define IN(k) (lo <= (k) && (k) < hi)
#define XL ((L == 0) ? kin(I_X) : (const float*)F.out)
#define XC ((L == 0) ? kin(I_CTX) : (const float*)(F.ws + WS_CTXF))
#define SEAM(k) do { if (IN(k) && IN((k) + 1)) xcd_barrier(bar); asm volatile("" : "+v"(F.lane), "+v"(F.tid)); F.wave = __builtin_amdgcn_readfirstlane(F.tid >> 6); } while (0)

    bf16* W0 = (bf16*)(F.ws + WS_W0); bf16* W1 = (bf16*)(F.ws + WS_W1);
    bf16* RA = (bf16*)(F.ws + WS_A); bf16* RB = (bf16*)(F.ws + WS_B);
    float* CTXF = (float*)(F.ws + WS_CTXF);
    const float* MOD = (const float*)(F.ws + WS_MOD);

        if (IN(0)) { phase_mod(F); }
    SEAM(0);

    for (int L = 0; L < 2; ++L) {
        const int p0 = 1 + 9 * L;
        const int Mout = (L == 0) ? MT : ML;
        if (IN(p0 + 0)) TWICE(0,
            convert_win(F, kin(I_WIN) + (size_t)L * DM * INW, W0);
            convert_weight(F, kin(I_WOUT) + (size_t)L * NY * DM, NY, DM, W1);
            norm_rows(F, L, MT, XL, XC, kin(I_N1G) + L * DM, 0, RA);
            __syncthreads();
        );
        SEAM(p0 + 0);
        if (IN(p0 + 1)) TWICE(1,
            pg8::Gemm g{RA, W0, MT, NUP, DM}; pg8::StaticOrder S; S.init(MT, NUP, F.G, (int)blockIdx.x);
            pg8::EpiU E{RB, (float*)(F.ws + WS_GATES), (const float*)(F.ws + WS_GB) + L * 32};
            pg8::gemm_phase<pg8::EpiU, pg8::StaticOrder, true, true>(F.lds + RING_OFF, g, S, E);
        );
        SEAM(p0 + 1);
        if (IN(p0 + 2)) { phase_qkn(F, L); phase_scan_prep(F, L); }
        SEAM(p0 + 2);
        if (IN(p0 + 3)) TWICE(3,
            if (blockIdx.x < 64) { MLSTMB_CALL((int)blockIdx.x >> 5, (int)blockIdx.x & 31) }
            else if (blockIdx.x < 128) { SSDB_CALL(((int)blockIdx.x - 64) >> 5, ((int)blockIdx.x - 64) & 31) }
            { const int nun = (L == 0) ? 576 : 512;
              for (;;) { __syncthreads(); if (F.tid == 0) F.MISC[16] = __hip_atomic_fetch_add((unsigned*)(F.ctl + 64 + 64 * (L + 2 * qrep)), 1u, __ATOMIC_RELAXED, __HIP_MEMORY_SCOPE_AGENT);
                  __syncthreads(); const int u = (int)F.MISC[16]; if (u >= nun) break; ATTN_CALL } }
            __syncthreads();
        );
        SEAM(p0 + 3);
        if (IN(p0 + 4)) { phase_finish(F, L); }
        SEAM(p0 + 4);
        if (IN(p0 + 5)) {
            pg8::Gemm g{RA, W1, Mout, DM, NY}; pg8::StaticOrder S; S.init(Mout, DM, F.G, (int)blockIdx.x);
            pg8::EpiRes E{XL, F.out, XC, CTXF, MOD + (size_t)L * 9 * 6144 + 2 * 1024};
            pg8::gemm_phase<pg8::EpiRes, pg8::StaticOrder, true, true>(F.lds + RING_OFF, g, S, E);
        }
        SEAM(p0 + 5);
        if (IN(p0 + 6)) TWICE(6,
            convert_weight(F, kin(I_WUP) + (size_t)L * DM * DFF, DM, DFF, W0);
            convert_weight(F, kin(I_WDOWN) + (size_t)L * DFF * DM, DFF, DM, W1);
            norm_rows(F, L, Mout, (const float*)F.out, (const float*)CTXF, kin(I_N2G) + L * DM, 3, RA);
        );
        SEAM(p0 + 6);
        if (IN(p0 + 7)) TWICE(7,
            pg8::Gemm g{RA, W0, Mout, DFF, DM}; pg8::StaticOrder S; S.init(Mout, DFF, F.G, (int)blockIdx.x);
            pg8::EpiBf16<2> E{RB, DFF};
            pg8::gemm_phase<pg8::EpiBf16<2>, pg8::StaticOrder, true, true>(F.lds + RING_OFF, g, S, E);
        );
        SEAM(p0 + 7);
        if (IN(p0 + 8)) {
            pg8::Gemm g{RB, W1, Mout, DM, DFF}; pg8::StaticOrder S; S.init(Mout, DM, F.G, (int)blockIdx.x);
            pg8::EpiRes E{(const float*)F.out, F.out, (const float*)CTXF, CTXF, MOD + (size_t)L * 9 * 6144 + 5 * 1024};
            pg8::gemm_phase<pg8::EpiRes, pg8::StaticOrder, true, true>(F.lds + RING_OFF, g, S, E);
        }
        SEAM(p0 + 8);
    }
#undef IN
#undef SEAM
}

#ifndef MK_N_LAUNCHES
#define MK_N_LAUNCHES 1
#endif
extern "C" void kernel_launch(void* const* d_in, const int* in_sizes, int n_in, void* d_out, int out_size, void* d_ws, size_t ws_size, hipStream_t stream) {
    static int grid = 0;
    if (grid == 0) {
        if (n_in != 24 || out_size != ML * DM || ws_size < WS_END) { fprintf(stderr, "kernel_launch: unexpected shapes (n_in %d out %d ws %zu)\n", n_in, out_size, ws_size); grid = -1; return; }
        int dev = 0, cus = 0, per_cu = 0;
        if (hipGetDevice(&dev) != hipSuccess || hipDeviceGetAttribute(&cus, hipDeviceAttributeMultiprocessorCount, dev) != hipSuccess) { grid = -1; return; }
        if (hipFuncSetAttribute((const void*)mk_fwd, hipFuncAttributeMaxDynamicSharedMemorySize, LDS_BYTES) != hipSuccess) { fprintf(stderr, "kernel_launch: hipFuncSetAttribute failed\n"); grid = -1; return; }
        if (hipOccupancyMaxActiveBlocksPerMultiprocessor(&per_cu, (const void*)mk_fwd, NWAVES * 64, LDS_BYTES) != hipSuccess || per_cu < 1) fprintf(stderr, "kernel_launch: occupancy query reports %d\n", per_cu);
        (void)hipGetLastError();
        grid = cus;
    }
    if (grid < 0) return;
    if (hipMemsetAsync((char*)d_ws + WS_CTL, 0, CTL_ZERO_BYTES, stream) != hipSuccess) return;
    Args a{};
    for (int i = 0; i < 24; ++i) a.in[i] = (const float*)d_in[i];
    a.out = (float*)d_out; a.ws = (unsigned char*)d_ws;
    if (MK_N_LAUNCHES == 1) { a.ph_lo = 0; a.ph_hi = NPH; hipLaunchKernelGGL(mk_fwd, dim3(grid), dim3(NWAVES * 64), LDS_BYTES, stream, a); }
    else { for (int p = 0; p < NPH; ++p) { a.ph_lo = p; a.ph_hi = p + 1; hipLaunchKernelGGL(mk_fwd, dim3(grid), dim3(NWAVES * 64), LDS_BYTES, stream, a); } }
}
```

```cpp
#include <hip/hip_runtime.h>
#include <cstdio>
#include <cstdint>
#include <cmath>
namespace pg8 {
#define PG8_LAS __attribute__((address_space(3)))
typedef unsigned short bf16_t;
typedef short bf16x8 __attribute__((ext_vector_type(8)));
typedef float f32x4 __attribute__((ext_vector_type(4)));
typedef unsigned u32x4 __attribute__((ext_vector_type(4)));
constexpr int BM = 256, BK = 64, HALF = 128, HTB = HALF * BK * 2  , STAGE_BYTES = 8 * HTB, NXCD = 8, WGM = 8;

__host__ __device__ __forceinline__ int lds_byte(int r, int c) { const int st = (r >> 4) * 2 + (c >> 5), rr = r & 15, cc = c & 31, ob = rr * 64 + cc * 2; return st * 1024 + (ob ^ (((ob >> 9) & 1) << 5)); }
__host__ __device__ __forceinline__ void stage_rc(int b, int& R, int& C) { const int st = b / 1024, sb = b % 1024, swz = sb ^ (((sb >> 9) & 1) << 5); R = (st >> 1) * 16 + swz / 64; C = (st & 1) * 32 + (swz % 64) / 2; }
__host__ __device__ __forceinline__ int perm32(int rho) { const int n = rho >> 4, i = rho & 15; return 8 * (i >> 2) + 4 * n + (i & 3); }

struct Unit { int pm, pn; };
struct Gemm { const bf16_t* A; const bf16_t* Bt; int M, N, K; };

struct StaticOrder {
    int nM, nN, nwg, G, c;
    __host__ __device__ void init(int M, int N, int G_, int c_) { nM = M / BM; nN = N / BM; nwg = nM * nN; G = G_; c = c_; }
    __host__ __device__ bool next(int i, Unit& u) const {
        const long L = (long)i * G + c; if (L >= nwg) return false;
        int wgid = (int)L; { const int q = nwg / NXCD, r = nwg % NXCD, xcd = wgid % NXCD, off = wgid / NXCD; wgid = (xcd < r ? xcd * (q + 1) : r * (q + 1) + (xcd - r) * q) + off; }
        const int nig = WGM * nN, gid = wgid / nig, fm = gid * WGM, gsz = (nM - fm) < WGM ? (nM - fm) : WGM;
        u.pm = fm + ((wgid % nig) % gsz); u.pn = (wgid % nig) / gsz; return true;
    }
    __device__ __forceinline__ void a_ready(const Unit&) const {}
    __device__ __forceinline__ void done(const Unit&) const {}
};

__device__ __forceinline__ unsigned cvt_pk_bf16(float lo, float hi) { unsigned r; asm volatile("v_cvt_pk_bf16_f32 %0, %1, %2" : "=v"(r) : "v"(lo), "v"(hi)); return r; }
typedef float f32x2 __attribute__((ext_vector_type(2)));
__device__ __forceinline__ f32x2 gelu_pk(f32x2 v) {
    const f32x2 av = __builtin_elementwise_abs(v), d = av * 0.2316418882f + 1.0f;
    f32x2 t; t.x = __builtin_amdgcn_rcpf(d.x); t.y = __builtin_amdgcn_rcpf(d.y);
    f32x2 q = t * 0.5307027145f + (-0.7265760135f); q = q * t + 0.7107068705f; q = q * t + (-0.142248368f); q = q * t + 0.127414796f; q = q * t;
    const f32x2 s = (v * v) * (-0.72134752044f);
    f32x2 e; e.x = __builtin_amdgcn_exp2f(s.x); e.y = __builtin_amdgcn_exp2f(s.y);
    const f32x2 m = v * (q * e), r = v - m;
    f32x2 o; o.x = v.x < 0.f ? m.x : r.x; o.y = v.y < 0.f ? m.y : r.y; return o;
}

template <int ACT  > struct EpiBf16 {
    static constexpr bool PERM = true, AFTER_DRAIN = false;
    bf16_t* O; int ldc;
    __device__ __forceinline__ void operator()(const f32x4 (&acc)[2][2][4][2], const Unit& u, int wr, int wc, int fr, int fq) const {
        const int row0 = u.pm * BM + wr * 64 + fr; const int col0 = u.pn * BM + wc * 32 + 8 * fq;
#pragma unroll
        for (int ai = 0; ai < 2; ++ai)
#pragma unroll
            for (int m = 0; m < 4; ++m) { bf16_t* rowp = O + (size_t)(row0 + ai * HALF + m * 16) * ldc + col0;
#pragma unroll
                for (int bj = 0; bj < 2; ++bj) { f32x4 v0 = acc[ai][bj][m][0], v1 = acc[ai][bj][m][1];
                    if (ACT == 2) {
#pragma unroll
                        for (int e = 0; e < 4; ++e) { float a = v0[e] > 0.f ? v0[e] : 0.f; v0[e] = a * a; float b = v1[e] > 0.f ? v1[e] : 0.f; v1[e] = b * b; } }
                    u32x4 w; w.x = cvt_pk_bf16(v0[0], v0[1]); w.y = cvt_pk_bf16(v0[2], v0[3]); w.z = cvt_pk_bf16(v1[0], v1[1]); w.w = cvt_pk_bf16(v1[2], v1[3]);
                    *(u32x4*)(rowp + bj * HALF) = w; } }
    }
};
struct EpiRes {
    static constexpr bool PERM = false, AFTER_DRAIN = false;
    const float* base_l; float* out_l; const float* base_c; float* out_c; const float* gate;
    __device__ __forceinline__ void operator()(const f32x4 (&acc)[2][2][4][2], const Unit& u, int wr, int wc, int fr, int fq) const {
        const bool lat = u.pm < 64;
        const float* bs = lat ? base_l + (size_t)u.pm * BM * 1024 : base_c + (size_t)(u.pm - 64) * BM * 1024;
        float* ot = lat ? out_l + (size_t)u.pm * BM * 1024 : out_c + (size_t)(u.pm - 64) * BM * 1024;
        const float* gt = gate + (size_t)(lat ? (u.pm >> 3) : 8) * 6144;
        const int col0 = u.pn * BM + wc * 32 + 4 * fq;
        f32x4 gv[2][2];
#pragma unroll
        for (int bj = 0; bj < 2; ++bj)
#pragma unroll
            for (int n = 0; n < 2; ++n) gv[bj][n] = *(const f32x4*)(gt + col0 + bj * HALF + n * 16);
#pragma unroll
        for (int ai = 0; ai < 2; ++ai)
#pragma unroll
            for (int m = 0; m < 4; ++m) { const size_t off = (size_t)(ai * HALF + wr * 64 + m * 16 + fr) * 1024 + col0;
#pragma unroll
                for (int bj = 0; bj < 2; ++bj)
#pragma unroll
                    for (int n = 0; n < 2; ++n) { const f32x4 b = *(const f32x4*)(bs + off + bj * HALF + n * 16);
                        *(f32x4*)(ot + off + bj * HALF + n * 16) = b + gv[bj][n] * acc[ai][bj][m][n]; }
                if (m & 1) asm volatile("" ::: "memory"); }
    }
};

struct EpiU {
    static constexpr bool PERM = true, AFTER_DRAIN = false;
    unsigned char* ws; unsigned o_off, g_off, c_off;
    __device__ __forceinline__ void operator()(const f32x4 (&acc)[2][2][4][2], const Unit& u, int wr, int wc, int fr, int fq) const {
        const int row0 = u.pm * BM + wr * 64 + fr;
        bf16_t* O = (bf16_t*)(ws + o_off); const float* cst = (const float*)(ws + c_off);
        if (u.pn < 16) {
            const int col0 = u.pn * BM + wc * 32 + 8 * fq;
            const bool nrm = (u.pn == 13 || u.pn == 14 || (u.pn == 15 && wc < 2));
            if (!nrm) {
#pragma unroll
                for (int ai = 0; ai < 2; ++ai)
#pragma unroll
                    for (int m = 0; m < 4; ++m) { bf16_t* rowp = O + (size_t)(row0 + ai * HALF + m * 16) * 4096 + col0;
#pragma unroll
                        for (int bj = 0; bj < 2; ++bj) { const f32x4 v0 = acc[ai][bj][m][0], v1 = acc[ai][bj][m][1];
                            u32x4 w; w.x = cvt_pk_bf16(v0[0], v0[1]); w.y = cvt_pk_bf16(v0[2], v0[3]); w.z = cvt_pk_bf16(v1[0], v1[1]); w.w = cvt_pk_bf16(v1[2], v1[3]);
                            *(u32x4*)(rowp + bj * HALF) = w; } }
            } else {
                const bool isq = u.pn < 15; const float* gp = cst + (isq ? 32 : 96) + 8 * fq; const float sc = isq ? 0.125f * 1.4426950408889634f : 1.0f;
                const bool rope = u.pm < 64;
                const float sgn = (fq < 2) ? -1.f : 1.f;
                const float* rt = cst + 1024 + 16 * (fq & 1);
#pragma unroll
                for (int ai = 0; ai < 2; ++ai)
#pragma unroll
                    for (int m = 0; m < 4; ++m) { const int row = row0 + ai * HALF + m * 16; const int t = row & 2047;
                        float ss = 0.f;
#pragma unroll
                        for (int bj = 0; bj < 2; ++bj) { const f32x4 v0 = acc[ai][bj][m][0], v1 = acc[ai][bj][m][1];
                            ss += (v0[0] * v0[0] + v0[1] * v0[1]) + (v0[2] * v0[2] + v0[3] * v0[3]) + (v1[0] * v1[0] + v1[1] * v1[1]) + (v1[2] * v1[2] + v1[3] * v1[3]); }
                        ss += __shfl_xor(ss, 16); ss += __shfl_xor(ss, 32);
                        const float rs = sc / sqrtf(ss * (1.f / 64.f) + 1e-6f);
                        bf16_t* rowp = O + (size_t)row * 4096 + col0;
#pragma unroll
                        for (int bj = 0; bj < 2; ++bj) { const int pos = (bj == 0) ? (t >> 6) : (t & 63);
                            const f32x4 g0 = *(const f32x4*)(gp + 32 * bj), g1 = *(const f32x4*)(gp + 32 * bj + 4);
                            const f32x4 v0 = acc[ai][bj][m][0] * g0 * rs, v1 = acc[ai][bj][m][1] * g1 * rs;
                            float y[8] = {v0[0], v0[1], v0[2], v0[3], v1[0], v1[1], v1[2], v1[3]};
                            if (rope) { const f32x4 c0 = *(const f32x4*)(rt + pos * 32), c1 = *(const f32x4*)(rt + pos * 32 + 4), c2 = *(const f32x4*)(rt + pos * 32 + 8), c3 = *(const f32x4*)(rt + pos * 32 + 12);
                                const float cs[8] = {c0[0], c0[2], c1[0], c1[2], c2[0], c2[2], c3[0], c3[2]}, sn[8] = {c0[1], c0[3], c1[1], c1[3], c2[1], c2[3], c3[1], c3[3]};
#pragma unroll
                                for (int e2 = 0; e2 < 8; ++e2) { const auto sw = __builtin_amdgcn_permlane32_swap(__float_as_uint(y[e2]), __float_as_uint(y[e2]), false, false);
                                    const float pr = __uint_as_float(fq < 2 ? sw[1] : sw[0]); y[e2] = y[e2] * cs[e2] + sgn * pr * sn[e2]; } }
                            u32x4 w; w.x = cvt_pk_bf16(y[0], y[1]); w.y = cvt_pk_bf16(y[2], y[3]); w.z = cvt_pk_bf16(y[4], y[5]); w.w = cvt_pk_bf16(y[6], y[7]);
                            *(u32x4*)(rowp + bj * HALF) = w; }
                        asm volatile("" ::: "memory"); __builtin_amdgcn_sched_barrier(0); }
            }
        } else if (wc == 0) {
            const int gj0 = 8 * fq; const f32x4 b0 = *(const f32x4*)(cst + gj0), b1 = *(const f32x4*)(cst + gj0 + 4); float* G = (float*)(ws + g_off);
#pragma unroll
            for (int ai = 0; ai < 2; ++ai)
#pragma unroll
                for (int m = 0; m < 4; ++m) { f32x4 v0 = acc[ai][0][m][0] + b0, v1 = acc[ai][0][m][1] + b1;
                    if (fq != 0) { const float sg = (fq == 1) ? -1.f : 1.f;
#pragma unroll
                        for (int e2 = 0; e2 < 4; ++e2) { const float z0 = v0[e2], z1 = v1[e2];
                            const float l0 = __logf(1.f + __expf(-fabsf(z0))), l1 = __logf(1.f + __expf(-fabsf(z1)));
                            v0[e2] = (fq == 1 ? fminf(z0, 0.f) : fmaxf(z0, 0.f)) + sg * l0; v1[e2] = (fq == 1 ? fminf(z1, 0.f) : fmaxf(z1, 0.f)) + sg * l1; } }
                    float* gp2 = G + (size_t)(row0 + ai * HALF + m * 16) * 32 + gj0;
                    *(f32x4*)gp2 = v0; *(f32x4*)(gp2 + 4) = v1; }
        }
    }
};

template <class Epi, class Sched, bool ALIGN_EPI = false, bool SP2 = false>
__device__ __forceinline__ void gemm_phase(PG8_LAS unsigned char* lds, const Gemm g, const Sched& S, const Epi& E) {
    int tid_l = threadIdx.x; asm volatile("" : "+v"(tid_l));
    const int tid = tid_l, wid = __builtin_amdgcn_readfirstlane(tid >> 6), lane = tid & 63, wr = wid >> 2, wc = wid & 3, fr = lane & 15, fq = lane >> 4;
    const int K = g.K, nt = K / BK;
    unsigned voffA[2], voffB[2];
#pragma unroll
    for (int i = 0; i < 2; ++i) { int R, C; stage_rc(tid * 16 + i * 8192, R, C); const int Rb = Epi::PERM ? ((R & ~31) + perm32(R & 31)) : R;
        voffA[i] = (unsigned)(R * K + C) * 2u; voffB[i] = (unsigned)(Rb * K + C) * 2u; }
    const size_t kstep = (size_t)(BK * 2);
    const size_t hstep = (size_t)HALF * K * 2;
    const size_t tstep = 2 * hstep;
    const unsigned ldsw = (unsigned)wid * 1024u;
    const int aoff = lds_byte(wr * 64 + fr, fq * 8), boff = lds_byte(wc * 32 + fr, fq * 8);
#define PG8_SA(b, h) (((b) * 2 + (h)) * HTB)
#define PG8_SB(b, h) ((4 + (b) * 2 + (h)) * HTB)
#define PG8_STAGE(bufoff, gbase, voff) do { _Pragma("unroll") for (int _i = 0; _i < 2; ++_i) \
        __builtin_amdgcn_global_load_lds((const unsigned*)((const char*)(gbase) + (voff)[_i]), (PG8_LAS unsigned*)(lds + (bufoff) + ldsw + _i * 8192), 16, 0, 0); } while (0)
#define PG8_LDA(dst, b, h) do { _Pragma("unroll") for (int m = 0; m < 4; ++m) _Pragma("unroll") for (int k = 0; k < 2; ++k) dst[m][k] = *(const PG8_LAS bf16x8*)(lds + PG8_SA(b, h) + aoff + m * 2048 + k * 1024); } while (0)
#define PG8_LDB(dst, b, h) do { _Pragma("unroll") for (int n = 0; n < 2; ++n) _Pragma("unroll") for (int k = 0; k < 2; ++k) dst[n][k] = *(const PG8_LAS bf16x8*)(lds + PG8_SB(b, h) + boff + n * 2048 + k * 1024); } while (0)
#define PG8_MMA(ai, bj, At, Bt) do { __builtin_amdgcn_s_setprio(1); _Pragma("unroll") for (int m = 0; m < 4; ++m) _Pragma("unroll") for (int n = 0; n < 2; ++n) _Pragma("unroll") for (int k = 0; k < 2; ++k) \
        acc[ai][bj][m][n] = __builtin_amdgcn_mfma_f32_16x16x32_bf16(Bt[n][k], At[m][k], acc[ai][bj][m][n], 0, 0, 0); __builtin_amdgcn_s_setprio(0); } while (0)
#define PG8_WAIT_V(n) asm volatile("s_waitcnt vmcnt(" #n ")" ::: "memory")
#define PG8_WAIT_L(n) asm volatile("s_waitcnt lgkmcnt(" #n ")" ::: "memory")
#define PG8_BAR __builtin_amdgcn_s_barrier()
#define PG8_SCHED __builtin_amdgcn_sched_barrier(0)
    Unit cur, nxt; int ui = 0;
    if (!S.next(0, cur)) return;
    f32x4 acc[2][2][4][2];
#pragma unroll
    for (int a = 0; a < 2; ++a)
#pragma unroll
        for (int b = 0; b < 2; ++b)
#pragma unroll
            for (int m = 0; m < 4; ++m)
#pragma unroll
                for (int n = 0; n < 2; ++n) acc[a][b][m][n] = (f32x4){0.f, 0.f, 0.f, 0.f};
    bf16x8 At[4][2], B0[2][2], B1[2][2];
    const char* cA = (const char*)g.A + (size_t)cur.pm * tstep; const char* cB = (const char*)g.Bt + (size_t)cur.pn * tstep;
    S.a_ready(cur);
    if constexpr (SP2) {
        PG8_STAGE(PG8_SB(0, 0), cB, voffB); PG8_STAGE(PG8_SB(0, 1), cB + hstep, voffB); PG8_STAGE(PG8_SA(0, 0), cA, voffA); PG8_STAGE(PG8_SA(0, 1), cA + hstep, voffA);
        if (wr == 1) PG8_BAR;
        PG8_WAIT_V(2); PG8_BAR;
        PG8_STAGE(PG8_SB(1, 0), cB + kstep, voffB); PG8_STAGE(PG8_SA(1, 0), cA + kstep, voffA); PG8_STAGE(PG8_SB(1, 1), cB + hstep + kstep, voffB);
        PG8_WAIT_V(6); PG8_BAR;
    } else {
        PG8_STAGE(PG8_SB(0, 0), cB, voffB); PG8_STAGE(PG8_SA(0, 0), cA, voffA); PG8_STAGE(PG8_SB(0, 1), cB + hstep, voffB); PG8_STAGE(PG8_SA(0, 1), cA + hstep, voffA);
        if (wr == 1) PG8_BAR;
        PG8_WAIT_V(4); PG8_BAR;
        PG8_STAGE(PG8_SB(1, 0), cB + kstep, voffB); PG8_STAGE(PG8_SA(1, 0), cA + kstep, voffA); PG8_STAGE(PG8_SB(1, 1), cB + hstep + kstep, voffB);
        PG8_WAIT_V(6); PG8_BAR;
    }
    for (;;) {
        const bool has_next = S.next(ui + 1, nxt);
        const char* nA = has_next ? (const char*)g.A + (size_t)nxt.pm * tstep : cA; const char* nB = has_next ? (const char*)g.Bt + (size_t)nxt.pn * tstep : cB;
        for (int t = 0; t < nt; t += 2) {
            const bool last = (t == nt - 2);
            const char* a1 = cA + (size_t)(t + 1) * kstep;
            const char* a2 = last ? nA : cA + (size_t)(t + 2) * kstep; const char* b2 = last ? nB : cB + (size_t)(t + 2) * kstep;
            const char* a3 = a2 + kstep; const char* b3 = b2 + kstep;
            if (last && has_next) S.a_ready(nxt);
            if constexpr (SP2) {
            PG8_LDB(B0, 0, 0); PG8_LDB(B1, 0, 1); PG8_SCHED; PG8_LDA(At, 0, 0); PG8_STAGE(PG8_SA(1, 1), a1 + hstep, voffA);
            PG8_WAIT_V(8); PG8_WAIT_L(0); PG8_BAR; PG8_MMA(0, 0, At, B0); PG8_MMA(0, 1, At, B1); PG8_BAR; PG8_SCHED;
            PG8_LDA(At, 0, 1); PG8_STAGE(PG8_SB(0, 0), b2, voffB); PG8_STAGE(PG8_SB(0, 1), b2 + hstep, voffB); PG8_STAGE(PG8_SA(0, 0), a2, voffA);
            PG8_WAIT_V(8); PG8_WAIT_L(0); PG8_BAR; PG8_MMA(1, 0, At, B0); PG8_MMA(1, 1, At, B1); PG8_BAR; PG8_SCHED;
            PG8_LDB(B0, 1, 0); PG8_LDB(B1, 1, 1); PG8_SCHED; PG8_LDA(At, 1, 0); PG8_STAGE(PG8_SA(0, 1), a2 + hstep, voffA);
            PG8_WAIT_V(8); PG8_WAIT_L(0); PG8_BAR; PG8_MMA(0, 0, At, B0); PG8_MMA(0, 1, At, B1); PG8_BAR; PG8_SCHED;
            PG8_LDA(At, 1, 1); PG8_STAGE(PG8_SB(1, 0), b3, voffB); PG8_STAGE(PG8_SB(1, 1), b3 + hstep, voffB); PG8_STAGE(PG8_SA(1, 0), a3, voffA);
            PG8_WAIT_V(8); PG8_WAIT_L(0); PG8_BAR; PG8_MMA(1, 0, At, B0); PG8_MMA(1, 1, At, B1); PG8_BAR; PG8_SCHED;
            } else {
            PG8_LDB(B0, 0, 0); PG8_SCHED; PG8_LDA(At, 0, 0); PG8_STAGE(PG8_SA(1, 1), a1 + hstep, voffA);
            PG8_WAIT_L(8); PG8_BAR; PG8_WAIT_L(0); PG8_MMA(0, 0, At, B0); PG8_BAR; PG8_SCHED;
            PG8_LDB(B1, 0, 1); PG8_STAGE(PG8_SB(0, 0), b2, voffB);
            PG8_BAR; PG8_WAIT_L(0); PG8_MMA(0, 1, At, B1); PG8_BAR;
            PG8_LDA(At, 0, 1); PG8_STAGE(PG8_SA(0, 0), a2, voffA);
            PG8_BAR; PG8_WAIT_L(0); PG8_MMA(1, 0, At, B0); PG8_BAR; PG8_SCHED;
            PG8_STAGE(PG8_SB(0, 1), b2 + hstep, voffB);
            PG8_WAIT_V(6); PG8_BAR; PG8_MMA(1, 1, At, B1); PG8_BAR;
            PG8_LDB(B0, 1, 0); PG8_SCHED; PG8_LDA(At, 1, 0); PG8_STAGE(PG8_SA(0, 1), a2 + hstep, voffA);
            PG8_WAIT_L(8); PG8_BAR; PG8_WAIT_L(0); PG8_MMA(0, 0, At, B0); PG8_BAR; PG8_SCHED;
            PG8_LDB(B1, 1, 1); PG8_STAGE(PG8_SB(1, 0), b3, voffB);
            PG8_BAR; PG8_WAIT_L(0); PG8_MMA(0, 1, At, B1); PG8_BAR;
            PG8_LDA(At, 1, 1); PG8_STAGE(PG8_SA(1, 0), a3, voffA);
            PG8_BAR; PG8_WAIT_L(0); PG8_MMA(1, 0, At, B0); PG8_BAR; PG8_SCHED;
            PG8_STAGE(PG8_SB(1, 1), b3 + hstep, voffB);
            PG8_WAIT_V(6); PG8_BAR; PG8_MMA(1, 1, At, B1); PG8_BAR;
            }
        }
        if constexpr (ALIGN_EPI) { if (wr == 0) PG8_BAR; }
        if constexpr (!Epi::AFTER_DRAIN) { E(acc, cur, wr, wc, fr, fq); S.done(cur); }
        if (!has_next) break;
#pragma unroll
        for (int a = 0; a < 2; ++a)
#pragma unroll
            for (int b = 0; b < 2; ++b)
#pragma unroll
                for (int m = 0; m < 4; ++m)
#pragma unroll
                    for (int n = 0; n < 2; ++n) acc[a][b][m][n] = (f32x4){0.f, 0.f, 0.f, 0.f};
        cur = nxt; cA = nA; cB = nB; ++ui;
        if constexpr (ALIGN_EPI) { if (wr == 1) PG8_BAR; }
    }
    PG8_WAIT_V(0);
    if constexpr (!ALIGN_EPI) { if (wr == 0) PG8_BAR; }
    PG8_BAR;
    if constexpr (Epi::AFTER_DRAIN) { E.fused(acc, cur, wr, wc, fr, fq, lds, wid, lane); S.done(cur); }
#undef PG8_SA
#undef PG8_SB
#undef PG8_STAGE
#undef PG8_LDA
#undef PG8_LDB
#undef PG8_MMA
#undef PG8_WAIT_V
#undef PG8_WAIT_L
#undef PG8_BAR
#undef PG8_SCHED
}
}
#define GAS __attribute__((address_space(1)))
#define LAS __attribute__((address_space(3)))
typedef unsigned short bf16;
typedef unsigned v4u __attribute__((ext_vector_type(4)));
typedef float f32x4 __attribute__((ext_vector_type(4)));
typedef short bf16x8 __attribute__((ext_vector_type(8)));
typedef GAS unsigned gu32;
typedef GAS unsigned long long gu64;
#define RLX_AGENT __ATOMIC_RELAXED, __HIP_MEMORY_SCOPE_AGENT
#define LDS_WAIT() asm volatile("s_waitcnt lgkmcnt(0)" ::: "memory")
#define VM_WAIT() asm volatile("s_waitcnt vmcnt(0)" ::: "memory")
__device__ __forceinline__ unsigned long long rt() { return __builtin_amdgcn_s_memrealtime(); }
__device__ __forceinline__ unsigned f2bf(float f) { unsigned u = __builtin_bit_cast(unsigned, f); return (u + 0x7fffu + ((u >> 16) & 1u)) >> 16; }
typedef float f32x2_cv __attribute__((ext_vector_type(2))); typedef __bf16 bf16x2_cv __attribute__((ext_vector_type(2)));
__device__ __forceinline__ unsigned pk2(float lo, float hi) { const f32x2_cv v = {lo, hi}; const bf16x2_cv r = __builtin_convertvector(v, bf16x2_cv); return __builtin_bit_cast(unsigned, r); }

#define XB_TMO      128
#define XB_XCNT(j)  (256  + 64 * (j))
#define XB_XSUB(j)  (1280 + 64 * (j))
#define XB_XGEN(j)  (2304 + 64 * (j))
#define XB_TOP      3328
#define XB_TOPGEN   3392
#define XCD_BAR_WORDS 3456
#define XB_SPIN_CAP (1u << 18)

__device__ __forceinline__ unsigned xb_ld(unsigned* p)              { return __hip_atomic_load(p, __ATOMIC_RELAXED, __HIP_MEMORY_SCOPE_AGENT); }
__device__ __forceinline__ unsigned xb_add(unsigned* p, unsigned v) { return __hip_atomic_fetch_add(p, v, __ATOMIC_RELAXED, __HIP_MEMORY_SCOPE_AGENT); }
__device__ __forceinline__ unsigned xb_xcc_id() { return (unsigned)__builtin_amdgcn_s_getreg((3 << 11) | 20) & 0xFu; }
#define XB_SPIN(cond, bar) do { unsigned _sp = 0; while (cond) { __builtin_amdgcn_s_sleep(1); \
    if ((++_sp & 255u) == 0u) { if (xb_ld(&(bar)[XB_TMO])) break; if (_sp > XB_SPIN_CAP) { atomicAdd(&(bar)[XB_TMO], 1u); break; } } } } while (0)

struct XcdBarrier {
    unsigned* bar; unsigned x;
    volatile LAS unsigned* st;
};

__device__ __forceinline__ XcdBarrier xcd_barrier_post(unsigned* bar, volatile LAS unsigned* st) {
    XcdBarrier b; b.bar = bar; b.x = xb_xcc_id(); b.st = st;
    if (threadIdx.x == 0) (void)xb_add(&bar[XB_XCNT(b.x)], 1u);
    return b;
}
__device__ __forceinline__ void xcd_barrier_complete(unsigned* bar, unsigned x, unsigned& nloc, unsigned& nx) {
    const unsigned G = gridDim.x * gridDim.y * gridDim.z;
    unsigned sum, cnt, mine, sp = 0u;
    for (;;) {
        sum = 0u; cnt = 0u; mine = 0u;
#pragma unroll
        for (unsigned j = 0; j < 16; ++j) { const unsigned c = xb_ld(&bar[XB_XCNT(j)]); sum += c; cnt += (c > 0u) ? 1u : 0u; mine = (j == x) ? c : mine; }
        if (sum == G) break;
        __builtin_amdgcn_s_sleep(1);
        if ((++sp & 255u) == 0u) { if (xb_ld(&bar[XB_TMO])) break; if (sp > XB_SPIN_CAP) { atomicAdd(&bar[XB_TMO], 1u); break; } }
    }
    nloc = mine > 0u ? mine : 1u; nx = cnt > 0u ? cnt : 1u;
}

__device__ __forceinline__ void xcd_barrier(const XcdBarrier& b) {
    asm volatile("s_waitcnt vmcnt(0)" ::: "memory");
    __syncthreads();
    if (threadIdx.x == 0) {
        unsigned* bar = b.bar;
        __builtin_amdgcn_s_waitcnt(0);
        unsigned nloc = b.st[0], nx = b.st[1];
        if (nloc == 0u) { xcd_barrier_complete(bar, b.x, nloc, nx); b.st[0] = nloc; b.st[1] = nx; }
        const unsigned old = xb_add(&bar[XB_XSUB(b.x)], 1u);
        const unsigned gen = old / nloc;
        if (old + 1u == (gen + 1u) * nloc) {
            __builtin_amdgcn_fence(__ATOMIC_RELEASE, "agent");
            asm volatile("s_waitcnt vmcnt(0)" ::: "memory");
            const unsigned og = xb_add(&bar[XB_TOP], 1u);
            const unsigned tg = og / nx;
            if (og + 1u == (tg + 1u) * nx) xb_add(&bar[XB_TOPGEN], 1u);
            else XB_SPIN(xb_ld(&bar[XB_TOPGEN]) == tg, bar);
            __builtin_amdgcn_fence(__ATOMIC_ACQUIRE, "agent");
            xb_add(&bar[XB_XGEN(b.x)], 1u);
            asm volatile("s_waitcnt vmcnt(0)" ::: "memory");
        } else {
            XB_SPIN(xb_ld(&bar[XB_XGEN(b.x)]) == gen, bar);
            __builtin_amdgcn_fence(__ATOMIC_ACQUIRE, "agent");
            asm volatile("s_waitcnt vmcnt(0)" ::: "memory");
        }
    }
    __syncthreads();
}

constexpr int NWAVES = 8;
constexpr int DM = 1024, NB = 8, TL = 2048, LC = 256, DFF = 4096;
constexpr int ML = NB * TL;
constexpr int MC = NB * LC;
constexpr int MT = ML + MC;
constexpr int NUP = 4352;
constexpr int NU = 4096;
constexpr int UQ = 0, UK = 512, UV = 1024, UO = 1536, UZ = 2048, UX = 2560, UB = 3072, UC = 3200, UAQ = 3328, UAK = 3840, UAV = 3968;
constexpr int INW = 4128;
constexpr int NY = 1536;
constexpr float EPS = 1e-6f;
constexpr int NPH = 17;

constexpr size_t MiB = 1u << 20;
constexpr size_t WS_CTL = 0, CTL_ZERO_BYTES = 1 * MiB;
constexpr size_t WS_MOD = 1 * MiB;
constexpr size_t WS_GATES = 2 * MiB;
constexpr size_t WS_CST = 5 * MiB, CST_BYTES = 16384;
constexpr size_t WS_W1 = 6 * MiB;
constexpr size_t WS_A = 14 * MiB;
constexpr size_t WS_B = 68 * MiB;
constexpr size_t WS_W0 = 212 * MiB;
constexpr size_t WS_CTXF = 221 * MiB;
constexpr size_t WS_P = 212 * MiB;
constexpr size_t WS_END = 256 * MiB;
static_assert(WS_GATES + (size_t)MT * 32 * 4 <= WS_CST && WS_CST + 2 * CST_BYTES <= WS_W1 && WS_W1 + 8 * MiB <= WS_A && WS_A + (size_t)MT * NY * 2 <= WS_B && WS_B + (size_t)MT * NU * 2 <= WS_W0 && WS_W0 + (size_t)NUP * DM * 2 <= WS_CTXF
              && WS_CTXF + (size_t)MC * DM * 4 <= WS_END && WS_P + (size_t)MT * 1024 * 2 <= WS_END, "d_ws map");
constexpr int CW_BAR = 4096;

constexpr int RING_OFF = 0, RING_BYTES = 131072;
constexpr int LDSCTL_OFF = RING_BYTES, MISC_OFF = LDSCTL_OFF + 320;
constexpr int LDS_BYTES = 147456;

__device__ __forceinline__ float bf2f(unsigned short h) { return __uint_as_float((unsigned)h << 16); }
__device__ __forceinline__ unsigned short f2bf_s(float f) { return (unsigned short)f2bf(f); }
__device__ __forceinline__ float wave_sum(float v) {
#pragma unroll
    for (int o = 1; o < 64; o <<= 1) v += __shfl_xor(v, o);
    return v;
}

struct Frame {
    LAS unsigned char* lds;
    volatile LAS unsigned* MISC;
    gu32* ctl;
    int tid, lane, wave, G;
    float* out;
    unsigned char* ws;
};
__device__ __forceinline__ const float* kin(int i) {
    const __attribute__((address_space(4))) char* ka = (const __attribute__((address_space(4))) char*)__builtin_amdgcn_kernarg_segment_ptr();
    asm volatile("" : "+s"(ka));
    return ((const float* const __attribute__((address_space(4)))*)ka)[i];
}
enum { I_X = 0, I_C, I_CTX, I_CCTX, I_WMOD, I_BMOD, I_N1G, I_WIN, I_MLBI, I_MLBF, I_MLNG, I_CONVW, I_CONVB, I_ALOG, I_DTB, I_SSDD, I_SSDNG, I_QNG, I_KNG, I_SINK, I_WOUT, I_N2G, I_WUP, I_WDOWN };

__device__ __forceinline__ void transpose_item(const float* W, int ldw, int src_col0, bf16* WT, int K, int dst_row0, int k0, LAS float* scr, int lane) {
#pragma unroll
    for (int i = 0; i < 32; ++i) { const int kk = 2 * i + (lane >> 5); scr[kk * 33 + (lane & 31)] = W[(size_t)(k0 + kk) * ldw + src_col0 + (lane & 31)]; }
    LDS_WAIT(); asm volatile("" ::: "memory");
    const int c = lane & 7;
#pragma unroll
    for (int j = 0; j < 4; ++j) { const int n = (lane >> 3) + 8 * j; const LAS float* s = scr + (8 * c) * 33 + n;
        v4u o; o.x = pk2(s[0 * 33], s[1 * 33]); o.y = pk2(s[2 * 33], s[3 * 33]); o.z = pk2(s[4 * 33], s[5 * 33]); o.w = pk2(s[6 * 33], s[7 * 33]);
        *(GAS v4u*)(WT + (size_t)(dst_row0 + n) * K + k0 + 8 * c) = o; }
    LDS_WAIT(); asm volatile("" ::: "memory");
}
__device__ __forceinline__ void convert_weight(Frame& F, const float* W, int K, int N, bf16* WT) {
    LAS float* scr = (LAS float*)(F.lds + RING_OFF + F.wave * 16384);
    const int gw = blockIdx.x * NWAVES + F.wave, NGW = F.G * NWAVES, nblk = N / 32, nitems = (K / 64) * nblk;
    for (int it = gw; it < nitems; it += NGW) { const int kb = it / nblk, nb = it % nblk; transpose_item(W, N, 32 * nb, WT, K, 32 * nb, 64 * kb, scr, F.lane); }
}
__device__ __forceinline__ void convert_win(Frame& F, const float* W, bf16* WT) {
    LAS float* scr = (LAS float*)(F.lds + RING_OFF + F.wave * 16384);
    const int gw = blockIdx.x * NWAVES + F.wave, NGW = F.G * NWAVES, nblk = NU / 32, nitems = (DM / 64) * nblk;
    for (int it = gw; it < nitems; it += NGW) { const int kb = it / nblk, nb = it % nblk, d0 = 32 * nb; int s0 = d0 + (d0 < 2048 ? 0 : 16);
        if (nb >= 104) {
            const int T = nb >> 3, half = (nb >> 2) & 1, wcol = nb & 3;
            s0 = (T < 15) ? 3360 + (4 * (T - 13) + wcol) * 64 + 32 * half : (wcol < 2 ? 3872 + wcol * 64 + 32 * half : 4000 + (wcol - 2) * 64 + 32 * half); }
        transpose_item(W, INW, s0, WT, DM, d0, 64 * kb, scr, F.lane); }
    const int gt = blockIdx.x * (NWAVES * 64) + F.tid, NGT = F.G * NWAVES * 64;
    for (int i0 = 0; i0 < 32 * 1024; i0 += NGT) { const int i = i0 + gt; if (i >= 32 * 1024) break; const int j = i & 31, k = i >> 5; WT[(size_t)(NU + j) * DM + k] = f2bf_s(W[(size_t)k * INW + (j < 16 ? 2048 + j : 3344 + (j - 16))]); }
    for (int i0 = 0; i0 < (NUP - NU - 32) * DM / 8; i0 += NGT) { const int i = i0 + gt; if (i < (NUP - NU - 32) * DM / 8) *(GAS v4u*)(WT + (size_t)(NU + 32) * DM + (size_t)i * 8) = (v4u){0u, 0u, 0u, 0u}; }
}

__device__ __forceinline__ void phase_mod(Frame& F) {
    LAS float* s = (LAS float*)(F.lds + RING_OFF);
    LAS float* red = (LAS float*)(F.lds + RING_OFF + 36864);
    float* MOD = (float*)(F.ws + WS_MOD);
    for (int i = F.tid; i < 9 * 1024; i += NWAVES * 64) { const int r = i >> 10, k = i & 1023; const float v = r < 8 ? kin(I_C)[r * 1024 + k] : kin(I_CCTX)[k]; s[i] = v / (1.f + expf(-v)); }
    __syncthreads();
    for (int u = blockIdx.x; u < 192; u += F.G) {
        const int L = u / 96, cg = u % 96, col = cg * 64 + F.lane, kq = F.wave;
        const float* w = kin(I_WMOD) + (size_t)L * 1024 * 6144 + col;
        float acc[9];
#pragma unroll
        for (int r = 0; r < 9; ++r) acc[r] = 0.f;
#pragma unroll 16
        for (int k = kq * 128; k < kq * 128 + 128; ++k) { const float wv = w[(size_t)k * 6144];
#pragma unroll
            for (int r = 0; r < 9; ++r) acc[r] += s[r * 1024 + k] * wv; }
#pragma unroll
        for (int r = 0; r < 9; ++r) red[(kq * 9 + r) * 64 + F.lane] = acc[r];
        __syncthreads();
        for (int i = F.tid; i < 576; i += NWAVES * 64) { const int r = i >> 6, c = i & 63; float a = kin(I_BMOD)[L * 6144 + cg * 64 + c];
#pragma unroll
            for (int q = 0; q < 8; ++q) a += red[(q * 9 + r) * 64 + c];
            MOD[(size_t)(L * 9 + r) * 6144 + cg * 64 + c] = a; }
        __syncthreads();
    }
    if (blockIdx.x == F.G - 1) for (int i = F.tid; i < 2 * (160 + 1024); i += NWAVES * 64) { const int L = i / 1184, k = i % 1184; float* CB = (float*)(F.ws + WS_CST + (size_t)L * CST_BYTES);
        if (k < 32) CB[k] = k < 8 ? kin(I_MLBI)[L * 8 + k] : (k < 16 ? kin(I_MLBF)[L * 8 + k - 8] : kin(I_DTB)[L * 16 + k - 16]);
        else if (k < 96) CB[k] = kin(I_QNG)[L * 64 + k - 32];
        else if (k < 160) CB[k] = kin(I_KNG)[L * 64 + k - 96];
        else { const int q = k - 160, pos = q >> 4, f = q & 15; const float ang = (float)pos * exp2f(-(float)f * (13.287712379549449f / 16.0f)); CB[1024 + 2 * q] = __cosf(ang); CB[1024 + 2 * q + 1] = __sinf(ang); } }

}

__device__ __forceinline__ void norm_rows(Frame& F, int L, int nrows, const float* xl, const float* xc, const float* g, int chunk0, bf16* XN) {
    const float* MODL = (const float*)(F.ws + WS_MOD) + (size_t)L * 9 * 6144;
    const int gw = blockIdx.x * NWAVES + F.wave, NGW = F.G * NWAVES, lane = F.lane;
    f32x4 gg[4];
#pragma unroll
    for (int j = 0; j < 4; ++j) gg[j] = *(const f32x4*)(g + 256 * j + 4 * lane);
    for (int r0 = gw; r0 < nrows; r0 += 3 * NGW) {
        f32x4 v[3][4], sh[3][4], sc[3][4]; float ss[3]; int rr[3];
#pragma unroll
        for (int i = 0; i < 3; ++i) { const int r = r0 + i * NGW; rr[i] = r < nrows ? r : r0;
            const bool lat = rr[i] < ML;
            const float* xr = lat ? xl + (size_t)rr[i] * DM : xc + (size_t)(rr[i] - ML) * DM;
#pragma unroll
            for (int j = 0; j < 4; ++j) v[i][j] = *(const f32x4*)(xr + 256 * j + 4 * lane); }
#pragma unroll
        for (int i = 0; i < 3; ++i) { const bool lat = rr[i] < ML; const float* md = MODL + (size_t)(lat ? (rr[i] >> 11) : 8) * 6144 + chunk0 * 1024;
#pragma unroll
            for (int j = 0; j < 4; ++j) { sh[i][j] = *(const f32x4*)(md + 256 * j + 4 * lane); sc[i][j] = *(const f32x4*)(md + 1024 + 256 * j + 4 * lane); } }
#pragma unroll
        for (int i = 0; i < 3; ++i) { float a = 0.f;
#pragma unroll
            for (int j = 0; j < 4; ++j) a += (v[i][j].x * v[i][j].x + v[i][j].y * v[i][j].y) + (v[i][j].z * v[i][j].z + v[i][j].w * v[i][j].w);
            ss[i] = a; }
#pragma unroll
        for (int o = 1; o < 64; o <<= 1) { const float t0 = __shfl_xor(ss[0], o), t1 = __shfl_xor(ss[1], o), t2 = __shfl_xor(ss[2], o); ss[0] += t0; ss[1] += t1; ss[2] += t2; }
#pragma unroll
        for (int i = 0; i < 3; ++i) { if (r0 + i * NGW < nrows) { const float rstd = 1.0f / sqrtf(ss[i] * (1.f / DM) + EPS);
#pragma unroll
            for (int j = 0; j < 4; ++j) { const f32x4 y = (v[i][j] * rstd) * gg[j] * (sc[i][j] + 1.0f) + sh[i][j];
                unsigned long long o = (unsigned long long)pk2(y.x, y.y) | ((unsigned long long)pk2(y.z, y.w) << 32);
                *(unsigned long long*)(XN + (size_t)rr[i] * DM + 256 * j + 4 * lane) = o; } } }
    }
}

__device__ __forceinline__ void phase_qkn(Frame& F, int L) {
    bf16* U = (bf16*)(F.ws + WS_B);
    const int gw = blockIdx.x * NWAVES + F.wave, NGW = F.G * NWAVES, lane = F.lane;
    const int gh = lane >> 5, p = lane & 31, fi = p & 15, d1 = (p < 16) ? p : 32 + (p - 16), d2 = d1 + 16;
    const float gq1 = kin(I_QNG)[L * 64 + d1], gq2 = kin(I_QNG)[L * 64 + d2], gk1 = kin(I_KNG)[L * 64 + d1], gk2 = kin(I_KNG)[L * 64 + d2];
    const float inv = exp2f(-(float)fi * (13.287712379549449f / 16.0f));
    const int nrows = (L == 0) ? MT : MT;
    for (int r = gw; r < nrows; r += NGW) {
        float cs = 1.f, sn = 0.f;
        if (r < ML) { const int t = r & 2047; const float pos = (float)((p < 16) ? (t >> 6) : (t & 63)); const float ang = pos * inv; cs = __cosf(ang); sn = __sinf(ang); }
#pragma unroll
        for (int j = 0; j < 5; ++j) {
            const int c = 2 * j + gh;
            bf16* kr = U + (size_t)r * NU + UAQ + c * 64;
            float x1 = bf2f(kr[d1]), x2 = bf2f(kr[d2]);
            float ss = x1 * x1 + x2 * x2;
#pragma unroll
            for (int o = 1; o < 32; o <<= 1) ss += __shfl_xor(ss, o);
            const float rs = 1.0f / sqrtf(ss * (1.f / 64.f) + EPS);
            const bool isq = c < 8; const float sc = isq ? 0.125f * 1.4426950408889634f : 1.0f;
            x1 = x1 * rs * (isq ? gq1 : gk1) * sc; x2 = x2 * rs * (isq ? gq2 : gk2) * sc;
            kr[d1] = f2bf_s(x1 * cs - x2 * sn); kr[d2] = f2bf_s(x2 * cs + x1 * sn);
        }
    }
}

__device__ __forceinline__ int scan_row(int s, int d, int b) {
    if (s < LC) { const int t = d ? (LC - 1 - s) : s; return ML + b * LC + t; }
    int t = s - LC; if (d) t = TL - 1 - t; return b * TL + t;
}

constexpr size_t WS_PREP = 248 * MiB;
constexpr size_t PO_B = 0, PO_A = 64 * 2304 * 4, PO_M = 2 * PO_A, PO_C = 3 * PO_A, PO_D = PO_C + 128 * 2304 * 4, PO_END = PO_D + 128 * 2304 * 4;
static_assert(WS_PREP + PO_END <= WS_END && WS_P + (size_t)MT * 1024 * 2 <= WS_PREP, "prep map");
__device__ __forceinline__ void prep_ml_chunk(Frame& F, int sq, int c) {
    const float* GATES = (const float*)(F.ws + WS_GATES); unsigned char* pp = F.ws + WS_PREP; const int lane = F.lane, d = sq >> 5, b = (sq >> 2) & 7, h = sq & 3;
    const int r = scan_row(c * 64 + lane, d, b); const float li = GATES[(size_t)r * 32 + d * 4 + h], lf = GATES[(size_t)r * 32 + 8 + d * 4 + h];
    float bc = lf;
#pragma unroll
    for (int o = 1; o < 64; o <<= 1) { const float t_ = __shfl_up(bc, o); if (lane >= o) bc += t_; }
    const float a = li - bc; float am = a;
#pragma unroll
    for (int o = 1; o < 64; o <<= 1) { const float t_ = __shfl_up(am, o); if (lane >= o) am = fmaxf(am, t_); }
    const size_t o_ = ((size_t)sq * 2304 + c * 64 + lane) * 4;
    *(float*)(pp + PO_B + o_) = bc; *(float*)(pp + PO_A + o_) = a; *(float*)(pp + PO_M + o_) = am;
}
__device__ __forceinline__ void prep_ssd_chunk(Frame& F, int L, int sq, int c) {
    const float* GATES = (const float*)(F.ws + WS_GATES); unsigned char* pp = F.ws + WS_PREP; const int lane = F.lane, d = sq >> 6, b = (sq >> 3) & 7, hd = sq & 7;
    const int r = scan_row(c * 64 + lane, d, b); const float dt = GATES[(size_t)r * 32 + 16 + d * 8 + hd];
    float ac = dt * -expf(kin(I_ALOG)[L * 16 + d * 8 + hd]);
#pragma unroll
    for (int o = 1; o < 64; o <<= 1) { const float t_ = __shfl_up(ac, o); if (lane >= o) ac += t_; }
    const size_t o_ = ((size_t)sq * 2304 + c * 64 + lane) * 4;
    *(float*)(pp + PO_C + o_) = ac; *(float*)(pp + PO_D + o_) = dt;
}

constexpr int MP_Q = 272, MP_S = 144;
constexpr int MO_QS = 0, MO_KS = 17408, MO_KW = 34816, MO_VT = 53248, MO_SP = 71680, MO_CT = 80896, MO_SC = 115712;
static_assert(MO_SC + 4096 <= RING_BYTES, "mLSTM LDS map");
__device__ __forceinline__ void mlstm_block_unit(Frame& F, int L, int d, int unit) {
    const int h = unit & 3, b = unit >> 2, tid = F.tid, lane = F.lane, w = F.wave, fr = lane & 15, fq = lane >> 4, sq = d * 32 + unit;
    const bf16* U = (const bf16*)(F.ws + WS_B); bf16* Y = (bf16*)(F.ws + WS_A);
    const float* PB = (const float*)(F.ws + WS_PREP + PO_B) + (size_t)sq * 2304; const float* PA = (const float*)(F.ws + WS_PREP + PO_A) + (size_t)sq * 2304; const float* PM = (const float*)(F.ws + WS_PREP + PO_M) + (size_t)sq * 2304;
    LAS unsigned char* lds = F.lds + RING_OFF;
    LAS float* sc_a = (LAS float*)(lds + MO_SC); LAS float* sc_mx = sc_a + 64; LAS float* sc_g = sc_a + 128; LAS float* sc_emt = sc_a + 192; LAS float* sc_den = sc_a + 256; LAS float* sc_qn = sc_a + 320;
    LAS float* sc_n = sc_a + 384; LAS float* sc_min = sc_a + 512; LAS float* sc_am63 = sc_a + 576; LAS float* sc_b63 = sc_a + 640;
    constexpr float KSC = 0.08838834764831845f;
    constexpr int NCH = (LC + TL) / 64;
    typedef unsigned u32x2 __attribute__((ext_vector_type(2)));
#ifndef SCAN_REPS
#define SCAN_REPS 1
#endif
#ifndef SSD_REPS
#define SSD_REPS 1
#endif
    _Pragma("unroll 1") for (int rep_ = 0; rep_ < SCAN_REPS; ++rep_) {
    for (int c = w; c < NCH; c += NWAVES) prep_ml_chunk(F, sq, c);
    asm volatile("s_waitcnt vmcnt(0)" ::: "memory");
    __syncthreads();
    for (int i = tid; i < 128 * MP_Q / 16; i += NWAVES * 64) *(LAS v4u*)(lds + MO_CT + i * 16) = (v4u){0u, 0u, 0u, 0u};
    if (tid < 128) sc_n[tid] = 0.f;
    if (tid < NCH) { sc_b63[tid] = PB[tid * 64 + 63]; sc_am63[tid] = PM[tid * 64 + 63]; }
    __syncthreads();
    if (tid == 0) { float m = 0.f; for (int c = 0; c < NCH; ++c) { sc_min[c] = m; m = sc_b63[c] + fmaxf(m, sc_am63[c]); } }
    f32x4 C[8];
#pragma unroll
    for (int j = 0; j < 8; ++j) C[j] = (f32x4){0.f, 0.f, 0.f, 0.f};
    const int tq = tid >> 5, kc = tid & 31;
    u32x2 pq[4], pk[4], pv[4]; f32x4 pa4; float pb1 = 0.f, pa1 = 0.f, pm1 = 0.f;
#define MB_LOAD(c_) do { _Pragma("unroll") for (int j_ = 0; j_ < 4; ++j_) { const int r_ = scan_row((c_) * 64 + 4 * tq + j_, d, b); const bf16* ur_ = U + (size_t)r_ * NU + h * 128 + 4 * kc; \
            pq[j_] = *(const u32x2*)(ur_ + UQ); pk[j_] = *(const u32x2*)(ur_ + UK); pv[j_] = *(const u32x2*)(ur_ + UV); } \
        pa4 = *(const f32x4*)(PA + (c_) * 64 + 4 * tq); \
        if (tid < 64) { pb1 = PB[(c_) * 64 + tid]; pa1 = PA[(c_) * 64 + tid]; pm1 = PM[(c_) * 64 + tid]; } } while (0)
    MB_LOAD(0);
    __syncthreads();

    for (int c = 0; c < NCH; ++c) {
        const float m_in = sc_min[c], mx63 = fmaxf(m_in, sc_am63[c]), decay = __expf(m_in - mx63);
        if (tid < 64) { const float mx = fmaxf(m_in, pm1); sc_a[tid] = pa1; sc_mx[tid] = mx; sc_g[tid] = __expf(m_in - mx); sc_emt[tid] = __expf(-(pb1 + mx)); sc_den[tid] = 0.f; }
        {
            const float w0 = __expf(pa4[0] - mx63) * KSC, w1 = __expf(pa4[1] - mx63) * KSC, w2 = __expf(pa4[2] - mx63) * KSC, w3 = __expf(pa4[3] - mx63) * KSC;
#pragma unroll
            for (int j = 0; j < 4; ++j) { *(LAS u32x2*)(lds + MO_QS + (4 * tq + j) * MP_Q + kc * 8) = pq[j]; *(LAS u32x2*)(lds + MO_KS + (4 * tq + j) * MP_Q + kc * 8) = pk[j]; }
#pragma unroll
            for (int e = 0; e < 4; ++e) {
                const unsigned k0 = (e < 2) ? pk[0].x : pk[0].y, k1 = (e < 2) ? pk[1].x : pk[1].y, k2 = (e < 2) ? pk[2].x : pk[2].y, k3 = (e < 2) ? pk[3].x : pk[3].y;
                const unsigned v0 = (e < 2) ? pv[0].x : pv[0].y, v1 = (e < 2) ? pv[1].x : pv[1].y, v2 = (e < 2) ? pv[2].x : pv[2].y, v3 = (e < 2) ? pv[3].x : pv[3].y;
                const float f0 = (e & 1) ? __uint_as_float(k0 & 0xffff0000u) : __uint_as_float(k0 << 16), f1 = (e & 1) ? __uint_as_float(k1 & 0xffff0000u) : __uint_as_float(k1 << 16);
                const float f2 = (e & 1) ? __uint_as_float(k2 & 0xffff0000u) : __uint_as_float(k2 << 16), f3 = (e & 1) ? __uint_as_float(k3 & 0xffff0000u) : __uint_as_float(k3 << 16);
                u32x2 ow; ow.x = pk2(f0 * w0, f1 * w1); ow.y = pk2(f2 * w2, f3 * w3);
                *(LAS u32x2*)(lds + MO_KW + (4 * kc + e) * MP_S + tq * 8) = ow;
                const unsigned h0 = (e & 1) ? (v0 >> 16) : (v0 & 0xffffu), h1 = (e & 1) ? (v1 >> 16) : (v1 & 0xffffu), h2 = (e & 1) ? (v2 >> 16) : (v2 & 0xffffu), h3 = (e & 1) ? (v3 >> 16) : (v3 & 0xffffu);
                u32x2 ov; ov.x = h0 | (h1 << 16); ov.y = h2 | (h3 << 16);
                *(LAS u32x2*)(lds + MO_VT + (4 * kc + e) * MP_S + tq * 8) = ov; }
        }
        if (c > 0) {
#pragma unroll
            for (int j = 0; j < 8; ++j) { u32x2 o; o.x = pk2(C[j][0], C[j][1]); o.y = pk2(C[j][2], C[j][3]);
                *(LAS u32x2*)(lds + MO_CT + (16 * j + fr) * MP_Q + (16 * w + 4 * fq) * 2) = o; }
        }
        if (c + 1 < NCH) MB_LOAD(c + 1);
        __syncthreads();
        {
            const int t = tid >> 3, part = tid & 7;
            const v4u q0 = *(const LAS v4u*)(lds + MO_QS + t * MP_Q + part * 32), q1 = *(const LAS v4u*)(lds + MO_QS + t * MP_Q + part * 32 + 16);
            const unsigned qq[8] = {q0.x, q0.y, q0.z, q0.w, q1.x, q1.y, q1.z, q1.w};
            float qn = 0.f;
#pragma unroll
            for (int e = 0; e < 8; ++e) qn += __uint_as_float(qq[e] << 16) * sc_n[16 * part + 2 * e] + __uint_as_float(qq[e] & 0xffff0000u) * sc_n[16 * part + 2 * e + 1];
            qn += __shfl_xor(qn, 1); qn += __shfl_xor(qn, 2); qn += __shfl_xor(qn, 4);
            if (part == 0) sc_qn[t] = qn;
        }
        {
            const int ms = w >> 1, nt0 = 2 * (w & 1);
            f32x4 acc[2] = {(f32x4){0.f, 0.f, 0.f, 0.f}, (f32x4){0.f, 0.f, 0.f, 0.f}};
#pragma unroll
            for (int kk2 = 0; kk2 < 4; ++kk2) {
                const bf16x8 af = *(const LAS bf16x8*)(lds + MO_KS + (16 * ms + fr) * MP_Q + (32 * kk2 + 8 * fq) * 2);
#pragma unroll
                for (int j = 0; j < 2; ++j) { const bf16x8 bfv = *(const LAS bf16x8*)(lds + MO_QS + (16 * (nt0 + j) + fr) * MP_Q + (32 * kk2 + 8 * fq) * 2);
                    acc[j] = __builtin_amdgcn_mfma_f32_16x16x32_bf16(af, bfv, acc[j], 0, 0, 0); }
            }
            const int s0 = 16 * ms + 4 * fq;
            const f32x4 av = *(const LAS f32x4*)(sc_a + s0);
#pragma unroll
            for (int j = 0; j < 2; ++j) { const int t = 16 * (nt0 + j) + fr; const float mxt = sc_mx[t];
                const float v0 = (s0 + 0 <= t) ? acc[j][0] * KSC * __expf(av[0] - mxt) : 0.f, v1 = (s0 + 1 <= t) ? acc[j][1] * KSC * __expf(av[1] - mxt) : 0.f;
                const float v2 = (s0 + 2 <= t) ? acc[j][2] * KSC * __expf(av[2] - mxt) : 0.f, v3 = (s0 + 3 <= t) ? acc[j][3] * KSC * __expf(av[3] - mxt) : 0.f;
                u32x2 o; o.x = pk2(v0, v1); o.y = pk2(v2, v3);
                *(LAS u32x2*)(lds + MO_SP + t * MP_S + s0 * 2) = o;
                float rs = (v0 + v1) + (v2 + v3); rs += __shfl_xor(rs, 16); rs += __shfl_xor(rs, 32);
                if (fq == 0 && 16 * ms <= t) atomicAdd((float*)(sc_den + t), rs); }
        }
        __syncthreads();
        if (c >= LC / 64 || L == 0) {
            const int mv = w;
            f32x4 a1[4], a2[4];
#pragma unroll
            for (int j = 0; j < 4; ++j) { a1[j] = (f32x4){0.f, 0.f, 0.f, 0.f}; a2[j] = (f32x4){0.f, 0.f, 0.f, 0.f}; }
#pragma unroll
            for (int kk2 = 0; kk2 < 2; ++kk2) {
                const bf16x8 af = *(const LAS bf16x8*)(lds + MO_VT + (16 * mv + fr) * MP_S + (32 * kk2 + 8 * fq) * 2);
#pragma unroll
                for (int j = 0; j < 4; ++j) { const bf16x8 bfv = *(const LAS bf16x8*)(lds + MO_SP + (16 * j + fr) * MP_S + (32 * kk2 + 8 * fq) * 2);
                    a1[j] = __builtin_amdgcn_mfma_f32_16x16x32_bf16(af, bfv, a1[j], 0, 0, 0); }
            }
#pragma unroll
            for (int kk2 = 0; kk2 < 4; ++kk2) {
                const bf16x8 af = *(const LAS bf16x8*)(lds + MO_CT + (16 * mv + fr) * MP_Q + (32 * kk2 + 8 * fq) * 2);
#pragma unroll
                for (int j = 0; j < 4; ++j) { const bf16x8 bfv = *(const LAS bf16x8*)(lds + MO_QS + (16 * j + fr) * MP_Q + (32 * kk2 + 8 * fq) * 2);
                    a2[j] = __builtin_amdgcn_mfma_f32_16x16x32_bf16(af, bfv, a2[j], 0, 0, 0); }
            }
#pragma unroll
            for (int j = 0; j < 4; ++j) { const int t = 16 * j + fr; const float g = sc_g[t];
                const float den = sc_den[t] + g * sc_qn[t], rd = 1.0f / fmaxf(fabsf(den), sc_emt[t]);
                const int row = scan_row(c * 64 + t, d, b);
                bf16* yp = (d == 0 ? Y + (size_t)row * NY : (bf16*)(F.ws + WS_P) + (size_t)row * 1024) + h * 128 + 16 * mv + 4 * fq;
                const float h0 = (a1[j][0] + g * a2[j][0]) * rd, h1 = (a1[j][1] + g * a2[j][1]) * rd, h2 = (a1[j][2] + g * a2[j][2]) * rd, h3 = (a1[j][3] + g * a2[j][3]) * rd;
                u32x2 o; o.x = pk2(h0, h1); o.y = pk2(h2, h3); *(u32x2*)yp = o; }
        }
        {
            const int mk = w;
#pragma unroll
            for (int j = 0; j < 8; ++j) C[j] = C[j] * decay;
#pragma unroll
            for (int kk2 = 0; kk2 < 2; ++kk2) {
                const bf16x8 af = *(const LAS bf16x8*)(lds + MO_KW + (16 * mk + fr) * MP_S + (32 * kk2 + 8 * fq) * 2);
#pragma unroll
                for (int j = 0; j < 8; ++j) { const bf16x8 bfv = *(const LAS bf16x8*)(lds + MO_VT + (16 * j + fr) * MP_S + (32 * kk2 + 8 * fq) * 2);
                    C[j] = __builtin_amdgcn_mfma_f32_16x16x32_bf16(af, bfv, C[j], 0, 0, 0); }
            }
            if (tid < 128) { float sm = 0.f;
#pragma unroll
                for (int e = 0; e < 8; ++e) { const v4u x = *(const LAS v4u*)(lds + MO_KW + tid * MP_S + e * 16);
                    sm += (__uint_as_float(x.x << 16) + __uint_as_float(x.x & 0xffff0000u)) + (__uint_as_float(x.y << 16) + __uint_as_float(x.y & 0xffff0000u))
                        + (__uint_as_float(x.z << 16) + __uint_as_float(x.z & 0xffff0000u)) + (__uint_as_float(x.w << 16) + __uint_as_float(x.w & 0xffff0000u)); }
                sc_n[tid] = decay * sc_n[tid] + sm; }
        }
        __syncthreads();
    }
    }

#undef MB_LOAD
}

constexpr int SP_P = 144;
constexpr int SO_BS = 0, SO_CS = 9216, SO_BT = 18432, SO_HD = 27648, SO_HSTRIDE = 36864, SO_SP = 0, SO_XT = 9216, SO_XW = 18432, SO_HB = 27648, SO_SC = 101376, SO_CW = 103488;
static_assert(SO_CW + 4096 <= RING_BYTES, "SSD LDS map");
__device__ __forceinline__ void ssd_block_unit(Frame& F, int L, int d, int unit) {
    const int hp = unit & 3, b = unit >> 2, g = hp >> 1, tid = F.tid, lane = F.lane, w = F.wave, fr = lane & 15, fq = lane >> 4;
    const bf16* U = (const bf16*)(F.ws + WS_B); bf16* Y = (bf16*)(F.ws + WS_A);
    LAS unsigned char* lds = F.lds + RING_OFF;
    LAS float* scb = (LAS float*)(lds + SO_SC);
    LAS float* cwt = (LAS float*)(lds + SO_CW);
    constexpr int NCH = (LC + TL) / 64;
    typedef unsigned u32x2 __attribute__((ext_vector_type(2)));
    for (int rep_ = 0; rep_ < SSD_REPS; ++rep_) {
    for (int t2 = w; t2 < 2 * NCH; t2 += NWAVES) prep_ssd_chunk(F, L, d * 64 + b * 8 + 2 * hp + (t2 >= NCH ? 1 : 0), t2 >= NCH ? t2 - NCH : t2);
    asm volatile("s_waitcnt vmcnt(0)" ::: "memory");
    __syncthreads();
    if (tid < 256) { const int ch = tid < 128 ? (2 * hp) * 64 + tid : (tid < 192 ? 512 + g * 64 + (tid - 128) : 640 + g * 64 + (tid - 192));
        const float* cw = kin(I_CONVW) + (size_t)L * 3 * 768;
        cwt[tid * 4 + 0] = cw[ch]; cwt[tid * 4 + 1] = cw[768 + ch]; cwt[tid * 4 + 2] = cw[1536 + ch]; cwt[tid * 4 + 3] = kin(I_CONVB)[L * 768 + ch]; }
    for (int i = tid; i < 2 * 9216 / 16; i += NWAVES * 64) { const int hl2 = i / 576, o = i % 576; *(LAS v4u*)(lds + SO_HD + hl2 * SO_HSTRIDE + SO_HB + o * 16) = (v4u){0u, 0u, 0u, 0u}; }
    const int hl = w >> 2, wq = w & 3, head = 2 * hp + hl;
    const float dsk = kin(I_SSDD)[L * 8 + head];
    f32x4 Hs[4];
#pragma unroll
    for (int j = 0; j < 4; ++j) Hs[j] = (f32x4){0.f, 0.f, 0.f, 0.f};
    const int tokq = tid & 15, c8 = tid >> 4;
    const int ucol = c8 < 16 ? UX + (2 * hp) * 64 + 8 * c8 : (c8 < 24 ? UB + g * 64 + 8 * (c8 - 16) : UC + g * 64 + 8 * (c8 - 24));
    const int i0 = d ? 60 - 4 * tokq : 4 * tokq;
    const int hxs = (c8 >> 3) & 1;
    const float* PCs = (const float*)(F.ws + WS_PREP + PO_C) + (size_t)(d * 64 + b * 8 + 2 * hp + hxs) * 2304;
    const float* PDs = (const float*)(F.ws + WS_PREP + PO_D) + (size_t)(d * 64 + b * 8 + 2 * hp + hxs) * 2304;
    const int sh = (tid >> 6) & 1, st = tid & 63;
    const float* PC1 = (const float*)(F.ws + WS_PREP + PO_C) + (size_t)(d * 64 + b * 8 + 2 * hp + sh) * 2304;
    const float* PD1 = (const float*)(F.ws + WS_PREP + PO_D) + (size_t)(d * 64 + b * 8 + 2 * hp + sh) * 2304;
    const float* PCc = (const float*)(F.ws + WS_PREP + PO_C) + (size_t)(d * 64 + b * 8 + head) * 2304;
    v4u raw[6]; f32x4 pac = (f32x4){0.f, 0.f, 0.f, 0.f}, pdt = pac; float paend = 0.f, pac1 = 0.f, pdt1 = 0.f, pend_c = 0.f;
#define SB_LOAD(c_) do { const int s0_ = (c_) * 64; const bool cx_ = s0_ < LC; const int seglen_ = cx_ ? LC : TL; const int tf_ = cx_ ? s0_ : s0_ - LC; const int tlo_ = d ? seglen_ - 64 - tf_ : tf_; \
        const size_t rb0_ = cx_ ? (size_t)(ML + b * LC) : (size_t)(b * TL); \
        _Pragma("unroll") for (int r_ = 0; r_ < 6; ++r_) { const int t_ = tlo_ + 4 * tokq - 1 + r_; const bool ok_ = t_ >= 0 && t_ < seglen_; \
            raw[r_] = ok_ ? *(const v4u*)(U + (rb0_ + t_) * NU + ucol) : (v4u){0u, 0u, 0u, 0u}; } \
        if (c8 < 16) { pac = *(const f32x4*)(PCs + s0_ + i0); pdt = *(const f32x4*)(PDs + s0_ + i0); paend = PCs[s0_ + 63]; } \
        if (tid < 128) { pac1 = PC1[s0_ + st]; pdt1 = PD1[s0_ + st]; } \
        pend_c = PCc[s0_ + 63]; } while (0)
    SB_LOAD(0);
    __syncthreads();
    for (int c = 0; c < NCH; ++c) {
        const bool need_out = (c >= LC / 64) || (L == 0);
        const float dA = __expf(pend_c);
        if (tid < 128) { LAS float* sb = scb + sh * 256; sb[st] = pac1; sb[64 + st] = pdt1; sb[192 + st] = __expf(pac1); }
        {
            float val[4][8];
#pragma unroll
            for (int e = 0; e < 8; ++e) { const f32x4 cw = *(const LAS f32x4*)(cwt + (8 * c8 + e) * 4);
                float rv[6];
#pragma unroll
                for (int r_ = 0; r_ < 6; ++r_) { const unsigned x = (e < 2) ? raw[r_].x : (e < 4 ? raw[r_].y : (e < 6 ? raw[r_].z : raw[r_].w)); rv[r_] = (e & 1) ? __uint_as_float(x & 0xffff0000u) : __uint_as_float(x << 16); }
#pragma unroll
                for (int jj = 0; jj < 4; ++jj) { float v = cw[0] * rv[jj] + cw[1] * rv[jj + 1] + cw[2] * rv[jj + 2] + cw[3]; val[jj][e] = v * __builtin_amdgcn_rcpf(1.f + __expf(-v)); } }
            if (c8 < 16) {
                const int p0 = 8 * (c8 & 7);
                LAS unsigned char* hb = lds + SO_HD + hxs * SO_HSTRIDE;
                const float w0 = __expf(paend - pac[0]) * pdt[0], w1 = __expf(paend - pac[1]) * pdt[1], w2 = __expf(paend - pac[2]) * pdt[2], w3 = __expf(paend - pac[3]) * pdt[3];
#pragma unroll
                for (int e = 0; e < 8; ++e) { const float x0 = val[d ? 3 : 0][e], x1 = val[d ? 2 : 1][e], x2 = val[d ? 1 : 2][e], x3 = val[d ? 0 : 3][e];
                    u32x2 o; o.x = pk2(x0, x1); o.y = pk2(x2, x3); *(LAS u32x2*)(hb + SO_XT + (p0 + e) * SP_P + i0 * 2) = o;
                    u32x2 q; q.x = pk2(x0 * w0, x1 * w1); q.y = pk2(x2 * w2, x3 * w3); *(LAS u32x2*)(hb + SO_XW + (p0 + e) * SP_P + i0 * 2) = q; }
            } else if (c8 < 24) {
                const int n0 = 8 * (c8 - 16);
#pragma unroll
                for (int q = 0; q < 4; ++q) { const int jj = d ? 3 - q : q; v4u o; o.x = pk2(val[jj][0], val[jj][1]); o.y = pk2(val[jj][2], val[jj][3]); o.z = pk2(val[jj][4], val[jj][5]); o.w = pk2(val[jj][6], val[jj][7]);
                    *(LAS v4u*)(lds + SO_BS + (i0 + q) * SP_P + n0 * 2) = o; }
#pragma unroll
                for (int e = 0; e < 8; ++e) { u32x2 o; o.x = pk2(val[d ? 3 : 0][e], val[d ? 2 : 1][e]); o.y = pk2(val[d ? 1 : 2][e], val[d ? 0 : 3][e]);
                    *(LAS u32x2*)(lds + SO_BT + (n0 + e) * SP_P + i0 * 2) = o; }
            } else {
                const int n0 = 8 * (c8 - 24);
#pragma unroll
                for (int q = 0; q < 4; ++q) { const int jj = d ? 3 - q : q; v4u o; o.x = pk2(val[jj][0], val[jj][1]); o.y = pk2(val[jj][2], val[jj][3]); o.z = pk2(val[jj][4], val[jj][5]); o.w = pk2(val[jj][6], val[jj][7]);
                    *(LAS v4u*)(lds + SO_CS + (i0 + q) * SP_P + n0 * 2) = o; }
            }
        }
        if (c > 0) { LAS unsigned char* hb = lds + SO_HD + hl * SO_HSTRIDE;
#pragma unroll
            for (int j = 0; j < 4; ++j) { u32x2 o; o.x = pk2(Hs[j][0], Hs[j][1]); o.y = pk2(Hs[j][2], Hs[j][3]);
                *(LAS u32x2*)(hb + SO_HB + (16 * j + fr) * SP_P + (16 * wq + 4 * fq) * 2) = o; } }
        if (c + 1 < NCH) SB_LOAD(c + 1);
        __syncthreads();
        if (need_out) {
            const int ms = w >> 1, nt0 = 2 * (w & 1);
            f32x4 acc[2] = {(f32x4){0.f, 0.f, 0.f, 0.f}, (f32x4){0.f, 0.f, 0.f, 0.f}};
#pragma unroll
            for (int kk2 = 0; kk2 < 2; ++kk2) {
                const bf16x8 af = *(const LAS bf16x8*)(lds + SO_BS + (16 * ms + fr) * SP_P + (32 * kk2 + 8 * fq) * 2);
#pragma unroll
                for (int j = 0; j < 2; ++j) { const bf16x8 bfv = *(const LAS bf16x8*)(lds + SO_CS + (16 * (nt0 + j) + fr) * SP_P + (32 * kk2 + 8 * fq) * 2);
                    acc[j] = __builtin_amdgcn_mfma_f32_16x16x32_bf16(af, bfv, acc[j], 0, 0, 0); }
            }
            const int s0 = 16 * ms + 4 * fq;
#pragma unroll
            for (int hx = 0; hx < 2; ++hx) { const LAS float* sb = scb + hx * 256;
                const f32x4 as = *(const LAS f32x4*)(sb + s0), ds = *(const LAS f32x4*)(sb + 64 + s0);
#pragma unroll
                for (int j = 0; j < 2; ++j) { const int t = 16 * (nt0 + j) + fr; const float at = sb[t];
                    const float v0 = (s0 + 0 <= t) ? acc[j][0] * __expf(at - as[0]) * ds[0] : 0.f, v1 = (s0 + 1 <= t) ? acc[j][1] * __expf(at - as[1]) * ds[1] : 0.f;
                    const float v2 = (s0 + 2 <= t) ? acc[j][2] * __expf(at - as[2]) * ds[2] : 0.f, v3 = (s0 + 3 <= t) ? acc[j][3] * __expf(at - as[3]) * ds[3] : 0.f;
                    u32x2 o; o.x = pk2(v0, v1); o.y = pk2(v2, v3);
                    *(LAS u32x2*)(lds + SO_HD + hx * SO_HSTRIDE + SO_SP + t * SP_P + s0 * 2) = o; } }
        }
        __syncthreads();
        {
            LAS unsigned char* hb = lds + SO_HD + hl * SO_HSTRIDE; const LAS float* sb = scb + hl * 256;
            if (need_out) {
                f32x4 a1[4], a2[4];
#pragma unroll
                for (int j = 0; j < 4; ++j) { a1[j] = (f32x4){0.f, 0.f, 0.f, 0.f}; a2[j] = (f32x4){0.f, 0.f, 0.f, 0.f}; }
#pragma unroll
                for (int kk2 = 0; kk2 < 2; ++kk2) {
                    const bf16x8 ax = *(const LAS bf16x8*)(hb + SO_XT + (16 * wq + fr) * SP_P + (32 * kk2 + 8 * fq) * 2);
                    const bf16x8 ah = *(const LAS bf16x8*)(hb + SO_HB + (16 * wq + fr) * SP_P + (32 * kk2 + 8 * fq) * 2);
#pragma unroll
                    for (int j = 0; j < 4; ++j) { const bf16x8 bs = *(const LAS bf16x8*)(hb + SO_SP + (16 * j + fr) * SP_P + (32 * kk2 + 8 * fq) * 2);
                        const bf16x8 bc = *(const LAS bf16x8*)(lds + SO_CS + (16 * j + fr) * SP_P + (32 * kk2 + 8 * fq) * 2);
                        a1[j] = __builtin_amdgcn_mfma_f32_16x16x32_bf16(ax, bs, a1[j], 0, 0, 0);
                        a2[j] = __builtin_amdgcn_mfma_f32_16x16x32_bf16(ah, bc, a2[j], 0, 0, 0); }
                }
#pragma unroll
                for (int j = 0; j < 4; ++j) { const int t = 16 * j + fr; const float et = sb[192 + t];
                    const int row = scan_row(c * 64 + t, d, b); const int p0 = 16 * wq + 4 * fq;
                    bf16* yp = (d == 0 ? Y + (size_t)row * NY : (bf16*)(F.ws + WS_P) + (size_t)row * 1024) + 512 + head * 64 + p0;
                    float y0 = a1[j][0] + et * a2[j][0], y1 = a1[j][1] + et * a2[j][1], y2 = a1[j][2] + et * a2[j][2], y3 = a1[j][3] + et * a2[j][3];
                    if (d == 1) { const LAS unsigned short* xp = (const LAS unsigned short*)(hb + SO_XT + p0 * SP_P + t * 2);
                        y0 += dsk * bf2f(xp[0]); y1 += dsk * bf2f(xp[SP_P / 2]); y2 += dsk * bf2f(xp[2 * (SP_P / 2)]); y3 += dsk * bf2f(xp[3 * (SP_P / 2)]); }
                    u32x2 o; o.x = pk2(y0, y1); o.y = pk2(y2, y3); *(u32x2*)yp = o; }
            }
#pragma unroll
            for (int j = 0; j < 4; ++j) Hs[j] = Hs[j] * dA;
#pragma unroll
            for (int kk2 = 0; kk2 < 2; ++kk2) {
                const bf16x8 af = *(const LAS bf16x8*)(lds + SO_BT + (16 * wq + fr) * SP_P + (32 * kk2 + 8 * fq) * 2);
#pragma unroll
                for (int j = 0; j < 4; ++j) { const bf16x8 bfv = *(const LAS bf16x8*)(hb + SO_XW + (16 * j + fr) * SP_P + (32 * kk2 + 8 * fq) * 2);
                    Hs[j] = __builtin_amdgcn_mfma_f32_16x16x32_bf16(af, bfv, Hs[j], 0, 0, 0); }
            }
        }
        __syncthreads();
    }
    }
#undef SB_LOAD
}

typedef float f32x16 __attribute__((ext_vector_type(16)));
constexpr int AT_KP = 144, AT_VP = 136;
constexpr int AT_KB = 64 * AT_KP, AT_VB = 64 * AT_VP;
__device__ __forceinline__ void attn_block_unit(Frame& F, int L, int unit) {
    const bf16* U = (const bf16*)(F.ws + WS_B); bf16* Y = (bf16*)(F.ws + WS_A);
    const int tid = F.tid, lane = F.lane, w = F.wave, r = lane & 31, hf = lane >> 5;
    const bool lat = unit < 512;
    int b, g, qt;
    if (lat) { b = unit >> 6; g = (unit >> 5) & 1; qt = unit & 31; } else { const int u2 = unit - 512; b = u2 >> 3; g = (u2 >> 2) & 1; qt = u2 & 3; }
    const int t0 = qt * 64, hh = w >> 1, qh = w & 1, head = g * 4 + hh, t = t0 + 32 * qh + r;
    const size_t qrow = lat ? (size_t)(b * TL + t) : (size_t)(ML + b * LC + t);
    LAS unsigned char* Kt = F.lds + RING_OFF;
    LAS unsigned char* Vt = F.lds + RING_OFF + 2 * AT_KB;
    bf16x8 qf[4];
#pragma unroll
    for (int ks = 0; ks < 4; ++ks) qf[ks] = *(const bf16x8*)(U + qrow * NU + 256 * (13 + (head >> 2)) + (ks < 2 ? 0 : 128) + 32 * (head & 3) + ((16 * ks + 8 * hf) & 31));
    const int rel_lo = lat ? (qt < 2 ? -qt : -2) : 0, rel_hi = lat ? (31 - qt < 2 ? 31 - qt : 2) : -1;
    const int ntiles = 4 + (rel_hi - rel_lo + 1);
    f32x16 o0, o1;
#pragma unroll
    for (int i = 0; i < 16; ++i) { o0[i] = 0.f; o1[i] = 0.f; }
    float mrun = kin(I_SINK)[L * 8 + head] * 1.4426950408889634f, lrun = (hf == 0) ? 1.f : 0.f;
    const int skk = tid >> 3, sc8 = tid & 7;
    v4u pk, pv;
#define AT_LOAD(i_) do { const int i__ = (i_); const size_t base_ = (i__ < 4) ? (size_t)(ML + b * LC + 64 * i__) : (size_t)(b * TL + t0 + 64 * (rel_lo + i__ - 4)); \
        const bf16* kp_ = U + (base_ + skk) * NU + 3840 + (sc8 < 4 ? 0 : 128) + 8 * (sc8 & 3); pk = *(const v4u*)(kp_ + 32 * g); pv = *(const v4u*)(kp_ + 32 * (2 + g)); } while (0)
#define AT_STORE(buf_) do { *(LAS v4u*)(Kt + (buf_) * AT_KB + skk * AT_KP + sc8 * 16) = pk; LAS unsigned short* vb_ = (LAS unsigned short*)(Vt + (buf_) * AT_VB + (8 * sc8) * AT_VP + skk * 2); \
        vb_[0 * (AT_VP / 2)] = (unsigned short)(pv.x & 0xffffu); vb_[1 * (AT_VP / 2)] = (unsigned short)(pv.x >> 16); vb_[2 * (AT_VP / 2)] = (unsigned short)(pv.y & 0xffffu); vb_[3 * (AT_VP / 2)] = (unsigned short)(pv.y >> 16); \
        vb_[4 * (AT_VP / 2)] = (unsigned short)(pv.z & 0xffffu); vb_[5 * (AT_VP / 2)] = (unsigned short)(pv.z >> 16); vb_[6 * (AT_VP / 2)] = (unsigned short)(pv.w & 0xffffu); vb_[7 * (AT_VP / 2)] = (unsigned short)(pv.w >> 16); } while (0)
    __syncthreads();
    AT_LOAD(0); AT_STORE(0);
    __syncthreads();
    for (int i = 0; i < ntiles; ++i) {
        const int buf = i & 1;
        if (i + 1 < ntiles) AT_LOAD(i + 1);
        const LAS unsigned char* kb = Kt + buf * AT_KB; const LAS unsigned char* vb = Vt + buf * AT_VB;
        f32x16 s0, s1;
#pragma unroll
        for (int e = 0; e < 16; ++e) { s0[e] = 0.f; s1[e] = 0.f; }
#pragma unroll
        for (int ks = 0; ks < 4; ++ks) {
            const bf16x8 k0 = *(const LAS bf16x8*)(kb + r * AT_KP + (16 * ks + 8 * hf) * 2), k1 = *(const LAS bf16x8*)(kb + (32 + r) * AT_KP + (16 * ks + 8 * hf) * 2);
            s0 = __builtin_amdgcn_mfma_f32_32x32x16_bf16(k0, qf[ks], s0, 0, 0, 0);
            s1 = __builtin_amdgcn_mfma_f32_32x32x16_bf16(k1, qf[ks], s1, 0, 0, 0);
        }
        if (i >= 4) { const int rel = rel_lo + i - 4;
            if (rel == 2 || rel == -2) { const int dbase = 64 * rel - 32 * qh - r + 4 * hf;
#pragma unroll
                for (int e = 0; e < 16; ++e) { const int d0 = dbase + (e & 3) + 8 * (e >> 2), d1 = d0 + 32;
                    if (d0 > 128 || d0 < -128) s0[e] = -INFINITY; if (d1 > 128 || d1 < -128) s1[e] = -INFINITY; } } }
        float tm = s0[0];
#pragma unroll
        for (int e = 1; e < 16; ++e) tm = fmaxf(tm, s0[e]);
#pragma unroll
        for (int e = 0; e < 16; ++e) tm = fmaxf(tm, s1[e]);
        tm = fmaxf(tm, __shfl_xor(tm, 32));
        const float mn = fmaxf(mrun, tm), al = __builtin_amdgcn_exp2f(mrun - mn); mrun = mn;
        float ps = 0.f;
#pragma unroll
        for (int e = 0; e < 16; ++e) { s0[e] = __builtin_amdgcn_exp2f(s0[e] - mn); s1[e] = __builtin_amdgcn_exp2f(s1[e] - mn); ps += s0[e] + s1[e]; }
        lrun = lrun * al + ps;
#pragma unroll
        for (int e = 0; e < 16; ++e) { o0[e] *= al; o1[e] *= al; }
        bf16x8 pf[4];
#pragma unroll
        for (int s2 = 0; s2 < 2; ++s2) {
            unsigned a0 = pk2(s0[8 * s2 + 0], s0[8 * s2 + 1]), a1 = pk2(s0[8 * s2 + 2], s0[8 * s2 + 3]), a2 = pk2(s0[8 * s2 + 4], s0[8 * s2 + 5]), a3 = pk2(s0[8 * s2 + 6], s0[8 * s2 + 7]);
            unsigned c0 = pk2(s1[8 * s2 + 0], s1[8 * s2 + 1]), c1 = pk2(s1[8 * s2 + 2], s1[8 * s2 + 3]), c2 = pk2(s1[8 * s2 + 4], s1[8 * s2 + 5]), c3 = pk2(s1[8 * s2 + 6], s1[8 * s2 + 7]);
            v4u x; x.x = a0; x.y = a1; x.z = a2; x.w = a3; pf[s2] = __builtin_bit_cast(bf16x8, x);
            v4u y; y.x = c0; y.y = c1; y.z = c2; y.w = c3; pf[2 + s2] = __builtin_bit_cast(bf16x8, y);
        }
#pragma unroll
        for (int ks = 0; ks < 4; ++ks) {
            const int kofs = (16 * ks + 4 * hf) * 2;
            typedef unsigned u32x2 __attribute__((ext_vector_type(2)));
            const u32x2 a_lo0 = *(const LAS u32x2*)(vb + r * AT_VP + kofs), a_hi0 = *(const LAS u32x2*)(vb + r * AT_VP + kofs + 16);
            const u32x2 a_lo1 = *(const LAS u32x2*)(vb + (32 + r) * AT_VP + kofs), a_hi1 = *(const LAS u32x2*)(vb + (32 + r) * AT_VP + kofs + 16);
            v4u va; va.x = a_lo0.x; va.y = a_lo0.y; va.z = a_hi0.x; va.w = a_hi0.y;
            v4u vc; vc.x = a_lo1.x; vc.y = a_lo1.y; vc.z = a_hi1.x; vc.w = a_hi1.y;
            o0 = __builtin_amdgcn_mfma_f32_32x32x16_bf16(__builtin_bit_cast(bf16x8, va), pf[ks], o0, 0, 0, 0);
            o1 = __builtin_amdgcn_mfma_f32_32x32x16_bf16(__builtin_bit_cast(bf16x8, vc), pf[ks], o1, 0, 0, 0);
        }
        if (i + 1 < ntiles) AT_STORE(buf ^ 1);
        __syncthreads();
    }
#undef AT_LOAD
#undef AT_STORE
    const float il = 1.f / (lrun + __shfl_xor(lrun, 32));
    bf16* yp = Y + qrow * NY + 1024 + head * 64 + 4 * hf;
    typedef unsigned u32x2s __attribute__((ext_vector_type(2)));
#pragma unroll
    for (int gq = 0; gq < 4; ++gq) {
        u32x2s w0; w0.x = pk2(o0[4 * gq] * il, o0[4 * gq + 1] * il); w0.y = pk2(o0[4 * gq + 2] * il, o0[4 * gq + 3] * il);
        u32x2s w1; w1.x = pk2(o1[4 * gq] * il, o1[4 * gq + 1] * il); w1.y = pk2(o1[4 * gq + 2] * il, o1[4 * gq + 3] * il);
        *(u32x2s*)(yp + 8 * gq) = w0; *(u32x2s*)(yp + 32 + 8 * gq) = w1;
    }
}

__device__ __forceinline__ void unpack8(const v4u w, float (&o)[8]) {
    o[0] = __uint_as_float(w.x << 16); o[1] = __uint_as_float(w.x & 0xffff0000u); o[2] = __uint_as_float(w.y << 16); o[3] = __uint_as_float(w.y & 0xffff0000u);
    o[4] = __uint_as_float(w.z << 16); o[5] = __uint_as_float(w.z & 0xffff0000u); o[6] = __uint_as_float(w.w << 16); o[7] = __uint_as_float(w.w & 0xffff0000u);
}
__device__ __forceinline__ void phase_finish(Frame& F, int L) {
    const bf16* U = (const bf16*)(F.ws + WS_B); bf16* Y = (bf16*)(F.ws + WS_A); const bf16* P = (const bf16*)(F.ws + WS_P);
    const int gw = blockIdx.x * NWAVES + F.wave, NGW = F.G * NWAVES, lane = F.lane, nrows = (L == 0) ? MT : ML;
    float g1[8], g2[8];
#pragma unroll
    for (int j = 0; j < 8; ++j) { g1[j] = kin(I_MLNG)[L * 512 + 8 * lane + j]; g2[j] = kin(I_SSDNG)[L * 512 + 8 * lane + j]; }
    for (int r0 = gw; r0 < nrows; r0 += 3 * NGW) {
        v4u hw[3], ow[3], pw[3], sw[3], zw[3], qw[3]; int rr[3];
#pragma unroll
        for (int i = 0; i < 3; ++i) { const int r = r0 + i * NGW; rr[i] = r < nrows ? r : r0;
            const bf16* yr = Y + (size_t)rr[i] * NY; const bf16* ur = U + (size_t)rr[i] * NU; const bf16* pr = P + (size_t)rr[i] * 1024;
            hw[i] = *(const v4u*)(yr + 8 * lane); ow[i] = *(const v4u*)(ur + UO + 8 * lane); pw[i] = *(const v4u*)(pr + 8 * lane);
            sw[i] = *(const v4u*)(yr + 512 + 8 * lane); zw[i] = *(const v4u*)(ur + UZ + 8 * lane); qw[i] = *(const v4u*)(pr + 512 + 8 * lane); }
        float hv[3][8], sv[3][8], s1[3], s2[3];
#pragma unroll
        for (int i = 0; i < 3; ++i) { float a[8], b[8]; unpack8(hw[i], a); unpack8(pw[i], b); float q = 0.f;
#pragma unroll
            for (int j = 0; j < 8; ++j) { hv[i][j] = a[j] + b[j]; q += hv[i][j] * hv[i][j]; }
            s1[i] = q;
            float c[8], e[8], z[8]; unpack8(sw[i], c); unpack8(qw[i], e); unpack8(zw[i], z); q = 0.f;
#pragma unroll
            for (int j = 0; j < 8; ++j) { const float y = (c[j] + e[j]) * z[j] * __builtin_amdgcn_rcpf(1.f + __expf(-z[j])); sv[i][j] = y; q += y * y; }
            s2[i] = q; }
#pragma unroll
        for (int o = 1; o < 16; o <<= 1) { const float t0 = __shfl_xor(s1[0], o), t1 = __shfl_xor(s1[1], o), t2 = __shfl_xor(s1[2], o); s1[0] += t0; s1[1] += t1; s1[2] += t2; }
#pragma unroll
        for (int o = 1; o < 64; o <<= 1) { const float t0 = __shfl_xor(s2[0], o), t1 = __shfl_xor(s2[1], o), t2 = __shfl_xor(s2[2], o); s2[0] += t0; s2[1] += t1; s2[2] += t2; }
#pragma unroll
        for (int i = 0; i < 3; ++i) { if (r0 + i * NGW < nrows) { bf16* yr = Y + (size_t)rr[i] * NY;
            const float r1 = 1.0f / sqrtf(s1[i] * (1.f / 128.f) + EPS), r2 = 1.0f / sqrtf(s2[i] * (1.f / 512.f) + EPS);
            float ov[8]; unpack8(ow[i], ov); float rv[8];
#pragma unroll
            for (int j = 0; j < 8; ++j) rv[j] = hv[i][j] * r1 * g1[j] * __builtin_amdgcn_rcpf(1.f + __expf(-ov[j]));
            v4u w; w.x = pk2(rv[0], rv[1]); w.y = pk2(rv[2], rv[3]); w.z = pk2(rv[4], rv[5]); w.w = pk2(rv[6], rv[7]);
            *(v4u*)(yr + 8 * lane) = w;
            v4u x; x.x = pk2(sv[i][0] * r2 * g2[0], sv[i][1] * r2 * g2[1]); x.y = pk2(sv[i][2] * r2 * g2[2], sv[i][3] * r2 * g2[3]); x.z = pk2(sv[i][4] * r2 * g2[4], sv[i][5] * r2 * g2[5]); x.w = pk2(sv[i][6] * r2 * g2[6], sv[i][7] * r2 * g2[7]);
            *(v4u*)(yr + 512 + 8 * lane) = x; } }
    }
}

#ifdef NO_MLSTM
#define MLSTM_CALL(d)
#else
#define MLSTM_CALL(d)
#endif
#ifdef NO_MLSTMB
#define MLSTMB_CALL(d, u)
#else
#define MLSTMB_CALL(d, u) mlstm_block_unit(F, L, d, u);
#endif
#ifdef NO_SSDB
#define SSDB_CALL(d, u)
#else
#define SSDB_CALL(d, u) ssd_block_unit(F, L, d, u);
#endif
#ifdef NO_SSD
#define SSD_CALL(d)
#else
#define SSD_CALL(d)
#endif
#ifdef NO_ATTN
#define ATTN_CALL ;
#else
#define ATTN_CALL attn_block_unit(F, L, u);
#endif
#ifndef DUP_MASK
#define DUP_MASK 0
#endif
#define TWICE(p, ...) do { int qrep = 0; (void)qrep; { __VA_ARGS__ } if (((DUP_MASK) >> (p)) & 1) { qrep = 1; __syncthreads(); asm volatile("" : "+v"(F.lane), "+v"(F.tid)); F.wave = __builtin_amdgcn_readfirstlane(F.tid >> 6); { __VA_ARGS__ } } } while (0)
struct Args { const float* in[24]; float* out; unsigned char* ws; int ph_lo, ph_hi; };
__global__ void __launch_bounds__(NWAVES * 64, 2) mk_fwd(Args args) {
    extern __shared__ __attribute__((aligned(16))) unsigned char lds[];
    Frame F;
    F.lds = (LAS unsigned char*)lds;
    F.MISC = (volatile LAS unsigned*)(F.lds + MISC_OFF);
    F.tid = threadIdx.x; F.lane = F.tid & 63; F.wave = __builtin_amdgcn_readfirstlane(F.tid >> 6);
    F.G = gridDim.x;
    F.ws = args.ws; F.out = args.out; F.ctl = (gu32*)(args.ws + WS_CTL);
    for (int u = F.tid; u < (LDS_BYTES - LDSCTL_OFF) / 4; u += NWAVES * 64) ((LAS unsigned*)(F.lds + LDSCTL_OFF))[u] = 0u;
    __syncthreads();
    const int lo = args.ph_lo, hi = args.ph_hi;
    const bool use_bar = (hi - lo) > 1;
    XcdBarrier bar; bar.bar = (unsigned*)(F.ctl + CW_BAR); bar.x = 0; bar.st = nullptr;
    if (use_bar) bar = xcd_barrier_post((unsigned*)(F.ctl + CW_BAR), F.MISC + 8);
#define IN(k) (lo <= (k) && (k) < hi)
#define XL ((L == 0) ? kin(I_X) : (const float*)F.out)
#define XC ((L == 0) ? kin(I_CTX) : (const float*)(F.ws + WS_CTXF))
#define SEAM(k) do { if (IN(k) && IN((k) + 1)) xcd_barrier(bar); asm volatile("" : "+v"(F.lane), "+v"(F.tid)); F.wave = __builtin_amdgcn_readfirstlane(F.tid >> 6); } while (0)

    bf16* W0 = (bf16*)(F.ws + WS_W0); bf16* W1 = (bf16*)(F.ws + WS_W1);
    bf16* RA = (bf16*)(F.ws + WS_A); bf16* RB = (bf16*)(F.ws + WS_B);
    float* CTXF = (float*)(F.ws + WS_CTXF);
    const float* MOD = (const float*)(F.ws + WS_MOD);

        if (IN(0)) { phase_mod(F); }
    SEAM(0);

    for (int L = 0; L < 2; ++L) {
        const int p0 = 1 + 8 * L;
        const int Mout = (L == 0) ? MT : ML;
        if (IN(p0 + 0)) TWICE(0,
            convert_win(F, kin(I_WIN) + (size_t)L * DM * INW, W0);
            convert_weight(F, kin(I_WOUT) + (size_t)L * NY * DM, NY, DM, W1);
            norm_rows(F, L, MT, XL, XC, kin(I_N1G) + L * DM, 0, RA);
            __syncthreads();
        );
        SEAM(p0 + 0);
        if (IN(p0 + 1)) TWICE(1,
            pg8::Gemm g{RA, W0, MT, NUP, DM}; pg8::StaticOrder S; S.init(MT, NUP, F.G, (int)blockIdx.x);
            pg8::EpiU E{F.ws, (unsigned)WS_B, (unsigned)WS_GATES, (unsigned)(WS_CST + (size_t)L * CST_BYTES)};
            pg8::gemm_phase<pg8::EpiU, pg8::StaticOrder, true, true>(F.lds + RING_OFF, g, S, E);
        );
        SEAM(p0 + 1);
        if (IN(p0 + 2)) TWICE(2,
            if (blockIdx.x < 64) { MLSTMB_CALL((int)blockIdx.x >> 5, (int)blockIdx.x & 31) }
            else if (blockIdx.x < 128) { SSDB_CALL(((int)blockIdx.x - 64) >> 5, ((int)blockIdx.x - 64) & 31) }
            { const int nun = (L == 0) ? 576 : 512;
              for (;;) { __syncthreads(); if (F.tid == 0) F.MISC[16] = __hip_atomic_fetch_add((unsigned*)(F.ctl + 64 + 64 * (L + 2 * qrep)), 1u, __ATOMIC_RELAXED, __HIP_MEMORY_SCOPE_AGENT);
                  __syncthreads(); const int u = (int)F.MISC[16]; if (u >= nun) break; ATTN_CALL } }
            __syncthreads();
        );
        SEAM(p0 + 2);
        if (IN(p0 + 3)) { phase_finish(F, L); }
        SEAM(p0 + 3);
        if (IN(p0 + 4)) {
            pg8::Gemm g{RA, W1, Mout, DM, NY}; pg8::StaticOrder S; S.init(Mout, DM, F.G, (int)blockIdx.x);
            pg8::EpiRes E{XL, F.out, XC, CTXF, MOD + (size_t)L * 9 * 6144 + 2 * 1024};
            pg8::gemm_phase<pg8::EpiRes, pg8::StaticOrder, true, true>(F.lds + RING_OFF, g, S, E);
        }
        SEAM(p0 + 4);
        if (IN(p0 + 5)) TWICE(5,
            convert_weight(F, kin(I_WUP) + (size_t)L * DM * DFF, DM, DFF, W0);
            convert_weight(F, kin(I_WDOWN) + (size_t)L * DFF * DM, DFF, DM, W1);
            norm_rows(F, L, Mout, (const float*)F.out, (const float*)CTXF, kin(I_N2G) + L * DM, 3, RA);
        );
        SEAM(p0 + 5);
        if (IN(p0 + 6)) TWICE(6,
            pg8::Gemm g{RA, W0, Mout, DFF, DM}; pg8::StaticOrder S; S.init(Mout, DFF, F.G, (int)blockIdx.x);
            pg8::EpiBf16<2> E{RB, DFF};
            pg8::gemm_phase<pg8::EpiBf16<2>, pg8::StaticOrder, true, true>(F.lds + RING_OFF, g, S, E);
        );
        SEAM(p0 + 6);
        if (IN(p0 + 7)) {
            pg8::Gemm g{RB, W1, Mout, DM, DFF}; pg8::StaticOrder S; S.init(Mout, DM, F.G, (int)blockIdx.x);
            pg8::EpiRes E{(const float*)F.out, F.out, (const float*)CTXF, CTXF, MOD + (size_t)L * 9 * 6144 + 5 * 1024};
            pg8::gemm_phase<pg8::EpiRes, pg8::StaticOrder, true, true>(F.lds + RING_OFF, g, S, E);
        }
        SEAM(p0 + 7);
    }
#undef IN
#undef SEAM
}

#ifndef MK_N_LAUNCHES
#define MK_N_LAUNCHES 1
#endif
extern "C" void kernel_launch(void* const* d_in, const int* in_sizes, int n_in, void* d_out, int out_size, void* d_ws, size_t ws_size, hipStream_t stream) {
    static int grid = 0;
    if (grid == 0) {
        if (n_in != 24 || out_size != ML * DM || ws_size < WS_END) { fprintf(stderr, "kernel_launch: unexpected shapes (n_in %d out %d ws %zu)\n", n_in, out_size, ws_size); grid = -1; return; }
        int dev = 0, cus = 0, per_cu = 0;
        if (hipGetDevice(&dev) != hipSuccess || hipDeviceGetAttribute(&cus, hipDeviceAttributeMultiprocessorCount, dev) != hipSuccess) { grid = -1; return; }
        if (hipFuncSetAttribute((const void*)mk_fwd, hipFuncAttributeMaxDynamicSharedMemorySize, LDS_BYTES) != hipSuccess) { fprintf(stderr, "kernel_launch: hipFuncSetAttribute failed\n"); grid = -1; return; }
        if (hipOccupancyMaxActiveBlocksPerMultiprocessor(&per_cu, (const void*)mk_fwd, NWAVES * 64, LDS_BYTES) != hipSuccess || per_cu < 1) fprintf(stderr, "kernel_launch: occupancy query reports %d\n", per_cu);
        (void)hipGetLastError();
        grid = cus;
    }
    if (grid < 0) return;
    if (hipMemsetAsync((char*)d_ws + WS_CTL, 0, CTL_ZERO_BYTES, stream) != hipSuccess) return;
    Args a{};
    for (int i = 0; i < 24; ++i) a.in[i] = (const float*)d_in[i];
    a.out = (float*)d_out; a.ws = (unsigned char*)d_ws;
    if (MK_N_LAUNCHES == 1) { a.ph_lo = 0; a.ph_hi = NPH; hipLaunchKernelGGL(mk_fwd, dim3(grid), dim3(NWAVES * 64), LDS_BYTES, stream, a); }
    else { for (int p = 0; p < NPH; ++p) { a.ph_lo = p; a.ph_hi = p + 1; hipLaunchKernelGGL(mk_fwd, dim3(grid), dim3(NWAVES * 64), LDS_BYTES, stream, a); } }
}
```
